# Optimizing an MI355X kernel written in HIP

```python
import math
import jax, jax.numpy as jnp
from jax import lax
import numpy as np

D_MODEL = 2048
BATCH = 8
SEQ = 2048
DEPTH = 2

CHUNK = 64
N_MEM = 256
HEAD_DIM = 128
N_GROUPS = 4
GROUP_HEADS = D_MODEL // (N_GROUPS * HEAD_DIM)
GROUP_WIDTH = GROUP_HEADS * HEAD_DIM
D_MIX = N_GROUPS * GROUP_WIDTH
CONV_WIDTH = 4
N_PREV_CHUNKS = 8
N_BAND = N_PREV_CHUNKS + 1
REL_CLIP = 128
ROPE_BASE = 10000.0
D_FF = ((8 * D_MODEL // 3 + 255) // 256) * 256
N_EXPERTS = 8
TOP_K = 2
D_FF_EXPERT = 7 * D_MODEL // 2
N_DENSE = (DEPTH + 1) // 2
N_MOE = DEPTH // 2
EPS = 1e-6
IN_SPLITS = (GROUP_WIDTH, GROUP_WIDTH, GROUP_WIDTH, GROUP_WIDTH, GROUP_HEADS, GROUP_HEADS,
             GROUP_WIDTH, GROUP_WIDTH, GROUP_WIDTH, GROUP_WIDTH,
             GROUP_WIDTH, GROUP_WIDTH, GROUP_WIDTH,
             GROUP_WIDTH)
D_IN = sum(IN_SPLITS)

kernel_name = 'hybrid_chunk_streaming_block'


def rms_norm(x, g):
    xf = x.astype(jnp.float32)
    y = xf * lax.rsqrt(jnp.mean(xf * xf, axis=-1, keepdims=True) + EPS)
    return (y * g.astype(jnp.float32)).astype(x.dtype)


def l2_normalize(x):
    xf = x.astype(jnp.float32)
    return (xf * lax.rsqrt(jnp.sum(xf * xf, axis=-1, keepdims=True) + EPS)).astype(x.dtype)


def split_cols(x, sizes):
    offs = np.cumsum(np.array(sizes))[:-1].tolist()
    return jnp.split(x, offs, axis=-1)


def split_heads(x):
    b, s, _ = x.shape
    return x.reshape(b, s, -1, HEAD_DIM).transpose(0, 2, 1, 3)


def merge_heads(x):
    b, h, s, d = x.shape
    return x.transpose(0, 2, 1, 3).reshape(b, s, h * d)


def to_chunks(x):
    b, h, s = x.shape[:3]
    return x.reshape(b, h, s // CHUNK, CHUNK, *x.shape[3:])


def causal_depthwise_conv(x, w):
    k, c = w.shape
    return lax.conv_general_dilated(x, w[:, None, :].astype(x.dtype), window_strides=(1,),
                                    padding=[(k - 1, 0)], dimension_numbers=('NWC', 'WIO', 'NWC'),
                                    feature_group_count=c)


def rotary(x, pos):
    half = HEAD_DIM // 2
    inv = ROPE_BASE ** (-jnp.arange(half, dtype=jnp.float32) / half)
    ang = pos.astype(jnp.float32)[:, None] * inv[None, :]
    cos, sin = jnp.cos(ang), jnp.sin(ang)
    xf = x.astype(jnp.float32)
    x1, x2 = xf[..., :half], xf[..., half:]
    return jnp.concatenate([x1 * cos - x2 * sin, x2 * cos + x1 * sin], axis=-1).astype(x.dtype)


def gated_delta_rule(q, k, v, g, beta):
    out_dtype = v.dtype
    q, k, v, g, beta = (t.astype(jnp.float32) for t in (q, k, v, g, beta))
    b, h, s, dk = q.shape
    n = s // CHUNK
    qc = to_chunks(q) * dk ** -0.5
    kc, vc = to_chunks(k), to_chunks(v)
    gc = jnp.cumsum(g.reshape(b, h, n, CHUNK), axis=-1)
    bc = beta.reshape(b, h, n, CHUNK)[..., None]
    incl = jnp.tril(jnp.ones((CHUNK, CHUNK), bool))
    strict = jnp.tril(jnp.ones((CHUNK, CHUNK), bool), -1)
    diff = gc[..., :, None] - gc[..., None, :]
    decay = jnp.where(incl, jnp.exp(jnp.where(incl, diff, 0.0)), 0.0)
    k_beta = kc * bc
    lmat = jnp.where(strict, jnp.einsum('bhnid,bhnjd->bhnij', k_beta, kc) * decay, 0.0)
    tmat = lmat + jnp.eye(CHUNK, dtype=jnp.float32)
    solve = lambda rhs: lax.linalg.triangular_solve(tmat, rhs, left_side=True, lower=True,
                                                    unit_diagonal=True)
    u = solve(vc * bc)
    w = solve(k_beta * jnp.exp(gc)[..., None])
    attn = jnp.einsum('bhnid,bhnjd->bhnij', qc, kc) * decay
    q_dec = qc * jnp.exp(gc)[..., None]
    k_dec = kc * jnp.exp(gc[..., -1:] - gc)[..., None]
    g_tot = jnp.exp(gc[..., -1])

    def step(state, inp):
        q_i, k_i, u_i, w_i, a_i, gt_i = inp
        v_new = u_i - jnp.einsum('bhck,bhkv->bhcv', w_i, state)
        o_i = jnp.einsum('bhck,bhkv->bhcv', q_i, state) + jnp.einsum('bhij,bhjv->bhiv', a_i, v_new)
        state = state * gt_i[..., None, None] + jnp.einsum('bhck,bhcv->bhkv', k_i, v_new)
        return state, o_i

    xs = tuple(jnp.moveaxis(t, 2, 0) for t in (q_dec, k_dec, u, w, attn, g_tot))
    s0 = jnp.zeros((b, h, dk, v.shape[-1]), jnp.float32)
    _, o = lax.scan(step, s0, xs)
    return jnp.moveaxis(o, 0, 2).reshape(b, h, s, -1).astype(out_dtype)


def multiscale_retention(q, k, v):
    out_dtype = v.dtype
    q, k, v = (t.astype(jnp.float32) for t in (q, k, v))
    b, h, s, dk = q.shape
    log_gamma = jnp.log1p(-jnp.exp2(-5.0 - jnp.arange(h, dtype=jnp.float32)))
    pos = jnp.arange(CHUNK, dtype=jnp.float32)
    rel = pos[:, None] - pos[None, :]
    causal = rel >= 0
    dmat = jnp.where(causal, jnp.exp(jnp.where(causal, rel, 0.0) * log_gamma[:, None, None]), 0.0)
    qc, kc, vc = to_chunks(q), to_chunks(k) * dk ** -0.5, to_chunks(v)
    scores = jnp.einsum('bhnid,bhnjd->bhnij', qc, kc) * dmat[:, None]
    o_inner = jnp.einsum('bhnij,bhnjv->bhniv', scores, vc)
    xi = jnp.exp((pos + 1.0)[None, :] * log_gamma[:, None])
    zeta = jnp.exp((CHUNK - 1.0 - pos)[None, :] * log_gamma[:, None])
    gamma_chunk = jnp.exp(CHUNK * log_gamma)
    q_dec = qc * xi[:, None, :, None]
    k_dec = kc * zeta[:, None, :, None]

    def step(state, inp):
        q_i, k_i, v_i = inp
        o_i = jnp.einsum('bhck,bhkv->bhcv', q_i, state)
        state = state * gamma_chunk[:, None, None] + jnp.einsum('bhck,bhcv->bhkv', k_i, v_i)
        return state, o_i

    xs = tuple(jnp.moveaxis(t, 2, 0) for t in (q_dec, k_dec, vc))
    s0 = jnp.zeros((b, h, dk, v.shape[-1]), jnp.float32)
    _, o_cross = lax.scan(step, s0, xs)
    o = o_inner + jnp.moveaxis(o_cross, 0, 2)
    return o.reshape(b, h, s, -1).astype(out_dtype)


def head_group_norm(o, g):
    of = o.astype(jnp.float32)
    mu = jnp.mean(of, axis=-1, keepdims=True)
    var = jnp.mean(jnp.square(of - mu), axis=-1, keepdims=True)
    y = merge_heads((of - mu) * lax.rsqrt(var + EPS))
    return (y * g.astype(jnp.float32)).astype(o.dtype)


def chunk_band_attention(q, k, v, rel_bias):
    b, h, s, d = q.shape
    n = s // CHUNK
    qc = to_chunks(q)
    pad = ((0, 0), (0, 0), (N_PREV_CHUNKS, 0), (0, 0), (0, 0))
    kp, vp = jnp.pad(to_chunks(k), pad), jnp.pad(to_chunks(v), pad)
    idx = jnp.arange(n)[:, None] + jnp.arange(N_BAND)[None, :]
    kb = kp[:, :, idx].reshape(b, h, n, N_BAND * CHUNK, d)
    vb = vp[:, :, idx].reshape(b, h, n, N_BAND * CHUNK, d)
    valid = jnp.repeat(idx >= N_PREV_CHUNKS, CHUNK, axis=1)
    rel = N_PREV_CHUNKS * CHUNK + jnp.arange(CHUNK)[:, None] - jnp.arange(N_BAND * CHUNK)[None, :]
    bias = rel_bias[:, jnp.clip(rel, -REL_CLIP, REL_CLIP) + REL_CLIP].astype(jnp.float32)
    scores = jnp.einsum('bhncd,bhnkd->bhnck', qc, kb).astype(jnp.float32) * d ** -0.5
    scores = scores + bias[None, :, None]
    scores = jnp.where(valid[None, None, :, None, :], scores, -1e30)
    p = jax.nn.softmax(scores, axis=-1).astype(v.dtype)
    o = jnp.einsum('bhnck,bhnkd->bhncd', p, vb)
    return o.reshape(b, h, s, d)


def memory_attention(q, k, v):
    scores = jnp.einsum('bhsd,bhmd->bhsm', q, k).astype(jnp.float32) * q.shape[-1] ** -0.5
    p = jax.nn.softmax(scores, axis=-1).astype(v.dtype)
    return jnp.einsum('bhsm,bhmd->bhsd', p, v)


def swiglu(h, w_gate, w_up, w_down):
    return (jax.nn.silu(h @ w_gate) * (h @ w_up)) @ w_down


def moe_swiglu(h, w_router, w_gate, w_up, w_down):
    b, s, d = h.shape
    t = h.reshape(b * s, d)
    logits = (t @ w_router).astype(jnp.float32)
    top_logits, top_idx = lax.top_k(logits, TOP_K)
    gates = jax.nn.softmax(top_logits, axis=-1)
    flat_e = top_idx.reshape(-1)
    order = jnp.argsort(flat_e)
    tok = order // TOP_K
    xs = t[tok]
    sizes = jnp.bincount(flat_e, length=N_EXPERTS).astype(jnp.int32)
    hg = lax.ragged_dot(xs, w_gate, sizes)
    hu = lax.ragged_dot(xs, w_up, sizes)
    ys = lax.ragged_dot(jax.nn.silu(hg) * hu, w_down, sizes)
    ys = ys * gates.reshape(-1)[order][:, None].astype(ys.dtype)
    out = jnp.zeros_like(t).at[tok].add(ys)
    return out.reshape(b, s, d)


def setup_inputs(seed: int = 0) -> dict:
    key = jax.random.key(seed)
    ks = jax.random.split(key, 32)
    f32 = jnp.float32
    nrm = lambda k, shape, fan_in: jax.random.normal(k, shape, f32) * fan_in ** -0.5
    gain = lambda k, shape: 1.0 + 0.05 * jax.random.normal(k, shape, f32)
    dt = jnp.exp(jax.random.uniform(ks[7], (DEPTH, GROUP_HEADS), f32,
                                    minval=math.log(1e-3), maxval=math.log(1e-1)))
    return {
        'x': jax.random.normal(ks[0], (BATCH, SEQ, D_MODEL), f32),
        'mem': jax.random.normal(ks[1], (BATCH, N_MEM, D_MODEL), f32),
        'norm_mix_g': gain(ks[2], (DEPTH, D_MODEL)),
        'norm_mem_g': gain(ks[3], (DEPTH, D_MODEL)),
        'w_in': nrm(ks[4], (DEPTH, D_MODEL, D_IN), D_MODEL),
        'conv_w': nrm(ks[5], (DEPTH, CONV_WIDTH, 3 * GROUP_WIDTH), CONV_WIDTH),
        'a_log': jnp.log(jax.random.uniform(ks[6], (DEPTH, GROUP_HEADS), f32, minval=1.0, maxval=16.0)),
        'dt_bias': dt + jnp.log(-jnp.expm1(-dt)),
        'delta_norm_g': gain(ks[8], (DEPTH, HEAD_DIM)),
        'ret_norm_g': gain(ks[9], (DEPTH, GROUP_WIDTH)),
        'attn_q_norm_g': gain(ks[10], (DEPTH, HEAD_DIM)),
        'attn_k_norm_g': gain(ks[11], (DEPTH, HEAD_DIM)),
        'rel_bias': 0.2 * jax.random.normal(ks[12], (DEPTH, GROUP_HEADS, 2 * REL_CLIP + 1), f32),
        'mem_q_norm_g': gain(ks[13], (DEPTH, HEAD_DIM)),
        'mem_k_norm_g': gain(ks[14], (DEPTH, HEAD_DIM)),
        'w_mem_kv': nrm(ks[15], (DEPTH, D_MODEL, 2 * GROUP_WIDTH), D_MODEL),
        'w_out': nrm(ks[16], (DEPTH, D_MIX, D_MODEL), D_MIX),
        'norm_ffn_g': gain(ks[17], (DEPTH, D_MODEL)),
        'ffn_w_gate': nrm(ks[18], (N_DENSE, D_MODEL, D_FF), D_MODEL),
        'ffn_w_up': nrm(ks[19], (N_DENSE, D_MODEL, D_FF), D_MODEL),
        'ffn_w_down': nrm(ks[20], (N_DENSE, D_FF, D_MODEL), D_FF),
        'router_w': nrm(ks[21], (N_MOE, D_MODEL, N_EXPERTS), D_MODEL),
        'moe_w_gate': nrm(ks[22], (N_MOE, N_EXPERTS, D_MODEL, D_FF_EXPERT), D_MODEL),
        'moe_w_up': nrm(ks[23], (N_MOE, N_EXPERTS, D_MODEL, D_FF_EXPERT), D_MODEL),
        'moe_w_down': nrm(ks[24], (N_MOE, N_EXPERTS, D_FF_EXPERT, D_MODEL), D_FF_EXPERT),
    }


def reference(x, mem, norm_mix_g, norm_mem_g, w_in, conv_w, a_log, dt_bias, delta_norm_g, ret_norm_g,
              attn_q_norm_g, attn_k_norm_g, rel_bias, mem_q_norm_g, mem_k_norm_g, w_mem_kv, w_out,
              norm_ffn_g, ffn_w_gate, ffn_w_up, ffn_w_down, router_w, moe_w_gate, moe_w_up, moe_w_down):
    pos = jnp.arange(x.shape[1])
    for l in range(DEPTH):
        h = rms_norm(x, norm_mix_g[l])
        proj = h @ w_in[l]
        (qa, ka, va, za, aa, ba, qb, kb, vb, gb, qc, kc, vc, qm) = split_cols(proj, IN_SPLITS)
        qkv = jax.nn.silu(causal_depthwise_conv(jnp.concatenate([qa, ka, va], axis=-1), conv_w[l]))
        qa, ka, va = jnp.split(qkv, 3, axis=-1)
        beta = jax.nn.sigmoid(ba.astype(jnp.float32)).transpose(0, 2, 1)
        g = (-jnp.exp(a_log[l].astype(jnp.float32))
             * jax.nn.softplus(aa.astype(jnp.float32) + dt_bias[l].astype(jnp.float32))).transpose(0, 2, 1)
        o_a = gated_delta_rule(l2_normalize(split_heads(qa)), l2_normalize(split_heads(ka)),
                               split_heads(va), g, beta)
        o_a = merge_heads(rms_norm(o_a, delta_norm_g[l]) * jax.nn.silu(split_heads(za)))
        o_b = multiscale_retention(rotary(split_heads(qb), pos), rotary(split_heads(kb), pos), split_heads(vb))
        o_b = head_group_norm(o_b, ret_norm_g[l]) * jax.nn.silu(gb)
        o_c = merge_heads(chunk_band_attention(rms_norm(split_heads(qc), attn_q_norm_g[l]),
                                               rms_norm(split_heads(kc), attn_k_norm_g[l]),
                                               split_heads(vc), rel_bias[l]))
        km, vm = jnp.split(rms_norm(mem, norm_mem_g[l]) @ w_mem_kv[l], 2, axis=-1)
        o_m = merge_heads(memory_attention(rms_norm(split_heads(qm), mem_q_norm_g[l]),
                                           rms_norm(split_heads(km), mem_k_norm_g[l]),
                                           split_heads(vm)))
        x = x + jnp.concatenate([o_a, o_b, o_c, o_m], axis=-1) @ w_out[l]
        h = rms_norm(x, norm_ffn_g[l])
        i = l // 2
        if l % 2 == 0:
            f = swiglu(h, ffn_w_gate[i], ffn_w_up[i], ffn_w_down[i])
        else:
            f = moe_swiglu(h, router_w[i], moe_w_gate[i], moe_w_up[i], moe_w_down[i])
        x = x + f
    return x
```

```cpp
#include <hip/hip_runtime.h>
#include <cstdio>
#include <cstdint>

#ifndef W_IN_I8
#define W_IN_I8 1
#endif
#ifndef PROBE_MASK
#define PROBE_MASK 3
#endif
#ifndef NAIVE_ATTN
#define NAIVE_ATTN 0
#endif
#ifndef NAIVE_RECUR
#define NAIVE_RECUR 0
#endif
#ifndef ONE_LAUNCH
#define ONE_LAUNCH 1
#endif

#define GAS __attribute__((address_space(1)))
#define LAS __attribute__((address_space(3)))
typedef unsigned short bf16;
typedef unsigned v4u __attribute__((ext_vector_type(4)));
typedef unsigned v2u __attribute__((ext_vector_type(2)));
typedef float f32x4 __attribute__((ext_vector_type(4)));
typedef short bf16x8 __attribute__((ext_vector_type(8)));
typedef int i32x4 __attribute__((ext_vector_type(4)));

constexpr int D = 2048, NB = 8, SEQ = 2048, T = NB * SEQ, NH = 4, HD = 128, GW = 512, DIN = 6152, NPROJ = 6144;
constexpr int CH = 64, NCHUNK = SEQ / CH, NMEM = 256, MROWS = NB * NMEM, NPREV = 8;
constexpr int DFF = 5632, NE = 8, DFFE = 7168, RELW = 257;
constexpr int XS_ROWS = 2 * T + NE * 256;
constexpr float EPS = 1e-6f;
constexpr int C_QA = 0, C_KA = 512, C_VA = 1024, C_ZA = 1536, C_QB = 2048, C_KB = 2560, C_VB = 3072, C_GB = 3584, C_QC = 4096, C_KC = 4608, C_VC = 5120, C_QM = 5632;

constexpr size_t MiB = 1u << 20;
constexpr size_t WS_CTL = 0, CTL_ZERO_BYTES = 64 * 1024;
constexpr size_t WS_WIN = 1 * MiB;
constexpr size_t WS_WMKV = WS_WIN + 48 * MiB;
constexpr size_t WS_WOUT = WS_WMKV + 8 * MiB;
constexpr size_t WS_WGU = WS_WOUT + 16 * MiB;
constexpr size_t WS_WDN = WS_WGU + 44 * MiB;
constexpr size_t WS_MGU = WS_WDN + 22 * MiB;
constexpr size_t WS_MDN = WS_MGU + 448 * MiB;
constexpr size_t WS_HB = WS_MDN + 224 * MiB;
constexpr size_t WS_XB = WS_HB + 64 * MiB;
constexpr size_t WS_MISC = WS_XB + 128 * MiB;
constexpr size_t WS_SCR = WS_MISC + 40 * MiB;
constexpr size_t WS_END = WS_SCR + 748 * MiB;
static_assert(WS_HB == 811 * MiB && WS_END == 1791 * MiB, "ws map");
constexpr size_t MS_MEMH = WS_MISC;
constexpr size_t MS_KVM = WS_MISC + 16 * MiB;
constexpr size_t MS_VMT = WS_MISC + 24 * MiB;
constexpr size_t MS_GATES = WS_MISC + 28 * MiB;
constexpr size_t MS_ROPE = WS_MISC + 29 * MiB;
constexpr size_t MS_TOPE = WS_MISC + 30 * MiB;
constexpr size_t MS_TOPG = MS_TOPE + 128 * 1024;
constexpr size_t MS_POS = MS_TOPG + 128 * 1024;
constexpr size_t MS_ROWG = MS_POS + 128 * 1024;
constexpr size_t MS_CNT = MS_ROWG + 256 * 1024;
constexpr size_t MS_TILE = MS_CNT + 64 * 1024;
constexpr size_t SC_PROJ = WS_SCR;
constexpr size_t SC_CONVA = WS_SCR + 192 * MiB;
constexpr size_t SC_VCT = WS_SCR + 240 * MiB;
constexpr size_t SC_OBUF = WS_SCR + 256 * MiB;
constexpr size_t SC_PRE = WS_SCR + 320 * MiB;
constexpr int REC_BYTES = 90112, REC_QF = 0, REC_KF = 16384, REC_AF = 32768, REC_WF = 40960, REC_U = 57344;
constexpr size_t MS_GTOT = WS_MISC + 32 * MiB;
constexpr size_t MS_SA = WS_MISC + 33 * MiB;
constexpr size_t MS_SXS = WS_MISC + 34 * MiB;
constexpr float SW_D = 127.0f * 45.254833995939045f / 6.0f, INV_SW_D = 1.0f / SW_D;
constexpr size_t SC_ACT = WS_SCR;
constexpr size_t SC_XS = WS_SCR;
constexpr size_t SC_MACT = WS_SCR + 136 * MiB;
constexpr size_t SC_Y = WS_SCR + 612 * MiB;
constexpr int CW_BAR = 4096;

constexpr int LDS_BYTES = 163840;
constexpr int LDS_CTL_OFF = 162816;
constexpr int NWAVES = 8, NTHREADS = 512;

__device__ __forceinline__ unsigned f2bf(float f) { unsigned u = __builtin_bit_cast(unsigned, f); return (u + 0x7fffu + ((u >> 16) & 1u)) >> 16; }
__device__ __forceinline__ unsigned pk2(float lo, float hi) { return f2bf(lo) | (f2bf(hi) << 16); }
__device__ __forceinline__ float bflo(unsigned w) { return __builtin_bit_cast(float, w << 16); }
__device__ __forceinline__ float bfhi(unsigned w) { return __builtin_bit_cast(float, w & 0xffff0000u); }
__device__ __forceinline__ float bf2f(bf16 b) { return __builtin_bit_cast(float, ((unsigned)b) << 16); }
__device__ __forceinline__ float wave_sum(float v) {
#pragma unroll
    for (int o = 1; o < 64; o <<= 1) v += __shfl_xor(v, o);
    return v;
}
__device__ __forceinline__ float wave_max(float v) {
#pragma unroll
    for (int o = 1; o < 64; o <<= 1) v = fmaxf(v, __shfl_xor(v, o));
    return v;
}
__device__ __forceinline__ float grp16_sum(float v) {
#pragma unroll
    for (int o = 1; o < 16; o <<= 1) v += __shfl_xor(v, o);
    return v;
}
__device__ __forceinline__ float silu_f(float x) { return x / (1.0f + __expf(-x)); }
__device__ __forceinline__ void unpack8(const v4u w, float (&f)[8]) {
    f[0] = bflo(w.x); f[1] = bfhi(w.x); f[2] = bflo(w.y); f[3] = bfhi(w.y); f[4] = bflo(w.z); f[5] = bfhi(w.z); f[6] = bflo(w.w); f[7] = bfhi(w.w);
}
__device__ __forceinline__ v4u pack8(const float (&f)[8]) { v4u w; w.x = pk2(f[0], f[1]); w.y = pk2(f[2], f[3]); w.z = pk2(f[4], f[5]); w.w = pk2(f[6], f[7]); return w; }

#define XB_TMO      128
#define XB_XCNT(j)  (256  + 64 * (j))
#define XB_XSUB(j)  (1280 + 64 * (j))
#define XB_XGEN(j)  (2304 + 64 * (j))
#define XB_TOP      3328
#define XB_TOPGEN   3392
#define XCD_BAR_WORDS 3456
#define XB_SPIN_CAP (1u << 18)
__device__ __forceinline__ unsigned xb_ld(unsigned* p)              { return __hip_atomic_load(p, __ATOMIC_RELAXED, __HIP_MEMORY_SCOPE_AGENT); }
__device__ __forceinline__ unsigned xb_add(unsigned* p, unsigned v) { return __hip_atomic_fetch_add(p, v, __ATOMIC_RELAXED, __HIP_MEMORY_SCOPE_AGENT); }
__device__ __forceinline__ unsigned xb_xcc_id() { return (unsigned)__builtin_amdgcn_s_getreg((3 << 11) | 20) & 0xFu; }
#define XB_SPIN(cond, bar) do { unsigned _sp = 0; while (cond) { __builtin_amdgcn_s_sleep(1); \
    if ((++_sp & 255u) == 0u) { if (xb_ld(&(bar)[XB_TMO])) break; if (_sp > XB_SPIN_CAP) { atomicAdd(&(bar)[XB_TMO], 1u); break; } } } } while (0)
struct XcdBarrier { unsigned* bar; unsigned x; volatile LAS unsigned* st; };
__device__ __forceinline__ XcdBarrier xcd_barrier_post(unsigned* bar, volatile LAS unsigned* st) {
    XcdBarrier b; b.bar = bar; b.x = xb_xcc_id(); b.st = st;
    if (threadIdx.x == 0) (void)xb_add(&bar[XB_XCNT(b.x)], 1u);
    return b;
}
__device__ __forceinline__ void xcd_barrier_complete(unsigned* bar, unsigned x, unsigned& nloc, unsigned& nx) {
    const unsigned G = gridDim.x * gridDim.y * gridDim.z;
    unsigned sum, cnt, mine, sp = 0u;
    for (;;) {
        sum = 0u; cnt = 0u; mine = 0u;
#pragma unroll
        for (unsigned j = 0; j < 16; ++j) { const unsigned c = xb_ld(&bar[XB_XCNT(j)]); sum += c; cnt += (c > 0u) ? 1u : 0u; mine = (j == x) ? c : mine; }
        if (sum == G) break;
        __builtin_amdgcn_s_sleep(1);
        if ((++sp & 255u) == 0u) { if (xb_ld(&bar[XB_TMO])) break; if (sp > XB_SPIN_CAP) { atomicAdd(&bar[XB_TMO], 1u); break; } }
    }
    nloc = mine > 0u ? mine : 1u; nx = cnt > 0u ? cnt : 1u;
}
__device__ __forceinline__ void xcd_barrier(const XcdBarrier& b) {
    asm volatile("s_waitcnt vmcnt(0)" ::: "memory");
    __syncthreads();
    if (threadIdx.x == 0) {
        unsigned* bar = b.bar;
        __builtin_amdgcn_s_waitcnt(0);
        unsigned nloc = b.st[0], nx = b.st[1];
        if (nloc == 0u) { xcd_barrier_complete(bar, b.x, nloc, nx); b.st[0] = nloc; b.st[1] = nx; }
        const unsigned old = xb_add(&bar[XB_XSUB(b.x)], 1u);
        const unsigned gen = old / nloc;
        if (old + 1u == (gen + 1u) * nloc) {
            __builtin_amdgcn_fence(__ATOMIC_RELEASE, "agent");
            asm volatile("s_waitcnt vmcnt(0)" ::: "memory");
            const unsigned og = xb_add(&bar[XB_TOP], 1u);
            const unsigned tg = og / nx;
            if (og + 1u == (tg + 1u) * nx) xb_add(&bar[XB_TOPGEN], 1u);
            else XB_SPIN(xb_ld(&bar[XB_TOPGEN]) == tg, bar);
            __builtin_amdgcn_fence(__ATOMIC_ACQUIRE, "agent");
            xb_add(&bar[XB_XGEN(b.x)], 1u);
            asm volatile("s_waitcnt vmcnt(0)" ::: "memory");
        } else {
            XB_SPIN(xb_ld(&bar[XB_XGEN(b.x)]) == gen, bar);
            __builtin_amdgcn_fence(__ATOMIC_ACQUIRE, "agent");
            asm volatile("s_waitcnt vmcnt(0)" ::: "memory");
        }
    }
    __syncthreads();
}

namespace pg8 {
constexpr int BM = 256, BK = 64, HALF = 128, HTB = HALF * BK * 2, STAGE_BYTES = 8 * HTB, NXCD = 8, WGM = 8;
__host__ __device__ __forceinline__ int lds_byte(int r, int c) { const int st = (r >> 4) * 2 + (c >> 5), rr = r & 15, cc = c & 31, ob = rr * 64 + cc * 2; return st * 1024 + (ob ^ (((ob >> 9) & 1) << 5)); }
__host__ __device__ __forceinline__ void stage_rc(int b, int& R, int& C) { const int st = b / 1024, sb = b % 1024, swz = sb ^ (((sb >> 9) & 1) << 5); R = (st >> 1) * 16 + swz / 64; C = (st & 1) * 32 + (swz % 64) / 2; }
__host__ __device__ __forceinline__ int perm32(int rho) { const int n = rho >> 4, i = rho & 15; return 8 * (i >> 2) + 4 * n + (i & 3); }
__device__ __forceinline__ size_t img_off(int row, int kb, int RB) {
    return (size_t)(row >> 8) * ((size_t)256 * RB) + (size_t)(kb >> 7) * 32768 + (size_t)(((row >> 7) & 1) * 16384 + lds_byte(row & 127, (kb & 127) >> 1));
}
__device__ __forceinline__ int wslot(int n) { const int w = n & 31; return (n & ~31) + 16 * ((w >> 2) & 1) + 4 * (w >> 3) + (w & 3); }

__device__ __forceinline__ f32x4 tof(const f32x4 v) { return v; }
__device__ __forceinline__ f32x4 tof(const i32x4 v) { return __builtin_convertvector(v, f32x4); }
__device__ __forceinline__ unsigned cvt_pk_bf16(float lo, float hi) { unsigned r; asm volatile("v_cvt_pk_bf16_f32 %0, %1, %2" : "=v"(r) : "v"(lo), "v"(hi)); return r; }

struct GUnit { const char* A; const char* B; int pm, pn, aux; };
__device__ __forceinline__ void static_map(int L, int nM, int nN, int& pm, int& pn) {
    const int nwg = nM * nN; int wgid = L;
    { const int q = nwg / NXCD, r = nwg % NXCD, xcd = wgid % NXCD, off = wgid / NXCD; wgid = (xcd < r ? xcd * (q + 1) : r * (q + 1) + (xcd - r) * q) + off; }
    const int nig = WGM * nN, gid = wgid / nig, fm = gid * WGM, gsz = (nM - fm) < WGM ? (nM - fm) : WGM;
    pm = fm + ((wgid % nig) % gsz); pn = (wgid % nig) / gsz;
}

typedef int v8i __attribute__((ext_vector_type(8)));
__device__ __forceinline__ v8i cat8(const bf16x8 a, const bf16x8 b) { const v4u x = __builtin_bit_cast(v4u, a), y = __builtin_bit_cast(v4u, b); return (v8i){(int)x.x, (int)x.y, (int)x.z, (int)x.w, (int)y.x, (int)y.y, (int)y.z, (int)y.w}; }
template <int M_> struct AccSel { typedef f32x4 type; };
template <> struct AccSel<2> { typedef i32x4 type; };
template <int MODE, class Epi, class Sched>
__device__ __forceinline__ void gemm_phase(LAS unsigned char* lds, const int tid, const int RB, const Sched& S, const Epi& E) {
    constexpr bool FP8 = MODE == 1; typedef typename AccSel<MODE>::type AccT;
    const int wid = __builtin_amdgcn_readfirstlane(tid >> 6), lane = tid & 63, wr = wid >> 2, wc = wid & 3, fr = lane & 15, fq = lane >> 4;
    const int nt = RB / 128;
    unsigned voffA[2], voffB[2];
#pragma unroll
    for (int i = 0; i < 2; ++i) { voffA[i] = (unsigned)(tid * 16 + i * 8192); voffB[i] = voffA[i]; }
    const size_t kstep = (size_t)32768;
    const size_t hstep = (size_t)16384;
    const unsigned ldsw = (unsigned)wid * 1024u;
    const int aoff = lds_byte(wr * 64 + fr, fq * 8), boff = lds_byte(wc * 32 + fr, fq * 8);
#define PG8_SA(b, h) (((b) * 2 + (h)) * HTB)
#define PG8_SB(b, h) ((4 + (b) * 2 + (h)) * HTB)
#define PG8_STAGE(bufoff, gbase, voff) do { _Pragma("unroll") for (int _i = 0; _i < 2; ++_i) \
        __builtin_amdgcn_global_load_lds((const unsigned*)((const char*)(gbase) + (voff)[_i]), (LAS unsigned*)(lds + (bufoff) + ldsw + _i * 8192), 16, 0, 0); } while (0)
#define PG8_LD8(p) ({ const v4u lo_ = *(const LAS v4u*)(p), hi_ = *(const LAS v4u*)((p) + 1024); (v8i){(int)lo_.x, (int)lo_.y, (int)lo_.z, (int)lo_.w, (int)hi_.x, (int)hi_.y, (int)hi_.z, (int)hi_.w}; })
#define PG8_LDA(dst, b, h) do { _Pragma("unroll") for (int m = 0; m < 4; ++m) { if constexpr (FP8) dst##8[m] = PG8_LD8(lds + PG8_SA(b, h) + aoff + m * 2048); else { _Pragma("unroll") for (int k = 0; k < 2; ++k) dst[m][k] = *(const LAS bf16x8*)(lds + PG8_SA(b, h) + aoff + m * 2048 + k * 1024); } } } while (0)
#define PG8_LDB(dst, b, h) do { _Pragma("unroll") for (int n = 0; n < 2; ++n) { if constexpr (FP8) dst##8[n] = PG8_LD8(lds + PG8_SB(b, h) + boff + n * 2048); else { _Pragma("unroll") for (int k = 0; k < 2; ++k) dst[n][k] = *(const LAS bf16x8*)(lds + PG8_SB(b, h) + boff + n * 2048 + k * 1024); } } } while (0)
#define PG8_MMA(ai, bj, At, Bt) do { __builtin_amdgcn_s_setprio(1); _Pragma("unroll") for (int m = 0; m < 4; ++m) _Pragma("unroll") for (int n = 0; n < 2; ++n) { \
        if constexpr (FP8) asm volatile("v_mfma_scale_f32_16x16x128_f8f6f4 %0, %1, %2, %0, %3, %3 op_sel_hi:[0,0,0]" : "+v"(acc[ai][bj][m][n]) : "v"(Bt##8[n]), "v"(At##8[m]), "v"(scl1));   \
        else if constexpr (MODE == 2) { _Pragma("unroll") for (int k = 0; k < 2; ++k) acc[ai][bj][m][n] = __builtin_amdgcn_mfma_i32_16x16x64_i8(__builtin_bit_cast(i32x4, Bt[n][k]), __builtin_bit_cast(i32x4, At[m][k]), acc[ai][bj][m][n], 0, 0, 0); } \
        else { _Pragma("unroll") for (int k = 0; k < 2; ++k) acc[ai][bj][m][n] = __builtin_amdgcn_mfma_f32_16x16x32_bf16(Bt[n][k], At[m][k], acc[ai][bj][m][n], 0, 0, 0); } } __builtin_amdgcn_s_setprio(0); } while (0)
#define PG8_WAIT_V(n) asm volatile("s_waitcnt vmcnt(" #n ")" ::: "memory")
#define PG8_WAIT_L(n) asm volatile("s_waitcnt lgkmcnt(" #n ")" ::: "memory")
#define PG8_BAR __builtin_amdgcn_s_barrier()
#define PG8_SCHED __builtin_amdgcn_sched_barrier(0)
    GUnit cur, nxt; int ui = 0;
    if (!S.next(0, cur)) return;
    AccT acc[2][2][4][2];
#pragma unroll
    for (int a = 0; a < 2; ++a)
#pragma unroll
        for (int b = 0; b < 2; ++b)
#pragma unroll
            for (int m = 0; m < 4; ++m)
#pragma unroll
                for (int n = 0; n < 2; ++n) acc[a][b][m][n] = (AccT){0, 0, 0, 0};
    bf16x8 At[4][2], B0[2][2], B1[2][2]; v8i At8[4], B08[2], B18[2];
    const unsigned scl1 = 0x7f7f7f7fu;
    const char* cA = cur.A; const char* cB = cur.B;
    PG8_STAGE(PG8_SB(0, 0), cB, voffB); PG8_STAGE(PG8_SB(0, 1), cB + hstep, voffB); PG8_STAGE(PG8_SA(0, 0), cA, voffA); PG8_STAGE(PG8_SA(0, 1), cA + hstep, voffA);
    if (wr == 1) PG8_BAR;
    PG8_WAIT_V(2); PG8_BAR;
    PG8_STAGE(PG8_SB(1, 0), cB + kstep, voffB); PG8_STAGE(PG8_SA(1, 0), cA + kstep, voffA); PG8_STAGE(PG8_SB(1, 1), cB + hstep + kstep, voffB);
    PG8_WAIT_V(6); PG8_BAR;
    for (;;) {
        const bool has_next = S.next(ui + 1, nxt);
        const char* nA = has_next ? nxt.A : cA; const char* nB = has_next ? nxt.B : cB;
        for (int t = 0; t < nt; t += 2) {
            const bool last = (t == nt - 2);
            const char* a1 = cA + (size_t)(t + 1) * kstep;
            const char* a2 = last ? nA : cA + (size_t)(t + 2) * kstep; const char* b2 = last ? nB : cB + (size_t)(t + 2) * kstep;
            const char* a3 = a2 + kstep; const char* b3 = b2 + kstep;
            PG8_LDB(B0, 0, 0); PG8_LDB(B1, 0, 1); PG8_SCHED; PG8_LDA(At, 0, 0); PG8_STAGE(PG8_SA(1, 1), a1 + hstep, voffA);
            PG8_WAIT_V(8); PG8_WAIT_L(0); PG8_BAR; PG8_MMA(0, 0, At, B0); PG8_MMA(0, 1, At, B1); PG8_BAR; PG8_SCHED;
            PG8_LDA(At, 0, 1); PG8_STAGE(PG8_SB(0, 0), b2, voffB); PG8_STAGE(PG8_SB(0, 1), b2 + hstep, voffB); PG8_STAGE(PG8_SA(0, 0), a2, voffA);
            PG8_WAIT_V(8); PG8_WAIT_L(0); PG8_BAR; PG8_MMA(1, 0, At, B0); PG8_MMA(1, 1, At, B1); PG8_BAR; PG8_SCHED;
            PG8_LDB(B0, 1, 0); PG8_LDB(B1, 1, 1); PG8_SCHED; PG8_LDA(At, 1, 0); PG8_STAGE(PG8_SA(0, 1), a2 + hstep, voffA);
            PG8_WAIT_V(8); PG8_WAIT_L(0); PG8_BAR; PG8_MMA(0, 0, At, B0); PG8_MMA(0, 1, At, B1); PG8_BAR; PG8_SCHED;
            PG8_LDA(At, 1, 1); PG8_STAGE(PG8_SB(1, 0), b3, voffB); PG8_STAGE(PG8_SB(1, 1), b3 + hstep, voffB); PG8_STAGE(PG8_SA(1, 0), a3, voffA);
            PG8_WAIT_V(8); PG8_WAIT_L(0); PG8_BAR; PG8_MMA(1, 0, At, B0); PG8_MMA(1, 1, At, B1); PG8_BAR; PG8_SCHED;
        }
        if constexpr (FP8) asm volatile("s_nop 15\n\ts_nop 15" ::: "memory");
        if (wr == 0) PG8_BAR;
        E(acc, cur, wr, wc, fr, fq);
        if (!has_next) break;
#pragma unroll
        for (int a = 0; a < 2; ++a)
#pragma unroll
            for (int b = 0; b < 2; ++b)
#pragma unroll
                for (int m = 0; m < 4; ++m)
#pragma unroll
                    for (int n = 0; n < 2; ++n) acc[a][b][m][n] = (AccT){0, 0, 0, 0};
        cur = nxt; cA = nA; cB = nB; ++ui;
        if (wr == 1) PG8_BAR;
    }
    PG8_WAIT_V(0);
    PG8_BAR;
#undef PG8_SA
#undef PG8_SB
#undef PG8_STAGE
#undef PG8_LDA
#undef PG8_LDB
#undef PG8_MMA
#undef PG8_WAIT_V
#undef PG8_WAIT_L
#undef PG8_BAR
#undef PG8_SCHED
}

struct PlainSched {
    const char* A; const char* B; int nM, nN, G, c; size_t tstep;
    const char* A2; const char* B2; size_t a2stride, b2stride; int n2;
    __device__ __forceinline__ bool next(int i, GUnit& u) const {
        const int L = i * G + c, n1 = nM * nN;
        if (L < n1) { static_map(L, nM, nN, u.pm, u.pn); u.A = A + (size_t)u.pm * tstep; u.B = B + (size_t)u.pn * tstep; u.aux = 0; return true; }
        const int L2 = L - n1; if (L2 >= n2 * 32) return false;
        const int j = L2 >> 5, r = L2 & 31; u.pm = r & 7; u.pn = r >> 3; u.aux = 1 + j;
        u.A = A2 + (size_t)j * a2stride + (size_t)u.pm * tstep; u.B = B2 + (size_t)j * b2stride + (size_t)u.pn * tstep; return true;
    }
};
struct GroupSched {
    const char* A; const char* B; const int* tile_e; int nrt, nN, G, c; size_t tstep, estride;
    __device__ __forceinline__ bool next(int i, GUnit& u) const {
        const int L = i * G + c; if (L >= nrt * nN) return false;
        static_map(L, nrt, nN, u.pm, u.pn);
        const int e = tile_e ? tile_e[u.pm] : 0; u.aux = e;
        u.A = A + (size_t)u.pm * tstep; u.B = B + (size_t)e * estride + (size_t)u.pn * tstep; return true;
    }
};

struct EpiProj {
    bf16* proj; bf16* kvm0; size_t kvm_stride; const float* rowscale; float cscale;
    template <class AccT> __device__ __forceinline__ void operator()(const AccT (&acc)[2][2][4][2], const GUnit& u, int wr, int wc, int fr, int fq) const {
        bf16* base = u.aux == 0 ? proj : kvm0 + (size_t)(u.aux - 1) * kvm_stride; const int ldc = u.aux == 0 ? NPROJ : 1024;
        const int row0 = u.pm * BM + wr * 64 + fr, col0 = u.pn * BM + wc * 32 + 8 * fq;
        float rs[2][4];
#pragma unroll
        for (int ai = 0; ai < 2; ++ai)
#pragma unroll
            for (int m = 0; m < 4; ++m) rs[ai][m] = rowscale ? rowscale[row0 + ai * HALF + m * 16] * cscale : 1.0f;
        __builtin_amdgcn_sched_barrier(0);
#pragma unroll
        for (int ai = 0; ai < 2; ++ai)
#pragma unroll
            for (int m = 0; m < 4; ++m) { const int row = row0 + ai * HALF + m * 16; bf16* rowp = base + (size_t)row * ldc + col0;
#pragma unroll
                for (int bj = 0; bj < 2; ++bj) { const f32x4 v0 = tof(acc[ai][bj][m][0]) * rs[ai][m], v1 = tof(acc[ai][bj][m][1]) * rs[ai][m];
                    v4u w; w.x = cvt_pk_bf16(v0[0], v0[1]); w.y = cvt_pk_bf16(v0[2], v0[3]); w.z = cvt_pk_bf16(v1[0], v1[1]); w.w = cvt_pk_bf16(v1[2], v1[3]);
                    *(v4u*)(rowp + bj * HALF) = w; } }
    }
};
struct EpiRes {
    const void* res; int res_bf16; bf16* out; const float* rowscale; float cscale;
    template <class AccT> __device__ __forceinline__ void operator()(const AccT (&acc)[2][2][4][2], const GUnit& u, int wr, int wc, int fr, int fq) const {
        const int row0 = u.pm * BM + wr * 64 + fr, col0 = u.pn * BM + wc * 32 + 8 * fq;
#pragma unroll
        for (int ai = 0; ai < 2; ++ai) {
            f32x4 rr[4][2][2]; float rs[4];
#pragma unroll
            for (int m = 0; m < 4; ++m) { const size_t off = (size_t)(row0 + ai * HALF + m * 16) * D + col0; rs[m] = rowscale ? rowscale[row0 + ai * HALF + m * 16] * cscale : 1.0f;
#pragma unroll
                for (int bj = 0; bj < 2; ++bj) { if (res_bf16) { rr[m][bj][0] = __builtin_bit_cast(f32x4, *(const v4u*)((const bf16*)res + off + bj * HALF)); rr[m][bj][1] = rr[m][bj][0]; }
                    else { rr[m][bj][0] = *(const f32x4*)((const float*)res + off + bj * HALF); rr[m][bj][1] = *(const f32x4*)((const float*)res + off + bj * HALF + 4); } } }
            __builtin_amdgcn_sched_barrier(0);
#pragma unroll
            for (int m = 0; m < 4; ++m) { const size_t off = (size_t)(row0 + ai * HALF + m * 16) * D + col0;
#pragma unroll
                for (int bj = 0; bj < 2; ++bj) { f32x4 a0, a1;
                    if (res_bf16) { const v4u w = __builtin_bit_cast(v4u, rr[m][bj][0]); a0 = (f32x4){bflo(w.x), bfhi(w.x), bflo(w.y), bfhi(w.y)}; a1 = (f32x4){bflo(w.z), bfhi(w.z), bflo(w.w), bfhi(w.w)}; } else { a0 = rr[m][bj][0]; a1 = rr[m][bj][1]; }
                    const f32x4 v0 = a0 + tof(acc[ai][bj][m][0]) * rs[m], v1 = a1 + tof(acc[ai][bj][m][1]) * rs[m];
                    v4u w; w.x = cvt_pk_bf16(v0[0], v0[1]); w.y = cvt_pk_bf16(v0[2], v0[3]); w.z = cvt_pk_bf16(v1[0], v1[1]); w.w = cvt_pk_bf16(v1[2], v1[3]);
                    *(v4u*)(out + off + bj * HALF) = w; } }
            __builtin_amdgcn_sched_barrier(0);
        }
    }
};
struct EpiSwiglu {
    bf16* act; int ldc; float inscale; int fp8out; const float* rowscale;
    template <class AccT> __device__ __forceinline__ void operator()(const AccT (&acc)[2][2][4][2], const GUnit& u, int wr, int wc, int fr, int fq) const {
        const int row0 = u.pm * BM + wr * 64 + fr, col0 = u.pn * HALF + wc * 32 + 8 * fq;
        float rsv[2][4];
#pragma unroll
        for (int ai = 0; ai < 2; ++ai)
#pragma unroll
            for (int m = 0; m < 4; ++m) rsv[ai][m] = rowscale ? rowscale[row0 + ai * HALF + m * 16] * inscale : inscale;
        __builtin_amdgcn_sched_barrier(0);
#pragma unroll
        for (int ai = 0; ai < 2; ++ai)
#pragma unroll
            for (int m = 0; m < 4; ++m) { float o[8]; const float rs = rsv[ai][m];
#pragma unroll
                for (int n = 0; n < 2; ++n)
#pragma unroll
                    for (int j = 0; j < 4; ++j) { const float g = (float)acc[ai][0][m][n][j] * rs, up = (float)acc[ai][1][m][n][j] * rs; o[4 * n + j] = g * up * __builtin_amdgcn_rcpf(1.0f + __expf(-g)); }
                if (fp8out) {
#pragma unroll
                    for (int j = 0; j < 8; ++j) o[j] = fminf(fmaxf(o[j] * 8.0f, -448.0f), 448.0f);
                    unsigned w0 = 0, w1 = 0; w0 = __builtin_amdgcn_cvt_pk_fp8_f32(o[0], o[1], w0, false); w0 = __builtin_amdgcn_cvt_pk_fp8_f32(o[2], o[3], w0, true);
                    w1 = __builtin_amdgcn_cvt_pk_fp8_f32(o[4], o[5], w1, false); w1 = __builtin_amdgcn_cvt_pk_fp8_f32(o[6], o[7], w1, true);
                    *(v2u*)((unsigned char*)act + img_off(row0 + ai * HALF + m * 16, col0, ldc)) = (v2u){w0, w1};
                } else {
                v4u w; w.x = cvt_pk_bf16(o[0], o[1]); w.y = cvt_pk_bf16(o[2], o[3]); w.z = cvt_pk_bf16(o[4], o[5]); w.w = cvt_pk_bf16(o[6], o[7]);
                *(v4u*)((unsigned char*)act + img_off(row0 + ai * HALF + m * 16, col0 * 2, ldc * 2)) = w; } }
    }
};
struct EpiDown {
    const bf16* res; bf16* out; bf16* Y; const float* rowgate; int moe;
    template <class AccT> __device__ __forceinline__ void operator()(const AccT (&acc)[2][2][4][2], const GUnit& u, int wr, int wc, int fr, int fq) const {
        const int row0 = u.pm * BM + wr * 64 + fr, col0 = u.pn * BM + wc * 32 + 8 * fq;
        if (!moe) {
#pragma unroll
            for (int ai = 0; ai < 2; ++ai) {
                v4u rw[4][2];
#pragma unroll
                for (int m = 0; m < 4; ++m)
#pragma unroll
                    for (int bj = 0; bj < 2; ++bj) rw[m][bj] = *(const v4u*)(res + (size_t)(row0 + ai * HALF + m * 16) * D + col0 + bj * HALF);
                __builtin_amdgcn_sched_barrier(0);
#pragma unroll
                for (int m = 0; m < 4; ++m) { const size_t off = (size_t)(row0 + ai * HALF + m * 16) * D + col0;
#pragma unroll
                    for (int bj = 0; bj < 2; ++bj) { const v4u w0 = rw[m][bj];
                        const f32x4 v0 = (f32x4){bflo(w0.x), bfhi(w0.x), bflo(w0.y), bfhi(w0.y)} + tof(acc[ai][bj][m][0]), v1 = (f32x4){bflo(w0.z), bfhi(w0.z), bflo(w0.w), bfhi(w0.w)} + tof(acc[ai][bj][m][1]);
                        v4u w; w.x = cvt_pk_bf16(v0[0], v0[1]); w.y = cvt_pk_bf16(v0[2], v0[3]); w.z = cvt_pk_bf16(v1[0], v1[1]); w.w = cvt_pk_bf16(v1[2], v1[3]);
                        *(v4u*)(out + off + bj * HALF) = w; } }
                __builtin_amdgcn_sched_barrier(0);
            }
        } else {
            float gv[2][4];
#pragma unroll
            for (int ai = 0; ai < 2; ++ai)
#pragma unroll
                for (int m = 0; m < 4; ++m) gv[ai][m] = rowgate[row0 + ai * HALF + m * 16] * (1.0f / 512.0f);
            __builtin_amdgcn_sched_barrier(0);
#pragma unroll
            for (int ai = 0; ai < 2; ++ai)
#pragma unroll
                for (int m = 0; m < 4; ++m) { const int row = row0 + ai * HALF + m * 16; const float g = gv[ai][m]; bf16* rowp = Y + (size_t)row * D + col0;
#pragma unroll
                    for (int bj = 0; bj < 2; ++bj) { const f32x4 v0 = tof(acc[ai][bj][m][0]) * g, v1 = tof(acc[ai][bj][m][1]) * g;
                        v4u w; w.x = cvt_pk_bf16(v0[0], v0[1]); w.y = cvt_pk_bf16(v0[2], v0[3]); w.z = cvt_pk_bf16(v1[0], v1[1]); w.w = cvt_pk_bf16(v1[2], v1[3]);
                        *(v4u*)(rowp + bj * HALF) = w; } }
        }
    }
};
}

using pg8::img_off; using pg8::wslot;
struct Args { const float* in[25]; float* out; unsigned char* ws; int step_lo, step_hi; int pad0, pad1; };
struct Frame {
    LAS unsigned char* lds; int tid, lane, wave, G, blk;
    const __attribute__((address_space(4))) Args* ap; GAS float* out; GAS unsigned char* ws;
};
#define KARGS() const __attribute__((address_space(4))) Args* ap_ = F.ap; asm volatile("" : "+s"(ap_))
#define IN(i) (ap_->in[i])
#define WSP ((unsigned char*)F.ws)
#define OUTP ((float*)F.out)
enum { I_X = 0, I_MEM, I_NMIXG, I_NMEMG, I_WIN, I_CONVW, I_ALOG, I_DTB, I_DNG, I_RNG, I_AQG, I_AKG, I_RELB, I_MQG, I_MKG, I_WMKV, I_WOUT, I_NFFG, I_FWG, I_FWU, I_FWD, I_RW, I_MWG, I_MWU, I_MWD };

__device__ __forceinline__ void p0_item(const float* W, int ldw, int K, int nblk, bf16* WT, int row_off, int mode, LAS float* scr, int item, int lane) {
    const int kb = item / nblk, nb = item % nblk, k0 = 64 * kb, n0 = 32 * nb;
    const int drow0 = mode == 0 ? row_off + n0 : ((n0 >> 7) * 256 + (mode - 1) * 128 + (n0 & 127));
    float tv[32];
#pragma unroll
    for (int i = 0; i < 32; ++i) { const int kk = 2 * i + (lane >> 5); tv[i] = __builtin_nontemporal_load(W + (size_t)(k0 + kk) * ldw + n0 + (lane & 31));   }
#pragma unroll
    for (int i = 0; i < 32; ++i) { const int kk = 2 * i + (lane >> 5); scr[kk * 33 + (lane & 31)] = tv[i]; }
    asm volatile("s_waitcnt lgkmcnt(0)" ::: "memory");
    const int c = lane & 7;
#pragma unroll
    for (int j = 0; j < 4; ++j) { const int n = (lane >> 3) + 8 * j; const LAS float* s = scr + (8 * c) * 33 + n;
        v4u o; o.x = pk2(s[0 * 33], s[1 * 33]); o.y = pk2(s[2 * 33], s[3 * 33]); o.z = pk2(s[4 * 33], s[5 * 33]); o.w = pk2(s[6 * 33], s[7 * 33]);
        *(v4u*)((unsigned char*)WT + img_off(wslot(drow0 + n), (k0 + 8 * c) * 2, K * 2)) = o; }
    asm volatile("s_waitcnt lgkmcnt(0)" ::: "memory");
}
__device__ __forceinline__ unsigned pk4_fp8(float a, float b, float c, float d) { unsigned w = 0; w = __builtin_amdgcn_cvt_pk_fp8_f32(a, b, w, false); w = __builtin_amdgcn_cvt_pk_fp8_f32(c, d, w, true); return w; }
__device__ __forceinline__ unsigned pk4_i8(float a, float b, float c, float d) {
    const int x = (int)rintf(fminf(fmaxf(a, -127.f), 127.f)), y = (int)rintf(fminf(fmaxf(b, -127.f), 127.f)), z = (int)rintf(fminf(fmaxf(c, -127.f), 127.f)), w = (int)rintf(fminf(fmaxf(d, -127.f), 127.f));
    return (unsigned)(x & 255) | ((unsigned)(y & 255) << 8) | ((unsigned)(z & 255) << 16) | ((unsigned)w << 24); }
__device__ __forceinline__ void p0_item8(const float* W, int ldw, int K, int nblk, unsigned char* WT, int row_off, int mode, int fmt, LAS float* scr, int item, int lane) {
    const int kb = item / nblk, nb = item % nblk, k0 = 64 * kb, n0 = 32 * nb;
    const int drow0 = mode == 0 ? row_off + n0 : ((n0 >> 7) * 256 + (mode - 1) * 128 + (n0 & 127));
    const float wsc = fmt == 1 ? 64.0f : SW_D;
    float tv[32];
#pragma unroll
    for (int i = 0; i < 32; ++i) { const int kk = 2 * i + (lane >> 5); tv[i] = __builtin_nontemporal_load(W + (size_t)(k0 + kk) * ldw + n0 + (lane & 31));   }
#pragma unroll
    for (int i = 0; i < 32; ++i) { const int kk = 2 * i + (lane >> 5); scr[kk * 33 + (lane & 31)] = tv[i] * wsc; }
    asm volatile("s_waitcnt lgkmcnt(0)" ::: "memory");
    const int c = lane & 7;
#pragma unroll
    for (int j = 0; j < 4; ++j) { const int n = (lane >> 3) + 8 * j; const LAS float* s = scr + (8 * c) * 33 + n;
        v2u o; if (fmt == 1) { o.x = pk4_fp8(s[0 * 33], s[1 * 33], s[2 * 33], s[3 * 33]); o.y = pk4_fp8(s[4 * 33], s[5 * 33], s[6 * 33], s[7 * 33]); }
        else { o.x = pk4_i8(s[0 * 33], s[1 * 33], s[2 * 33], s[3 * 33]); o.y = pk4_i8(s[4 * 33], s[5 * 33], s[6 * 33], s[7 * 33]); }
        *(v2u*)(WT + img_off(wslot(drow0 + n), k0 + 8 * c, K)) = o; }
    asm volatile("s_waitcnt lgkmcnt(0)" ::: "memory");
}
__device__ __forceinline__ void phase_p0(Frame& F) {
    KARGS();
    LAS float* scr = (LAS float*)(F.lds + F.wave * 16384);
    const int gw = F.blk * NWAVES + F.wave, NGW = F.G * NWAVES;
    constexpr int I_MOE1 = 32 * 224, I_MOE = 3 * I_MOE1;
    constexpr int N_MOE = NE * I_MOE;
    constexpr int I_L = 2048 + 4096 + 1024 + 2048;
    constexpr int I_FF = 32 * 176;
    constexpr int NITEMS = N_MOE + 2 * I_L + 3 * I_FF;
    for (int it = gw; it < NITEMS; it += NGW) {
        int r = it;
        if (r < N_MOE) { const int e = r / I_MOE, q = r % I_MOE, which = q / I_MOE1, idx = q % I_MOE1;
            if (which < 2) p0_item8((which == 0 ? IN(I_MWG) : IN(I_MWU)) + (size_t)e * D * DFFE, DFFE, D, DFFE / 32, WSP + WS_MGU + (size_t)e * 2 * DFFE * D, 0, 1 + which, 2, scr, idx, F.lane);
            else p0_item8(IN(I_MWD) + (size_t)e * DFFE * D, D, DFFE, D / 32, WSP + WS_MDN + (size_t)e * D * DFFE, 0, 0, 1, scr, idx, F.lane);
            continue; }
        r -= N_MOE;
        if (r < 2 * I_L) { const int l = r / I_L; int q = r % I_L;
            const float* win = IN(I_WIN) + (size_t)l * D * DIN; unsigned char* wint = WSP + WS_WIN + (size_t)l * NPROJ * D;
#if W_IN_I8
            if (q < 2048) { p0_item8(win, DIN, D, 64, wint, 0, 0, 2, scr, q, F.lane); continue; } q -= 2048;
            if (q < 4096) { p0_item8(win + 2056, DIN, D, 128, wint, 2048, 0, 2, scr, q, F.lane); continue; } q -= 4096;
#else
            if (q < 2048) { p0_item(win, DIN, D, 64, (bf16*)(WSP + WS_WIN) + (size_t)l * NPROJ * D, 0, 0, scr, q, F.lane); continue; } q -= 2048;
            if (q < 4096) { p0_item(win + 2056, DIN, D, 128, (bf16*)(WSP + WS_WIN) + (size_t)l * NPROJ * D, 2048, 0, scr, q, F.lane); continue; } q -= 4096;
#endif
            if (q < 1024) { p0_item(IN(I_WMKV) + (size_t)l * D * 1024, 1024, D, 32, (bf16*)(WSP + WS_WMKV) + (size_t)l * 1024 * D, 0, 0, scr, q, F.lane); continue; } q -= 1024;
            p0_item(IN(I_WOUT) + (size_t)l * D * D, D, D, 64, (bf16*)(WSP + WS_WOUT) + (size_t)l * D * D, 0, 0, scr, q, F.lane); continue; }
        r -= 2 * I_L;
        if (r < I_FF) { p0_item8(IN(I_FWG), DFF, D, DFF / 32, WSP + WS_WGU, 0, 1, 2, scr, r, F.lane); continue; } r -= I_FF;
        if (r < I_FF) { p0_item8(IN(I_FWU), DFF, D, DFF / 32, WSP + WS_WGU, 0, 2, 2, scr, r, F.lane); continue; } r -= I_FF;
        p0_item(IN(I_FWD), D, DFF, D / 32, (bf16*)(WSP + WS_WDN), 0, 0, scr, r, F.lane);
    }
    { float* rc = (float*)(WSP + MS_ROPE); float* rs = rc + SEQ * 64;
      for (int idx = F.blk * NTHREADS + F.tid; idx < SEQ * 64; idx += F.G * NTHREADS) { const int pos = idx >> 6, i = idx & 63;
          const double inv = exp(-(double)i * (9.210340371976184 / 64.0)); const double ang = (double)pos * inv; rc[idx] = (float)cos(ang); rs[idx] = (float)sin(ang); } }
    for (int m = gw; m < 2 * MROWS; m += NGW) { const int l = m / MROWS, row = m % MROWS;
        const f32x4* xr = (const f32x4*)(IN(I_MEM) + (size_t)row * D) + F.lane; const f32x4* gr = (const f32x4*)(IN(I_NMEMG) + (size_t)l * D) + F.lane;
        f32x4 v[8]; float ss = 0.f;
#pragma unroll
        for (int j = 0; j < 8; ++j) { v[j] = xr[64 * j]; ss += (v[j].x * v[j].x + v[j].y * v[j].y) + (v[j].z * v[j].z + v[j].w * v[j].w); }
        const float r = rsqrtf(wave_sum(ss) * (1.0f / D) + EPS);
        unsigned char* o = WSP + MS_MEMH + (size_t)l * MROWS * D * 2;
#pragma unroll
        for (int j = 0; j < 8; ++j) { const f32x4 g = gr[64 * j]; v2u w; w.x = pk2(v[j].x * r * g.x, v[j].y * r * g.y); w.y = pk2(v[j].z * r * g.z, v[j].w * r * g.w); *(v2u*)(o + img_off(row, 512 * j + 8 * F.lane, D * 2)) = w; }
    }
}

__device__ __forceinline__ void phase_rmsnorm(Frame& F, const void* x, int xbf, const float* gain, bf16* out, int mode, int l, int bi, int nb) {
    KARGS();
    LAS float* w8 = (LAS float*)F.lds;
    LAS int* lcnt = (LAS int*)(F.lds + 65536);
    if (mode != 0) {
        for (int idx = F.tid; idx < D * 8; idx += NTHREADS) { const int d = idx >> 3, e = idx & 7;
            w8[e * D + d] = mode == 1 ? IN(I_WIN)[(size_t)l * D * DIN + (size_t)d * DIN + 2048 + e] : IN(I_RW)[d * 8 + e]; }
        if (F.tid < 8) lcnt[F.tid] = 0;
        __syncthreads();
    }
    const int rpb = (T + nb - 1) / nb, row_lo = bi * rpb, nrows = row_lo + rpb <= T ? rpb : (T - row_lo > 0 ? T - row_lo : 0);
    f32x4 g[8];
#pragma unroll
    for (int j = 0; j < 8; ++j) g[j] = ((const f32x4*)gain)[64 * j + F.lane];
    f32x4 nv[8];
#define RMS_LOADROW(rr) do { if (xbf) { const v2u* xr_ = (const v2u*)((const bf16*)x + (size_t)(rr) * D) + F.lane; \
        _Pragma("unroll") for (int j = 0; j < 8; ++j) { const v2u w_ = xr_[64 * j]; nv[j] = (f32x4){bflo(w_.x), bfhi(w_.x), bflo(w_.y), bfhi(w_.y)}; } } \
      else { const f32x4* xr_ = (const f32x4*)((const float*)x + (size_t)(rr) * D) + F.lane; _Pragma("unroll") for (int j = 0; j < 8; ++j) nv[j] = xr_[64 * j]; } } while (0)
    if (F.wave < nrows) RMS_LOADROW(row_lo + F.wave);
    for (int rl = F.wave; rl < nrows; rl += NWAVES) {
        const int row = row_lo + rl;
        f32x4 v[8]; float ss = 0.f;
#pragma unroll
        for (int j = 0; j < 8; ++j) { v[j] = nv[j]; ss += (v[j].x * v[j].x + v[j].y * v[j].y) + (v[j].z * v[j].z + v[j].w * v[j].w); }
        { const int rn = rl + NWAVES < nrows ? row + NWAVES : row; RMS_LOADROW(rn); }
        const float r = rsqrtf(wave_sum(ss) * (1.0f / D) + EPS);
        float amax = 0.f;
#pragma unroll
        for (int j = 0; j < 8; ++j) { v[j] = v[j] * r * g[j]; amax = fmaxf(amax, fmaxf(fmaxf(fabsf(v[j].x), fabsf(v[j].y)), fmaxf(fabsf(v[j].z), fabsf(v[j].w)))); }
        if (!W_IN_I8 && mode == 1) {
#pragma unroll
            for (int j = 0; j < 8; ++j) { v2u w; w.x = pk2(v[j].x, v[j].y); w.y = pk2(v[j].z, v[j].w); *(v2u*)((unsigned char*)out + img_off(row, 512 * j + 8 * F.lane, D * 2)) = w; }
        } else {
        amax = wave_max(amax); const float qs = amax > 0.f ? 127.0f / amax : 0.f;
        if (F.lane == 0) ((float*)(WSP + MS_SA))[row] = amax * (1.0f / 127.0f);
#pragma unroll
        for (int j = 0; j < 8; ++j) *(unsigned*)((unsigned char*)out + img_off(row, 256 * j + 4 * F.lane, D)) = pk4_i8(v[j].x * qs, v[j].y * qs, v[j].z * qs, v[j].w * qs);
        }
        if (mode != 0) {
            float myval = 0.f;
#pragma unroll 1
            for (int e = 0; e < 8; ++e) { float s = 0.f;
#pragma unroll
                for (int j = 0; j < 8; ++j) { const f32x4 w = *(const LAS f32x4*)(w8 + e * D + 256 * j + 4 * F.lane); s += (v[j].x * w.x + v[j].y * w.y) + (v[j].z * w.z + v[j].w * w.w); }
                s = wave_sum(s); if (F.lane == e) myval = s; }
            if (mode == 1) {
                if (F.lane < 8) { float res;
                    if (F.lane < 4) { const float a = IN(I_ALOG)[l * NH + F.lane], db = IN(I_DTB)[l * NH + F.lane]; const float z = myval + db; const float sp = z > 20.f ? z : log1pf(expf(z)); res = -expf(a) * sp; }
                    else res = 1.0f / (1.0f + expf(-myval));
                    ((float*)(WSP + MS_GATES))[(size_t)row * 8 + F.lane] = res; }
            } else {
                float dt[8];
#pragma unroll
                for (int e = 0; e < 8; ++e) dt[e] = __shfl(myval, e);
                int e0 = 0; float l0 = dt[0];
#pragma unroll
                for (int e = 1; e < 8; ++e) if (dt[e] > l0) { l0 = dt[e]; e0 = e; }
                int e1 = -1; float l1 = -3.0e38f;
#pragma unroll
                for (int e = 0; e < 8; ++e) if (e != e0 && dt[e] > l1) { l1 = dt[e]; e1 = e; }
                if (F.lane == 0) { const float ex = expf(l1 - l0); const float g0 = 1.0f / (1.0f + ex), g1 = ex / (1.0f + ex);
                    ((int*)(WSP + MS_TOPE))[row * 2] = e0; ((int*)(WSP + MS_TOPE))[row * 2 + 1] = e1;
                    ((float*)(WSP + MS_TOPG))[row * 2] = g0; ((float*)(WSP + MS_TOPG))[row * 2 + 1] = g1;
                    __hip_atomic_fetch_add(&lcnt[e0], 1, __ATOMIC_RELAXED, __HIP_MEMORY_SCOPE_WORKGROUP); __hip_atomic_fetch_add(&lcnt[e1], 1, __ATOMIC_RELAXED, __HIP_MEMORY_SCOPE_WORKGROUP); }
            }
        }
    }
    if (mode == 2) { __syncthreads(); if (F.tid < 8) ((int*)(WSP + MS_CNT))[F.blk * 8 + F.tid] = lcnt[F.tid]; }
    __syncthreads();
}

__device__ __forceinline__ void phase_prep(Frame& F, int l) {
    KARGS();
    bf16* proj = (bf16*)(WSP + SC_PROJ); bf16* conva = (bf16*)(WSP + SC_CONVA); bf16* kvm = (bf16*)(WSP + MS_KVM) + (size_t)l * MROWS * 1024;
    const float* convw = IN(I_CONVW) + (size_t)l * 4 * 1536;
    const float* rc = (const float*)(WSP + MS_ROPE); const float* rs = rc + SEQ * 64;
    const int gw = F.blk * NWAVES + F.wave, NGW = F.G * NWAVES;
    const int lane = F.lane, li = lane & 15, d0 = li * 8;
    const float qscale = 0.08838834764831845f;
    LAS bf16* vt = (LAS bf16*)(F.lds + F.wave * 16896);
    for (int it = T * 8 + gw; it < T * 8 + MROWS + 1152; it += NGW) {
        if (it >= T * 8 + MROWS) {
            const int vi = it - (T * 8 + MROWS); const bf16* src; bf16* dst; int lds_;
            if (vi < 1024) { const int b = vi >> 7, h = (vi >> 5) & 3, c = vi & 31; src = proj + (size_t)(b * SEQ + c * CH) * NPROJ + C_VC + h * HD; lds_ = NPROJ; dst = (bf16*)(WSP + SC_VCT) + (size_t)vi * 8192; }
            else { const int mi = vi - 1024, b = mi >> 4, h = (mi >> 2) & 3, c = mi & 3; src = kvm + (size_t)(b * NMEM + c * CH) * 1024 + 512 + h * HD; lds_ = 1024; dst = (bf16*)(WSP + MS_VMT) + (size_t)mi * 8192; }
#pragma unroll 4
            for (int i = 0; i < 16; ++i) { const int row = 4 * i + (lane >> 4); const v4u w = *(const v4u*)(src + (size_t)row * lds_ + li * 8);
                LAS v2u* d = (LAS v2u*)(vt + row * 132 + li * 8); d[0] = (v2u){w.x, w.y}; d[1] = (v2u){w.z, w.w}; }
            asm volatile("s_waitcnt lgkmcnt(0)" ::: "memory");
            const int q4 = lane >> 4;
#pragma unroll 2
            for (int f = 0; f < 16; ++f) { const int mt8 = f >> 1, kt = f & 1; const LAS bf16* p = vt + (32 * kt + 4 * q4) * 132 + 16 * mt8 + li;
                v4u w; w.x = (unsigned)p[0] | ((unsigned)p[132] << 16); w.y = (unsigned)p[2 * 132] | ((unsigned)p[3 * 132] << 16);
                w.z = (unsigned)p[16 * 132] | ((unsigned)p[17 * 132] << 16); w.w = (unsigned)p[18 * 132] | ((unsigned)p[19 * 132] << 16);
                *(v4u*)(dst + (size_t)(f * 64 + lane) * 8) = w; }
            asm volatile("s_waitcnt lgkmcnt(0)" ::: "memory");
            continue; }
        if (it >= T * 8) {
            const int row = it - T * 8; bf16* p = kvm + (size_t)row * 1024 + lane * 8; float f[8]; unpack8(*(const v4u*)p, f);
            float ss = 0.f;
#pragma unroll
            for (int j = 0; j < 8; ++j) ss += f[j] * f[j];
            const float r = rsqrtf(grp16_sum(ss) * (1.0f / HD) + EPS); const float* gn = IN(I_MKG) + l * HD + d0;
#pragma unroll
            for (int j = 0; j < 8; ++j) f[j] = f[j] * r * gn[j];
            *(v4u*)p = pack8(f); continue; }
    }
    const int grp = gw & 7, tstart = gw >> 3, tstride = NGW >> 3;
    if (grp < 3) {
        const int c0 = grp * 512 + lane * 8; float w[4][8];
#pragma unroll
        for (int tap = 0; tap < 4; ++tap) { const f32x4 w0 = *(const f32x4*)(convw + tap * 1536 + c0), w1 = *(const f32x4*)(convw + tap * 1536 + c0 + 4);
            w[tap][0] = w0.x; w[tap][1] = w0.y; w[tap][2] = w0.z; w[tap][3] = w0.w; w[tap][4] = w1.x; w[tap][5] = w1.y; w[tap][6] = w1.z; w[tap][7] = w1.w; }
        for (int tb = tstart; tb < T; tb += 4 * tstride) {
            v4u xin[4][4];
#pragma unroll
            for (int u = 0; u < 4; ++u) { const int t = tb + u * tstride, pos = t & (SEQ - 1);
#pragma unroll
                for (int tap = 0; tap < 4; ++tap) { const int dp = pos - 3 + tap; const int tt = dp >= 0 ? t - 3 + tap : t;
                    xin[u][tap] = *(const v4u*)(proj + (size_t)tt * NPROJ + c0); } }
#pragma unroll
            for (int u = 0; u < 4; ++u) { const int t = tb + u * tstride, pos = t & (SEQ - 1); float a[8];
#pragma unroll
                for (int j = 0; j < 8; ++j) a[j] = 0.f;
#pragma unroll
                for (int tap = 0; tap < 4; ++tap) { float f[8]; unpack8(xin[u][tap], f); const float en = (pos - 3 + tap >= 0) ? 1.f : 0.f;
#pragma unroll
                    for (int j = 0; j < 8; ++j) a[j] += f[j] * (w[tap][j] * en); }
#pragma unroll
                for (int j = 0; j < 8; ++j) a[j] = silu_f(a[j]);
                if (grp < 2) { float ss = 0.f;
#pragma unroll
                    for (int j = 0; j < 8; ++j) ss += a[j] * a[j];
                    float r = rsqrtf(grp16_sum(ss) + EPS); if (grp == 0) r *= qscale;
#pragma unroll
                    for (int j = 0; j < 8; ++j) a[j] *= r; }
                *(v4u*)(conva + (size_t)t * 1536 + c0) = pack8(a); }
        }
    } else if (grp < 5) {
        const int i0 = (li & 7) * 8; const int col = (grp == 3 ? C_QB : C_KB) + lane * 8;
        for (int tb = tstart; tb < T; tb += 4 * tstride) {
            v4u xin[4]; f32x4 cs[4][4];
#pragma unroll
            for (int u = 0; u < 4; ++u) { const int t = tb + u * tstride, pos = t & (SEQ - 1); xin[u] = *(const v4u*)(proj + (size_t)t * NPROJ + col);
                cs[u][0] = *(const f32x4*)(rc + pos * 64 + i0); cs[u][1] = *(const f32x4*)(rc + pos * 64 + i0 + 4); cs[u][2] = *(const f32x4*)(rs + pos * 64 + i0); cs[u][3] = *(const f32x4*)(rs + pos * 64 + i0 + 4); }
#pragma unroll
            for (int u = 0; u < 4; ++u) { const int t = tb + u * tstride; float f[8], o[8]; unpack8(xin[u], f);
                const float c[8] = {cs[u][0].x, cs[u][0].y, cs[u][0].z, cs[u][0].w, cs[u][1].x, cs[u][1].y, cs[u][1].z, cs[u][1].w}, sn[8] = {cs[u][2].x, cs[u][2].y, cs[u][2].z, cs[u][2].w, cs[u][3].x, cs[u][3].y, cs[u][3].z, cs[u][3].w};
#pragma unroll
                for (int j = 0; j < 8; ++j) { const float other = __shfl_xor(f[j], 8); o[j] = li < 8 ? f[j] * c[j] - other * sn[j] : f[j] * c[j] + other * sn[j]; }
                if (grp == 4) {
#pragma unroll
                    for (int j = 0; j < 8; ++j) o[j] *= qscale; }
                *(v4u*)(proj + (size_t)t * NPROJ + col) = pack8(o); }
        }
    } else {
        const int col = (grp == 5 ? C_QC : (grp == 6 ? C_KC : C_QM)) + lane * 8; const float* gn = (grp == 5 ? IN(I_AQG) : (grp == 6 ? IN(I_AKG) : IN(I_MQG))) + l * HD + d0;
        float gv[8];
#pragma unroll
        for (int j = 0; j < 8; ++j) gv[j] = gn[j] * (grp != 6 ? qscale : 1.0f);
        for (int tb = tstart; tb < T; tb += 4 * tstride) {
            v4u xin[4];
#pragma unroll
            for (int u = 0; u < 4; ++u) xin[u] = *(const v4u*)(proj + (size_t)(tb + u * tstride) * NPROJ + col);
#pragma unroll
            for (int u = 0; u < 4; ++u) { float f[8]; unpack8(xin[u], f); float ss = 0.f;
#pragma unroll
                for (int j = 0; j < 8; ++j) ss += f[j] * f[j];
                const float r = rsqrtf(grp16_sum(ss) * (1.0f / HD) + EPS);
#pragma unroll
                for (int j = 0; j < 8; ++j) f[j] = f[j] * r * gv[j];
                *(v4u*)(proj + (size_t)(tb + u * tstride) * NPROJ + col) = pack8(f); }
        }
    }
}

__device__ __forceinline__ void phase_attn_naive(Frame& F, int l) {
    KARGS();
    const bf16* proj = (const bf16*)(WSP + SC_PROJ); const bf16* kvm = (const bf16*)(WSP + MS_KVM) + (size_t)l * MROWS * 1024; bf16* mix = (bf16*)(WSP + WS_HB);
    LAS float* sq = (LAS float*)F.lds + F.wave * 128;
    LAS float* sp = (LAS float*)(F.lds + 4096) + F.wave * 640;
    const float* relb = IN(I_RELB) + (size_t)l * NH * RELW;
    for (int u = F.blk; u < 2 * NB * NH * NCHUNK; u += F.G) {
        const int kind = u / (NB * NH * NCHUNK), r = u % (NB * NH * NCHUNK), b = r / (NH * NCHUNK), h = (r / NCHUNK) % NH, n = r % NCHUNK;
        const int c0 = kind == 0 ? (n - NPREV < 0 ? 0 : n - NPREV) : 0; const int nk = kind == 0 ? CH * (n - c0 + 1) : NMEM;
        const bf16* kb = kind == 0 ? proj + (size_t)(b * SEQ + c0 * CH) * NPROJ + C_KC + h * HD : kvm + (size_t)(b * NMEM) * 1024 + h * HD;
        const bf16* vb = kind == 0 ? proj + (size_t)(b * SEQ + c0 * CH) * NPROJ + C_VC + h * HD : kvm + (size_t)(b * NMEM) * 1024 + 512 + h * HD;
        const int ld = kind == 0 ? NPROJ : 1024;
        for (int qi = 0; qi < 8; ++qi) {
            const int ql = F.wave * 8 + qi, t = b * SEQ + n * CH + ql;
            const bf16* qp = proj + (size_t)t * NPROJ + (kind == 0 ? C_QC : C_QM) + h * HD;
            { const unsigned w = ((const unsigned*)qp)[F.lane]; sq[2 * F.lane] = bflo(w); sq[2 * F.lane + 1] = bfhi(w); }
            asm volatile("s_waitcnt lgkmcnt(0)" ::: "memory");
            float mx = -3.0e38f;
            for (int kk = F.lane; kk < nk; kk += 64) { const v4u* kr = (const v4u*)(kb + (size_t)kk * ld); float s = 0.f;
#pragma unroll
                for (int c = 0; c < 16; ++c) { float f[8]; unpack8(kr[c], f);
#pragma unroll
                    for (int j = 0; j < 8; ++j) s += f[j] * sq[c * 8 + j]; }
                if (kind == 0) { int rel = (n * CH + ql) - (c0 * CH + kk); rel = rel < -128 ? -128 : (rel > 128 ? 128 : rel); s += relb[h * RELW + rel + 128]; }
                sp[kk] = s; mx = fmaxf(mx, s); }
            mx = wave_max(mx); float sum = 0.f;
            for (int kk = F.lane; kk < nk; kk += 64) { const float p = __expf(sp[kk] - mx); sp[kk] = p; sum += p; }
            sum = wave_sum(sum); const float inv = 1.0f / sum;
            asm volatile("s_waitcnt lgkmcnt(0)" ::: "memory");
            float o0 = 0.f, o1 = 0.f;
            for (int kk = 0; kk < nk; ++kk) { const float p = sp[kk]; const unsigned w = *(const unsigned*)(vb + (size_t)kk * ld + 2 * F.lane); o0 += p * bflo(w); o1 += p * bfhi(w); }
            *(unsigned*)(mix + (size_t)t * D + (kind == 0 ? 1024 : 1536) + h * HD + 2 * F.lane) = pk2(o0 * inv, o1 * inv);
            asm volatile("s_waitcnt lgkmcnt(0)" ::: "memory");
        }
    }
}

__device__ __forceinline__ void phase_recur_naive(Frame& F, int l) {
    if (F.blk >= 2 * NB * NH) return;
    const int kind = F.blk / (NB * NH), b = (F.blk / NH) % NB, h = F.blk % NH;
    const bf16* proj = (const bf16*)(WSP + SC_PROJ); const bf16* conva = (const bf16*)(WSP + SC_CONVA); const float* gates = (const float*)(WSP + MS_GATES);
    float* obuf = (float*)(WSP + SC_OBUF);
    LAS float* sk = (LAS float*)F.lds; LAS float* sqv = sk + 128; LAS float* sv = sk + 256; LAS float* red = sk + 384; LAS float* red2 = sk + 896; LAS float* sab = sk + 1408;
    const int v = F.tid & 127, kg = F.tid >> 7;
    float s[32];
#pragma unroll
    for (int i = 0; i < 32; ++i) s[i] = 0.f;
    const float gam = 1.0f - exp2f(-5.0f - (float)h);
    const bf16* qb = kind == 0 ? conva + C_QA + h * HD : proj + C_QB + h * HD; const bf16* kb = kind == 0 ? conva + 512 + h * HD : proj + C_KB + h * HD; const bf16* vb = kind == 0 ? conva + 1024 + h * HD : proj + C_VB + h * HD;
    const int ld = kind == 0 ? 1536 : NPROJ;
    bf16 pk_ = 0, pq_ = 0, pv_ = 0; float pg_ = 0.f, pb_ = 0.f;
    { const int t = b * SEQ; if (F.tid < 128) { pk_ = kb[(size_t)t * ld + F.tid]; pq_ = qb[(size_t)t * ld + F.tid]; pv_ = vb[(size_t)t * ld + F.tid]; } if (kind == 0) { pg_ = gates[(size_t)t * 8 + h]; pb_ = gates[(size_t)t * 8 + 4 + h]; } }
    for (int tt = 0; tt < SEQ; ++tt) {
        const int t = b * SEQ + tt;
        if (F.tid < 128) { sk[F.tid] = bf2f(pk_); sqv[F.tid] = bf2f(pq_); sv[F.tid] = bf2f(pv_); }
        if (F.tid == 0) { if (kind == 0) { sab[0] = expf(pg_); sab[1] = pb_; } else { sab[0] = gam; sab[1] = 0.f; } }
        if (tt + 1 < SEQ) { const int t1 = t + 1; if (F.tid < 128) { pk_ = kb[(size_t)t1 * ld + F.tid]; pq_ = qb[(size_t)t1 * ld + F.tid]; pv_ = vb[(size_t)t1 * ld + F.tid]; } if (kind == 0) { pg_ = gates[(size_t)t1 * 8 + h]; pb_ = gates[(size_t)t1 * 8 + 4 + h]; } }
        __syncthreads();
        const float a = sab[0], bb = sab[1], bp = kind == 0 ? bb : 1.0f;
        float part = 0.f;
#pragma unroll
        for (int i = 0; i < 32; ++i) part += sk[kg * 32 + i] * s[i];
        red[kg * 128 + v] = part;
        __syncthreads();
        const float ks = (red[v] + red[128 + v]) + (red[256 + v] + red[384 + v]);
        const float dl = bp * sv[v] - a * bb * ks;
        float p2 = 0.f;
#pragma unroll
        for (int i = 0; i < 32; ++i) { s[i] = a * s[i] + sk[kg * 32 + i] * dl; p2 += sqv[kg * 32 + i] * s[i]; }
        red2[kg * 128 + v] = p2;
        __syncthreads();
        if (kg == 0) obuf[(size_t)t * 1024 + kind * 512 + h * HD + v] = (red2[v] + red2[128 + v]) + (red2[256 + v] + red2[384 + v]);
    }
}


template <int MT, int KS, int NTHR>
__device__ __forceinline__ void write_frags(const LAS bf16* X, int ldx, bf16* dst, int t0) {
    v2u lo[MT * KS * 64 / NTHR], hi[MT * KS * 64 / NTHR];
#pragma unroll
    for (int it = 0; it < MT * KS * 64 / NTHR; ++it) { const int idx = t0 + it * NTHR, ln = idx & 63, ks = (idx >> 6) % KS, mt = (idx >> 6) / KS, c16 = ln & 15, q4 = ln >> 4;
        const LAS bf16* p = X + (16 * mt + c16) * ldx + 32 * ks + 4 * q4; lo[it] = *(const LAS v2u*)p; hi[it] = *(const LAS v2u*)(p + 16); }
#pragma unroll
    for (int it = 0; it < MT * KS * 64 / NTHR; ++it) { const int idx = t0 + it * NTHR; *(v4u*)(dst + (size_t)idx * 8) = (v4u){lo[it].x, lo[it].y, hi[it].x, hi[it].y}; }
}
template <int I, int H> __device__ __forceinline__ void c1_load(f32x4 (&dst)[8], const LAS float* Lm) {
#pragma unroll
    for (int jj = 0; jj < 8; ++jj) { constexpr int dummy = 0; const int j4 = 8 * H + jj; if (j4 < (I + 3) / 4) dst[jj] = *(const LAS f32x4*)(Lm + I * 64 + 4 * j4); (void)dummy; }
}
template <int I, int H> __device__ __forceinline__ void c1_comp(const f32x4 (&src)[8], const float (&x)[64], float& a0, float& a1, float& a2, float& a3) {
#pragma unroll
    for (int jj = 0; jj < 8; ++jj) { const int j4 = 8 * H + jj; if (j4 < (I + 3) / 4) { const f32x4 lv = src[jj];
        if (4 * j4 + 0 < I) a0 += lv.x * x[4 * j4 + 0]; if (4 * j4 + 1 < I) a1 += lv.y * x[4 * j4 + 1]; if (4 * j4 + 2 < I) a2 += lv.z * x[4 * j4 + 2]; if (4 * j4 + 3 < I) a3 += lv.w * x[4 * j4 + 3]; } }
}
template <int I> struct C1Rows {
    static __device__ __forceinline__ void run(float (&x)[64], f32x4 (&la)[8], f32x4 (&lb)[8], const LAS float* Lm) {
        float a0 = 0.f, a1 = 0.f, a2 = 0.f, a3 = 0.f;
        c1_load<I, 1>(lb, Lm);
        __builtin_amdgcn_sched_barrier(0);
        c1_comp<I, 0>(la, x, a0, a1, a2, a3);
        __builtin_amdgcn_sched_barrier(0);
        if (I + 1 < 64) c1_load<(I + 1 < 64 ? I + 1 : 63), 0>(la, Lm);
        __builtin_amdgcn_sched_barrier(0);
        c1_comp<I, 1>(lb, x, a0, a1, a2, a3);
        x[I] = x[I] - ((a0 + a1) + (a2 + a3));
        __builtin_amdgcn_sched_barrier(0);
        C1Rows<I + 1>::run(x, la, lb, Lm);
    }
};
template <> struct C1Rows<64> { static __device__ __forceinline__ void run(float (&)[64], f32x4 (&)[8], f32x4 (&)[8], const LAS float*) {} };
constexpr int C1_HSZ = 77824;
__device__ __forceinline__ void phase_c1(Frame& F, int l) {
    const bf16* proj = (const bf16*)(WSP + SC_PROJ); const bf16* conva = (const bf16*)(WSP + SC_CONVA); const float* gates = (const float*)(WSP + MS_GATES);
    const int lane = F.lane, wave = F.wave, c16 = lane & 15, q4 = lane >> 4;
    const int hb = wave >> 2, lw = wave & 3, lt = F.tid & 255;
    LAS unsigned char* hl = F.lds + hb * C1_HSZ;
    LAS float* Lm = (LAS float*)hl; LAS float* Lm_u = Lm;
    LAS bf16* Xa = (LAS bf16*)(hl + 16384);
    LAS bf16* Xk = (LAS bf16*)(hl + 25088);
    LAS float* sgc = (LAS float*)(hl + 42496); LAS float* sbeta = sgc + 64; LAS float* seg = sgc + 128; LAS float* sbeta_u = sbeta; LAS float* seg_u = seg;
    LAS bf16* Xkr = (LAS bf16*)(hl + 43264);
    LAS bf16* Xw = Xkr;
    LAS bf16* Xv = (LAS bf16*)(hl + 60160);
    for (int u0 = F.blk; u0 < 2048; u0 += 2 * F.G) {
        const int uu = u0 + hb * F.G; const bool act = uu < 2048; const int u = act ? uu : 0;
        const int kind = u >> 10, r = u & 1023, b = r >> 7, h = (r >> 5) & 3, n = r & 31, t0 = b * SEQ + n * CH;
        const bf16* qb = kind == 0 ? conva + h * HD : proj + C_QB + h * HD; const bf16* kb = kind == 0 ? conva + 512 + h * HD : proj + C_KB + h * HD; const bf16* vb = kind == 0 ? conva + 1024 + h * HD : proj + C_VB + h * HD;
        const int ld = kind == 0 ? 1536 : NPROJ;
        unsigned char* rec = WSP + SC_PRE + (size_t)(kind * 1024 + (b * NH + h) * 32 + n) * REC_BYTES;
        bf16x8 qa[4];
        { const bf16* xq = qb + (size_t)(t0 + 16 * lw + c16) * ld + 8 * q4;
#pragma unroll
          for (int ks = 0; ks < 4; ++ks) qa[ks] = *(const bf16x8*)(xq + 32 * ks); }
        v4u qv[4], kv[4], vv[4];
        { const int row = lt >> 2, cb = (lt & 3) * 32; const size_t o = (size_t)(t0 + row) * ld + cb;
#pragma unroll
          for (int i = 0; i < 4; ++i) { qv[i] = *(const v4u*)(qb + o + 8 * i); kv[i] = *(const v4u*)(kb + o + 8 * i); vv[i] = *(const v4u*)(vb + o + 8 * i); } }
        if (lw == 0) { float g, be;
            if (kind == 0) { g = gates[(size_t)(t0 + lane) * 8 + h]; be = gates[(size_t)(t0 + lane) * 8 + 4 + h]; } else { g = log1pf(-exp2f(-5.0f - (float)h)); be = 1.0f; }
#pragma unroll
            for (int o = 1; o < 64; o <<= 1) { const float y = __shfl_up(g, o); if (lane >= o) g += y; }
            sgc[lane] = g; sbeta[lane] = be; seg[lane] = __expf(g);
            if (lane == 63 && act) ((float*)(WSP + MS_GTOT))[kind * 1024 + (b * NH + h) * 32 + n] = __expf(g); }
        __syncthreads();
        { const int row = lt >> 2, ksq = lt & 3, cb = ksq * 32; const float eq = seg[row], ek = __expf(sgc[63] - sgc[row]);
          float f[32];
#pragma unroll
          for (int i = 0; i < 4; ++i) { float t8[8]; unpack8(qv[i], t8);
#pragma unroll
              for (int j = 0; j < 8; ++j) f[8 * i + j] = t8[j] * eq; }
          if (act) { bf16* dq = (bf16*)(rec + REC_QF) + (size_t)((((row >> 4) * 4 + ksq) * 64) + (row & 15)) * 8;
#pragma unroll
              for (int qq = 0; qq < 4; ++qq) *(v4u*)(dq + (size_t)qq * 16 * 8) = (v4u){pk2(f[4 * qq], f[4 * qq + 1]), pk2(f[4 * qq + 2], f[4 * qq + 3]), pk2(f[16 + 4 * qq], f[16 + 4 * qq + 1]), pk2(f[16 + 4 * qq + 2], f[16 + 4 * qq + 3])}; }
          { LAS v2u* d = (LAS v2u*)(Xkr + row * 132 + cb);
#pragma unroll
            for (int i = 0; i < 4; ++i) { d[2 * i] = (v2u){kv[i].x, kv[i].y}; d[2 * i + 1] = (v2u){kv[i].z, kv[i].w}; } }
          { LAS v2u* d = (LAS v2u*)(Xv + row * 132 + cb);
#pragma unroll
            for (int i = 0; i < 4; ++i) { d[2 * i] = (v2u){vv[i].x, vv[i].y}; d[2 * i + 1] = (v2u){vv[i].z, vv[i].w}; } }
#pragma unroll
          for (int i = 0; i < 4; ++i) { float t8[8]; unpack8(kv[i], t8);
#pragma unroll
              for (int j = 0; j < 8; ++j) Xk[(cb + 8 * i + j) * 68 + row] = (bf16)f2bf(t8[j] * ek); } }
        __syncthreads();
        { const int mt = lw;
            bf16x8 bfr[16];
#pragma unroll
            for (int nt = 0; nt < 4; ++nt)
#pragma unroll
                for (int ks = 0; ks < 4; ++ks) { const LAS bf16* pb = Xkr + (16 * nt + c16) * 132 + 32 * ks + 8 * q4; const v2u lo = *(const LAS v2u*)pb, hi = *(const LAS v2u*)(pb + 4); bfr[nt * 4 + ks] = __builtin_bit_cast(bf16x8, (v4u){lo.x, lo.y, hi.x, hi.y}); }
#pragma unroll 1
            for (int mat = 0; mat < (kind == 0 ? 2 : 1); ++mat) {
                bf16x8 af[4];
                if (mat == 0) {
#pragma unroll
                    for (int ks = 0; ks < 4; ++ks) af[ks] = qa[ks];
                } else {
#pragma unroll
                    for (int ks = 0; ks < 4; ++ks) { const LAS bf16* pa = Xkr + (16 * mt + c16) * 132 + 32 * ks + 8 * q4; const v2u lo = *(const LAS v2u*)pa, hi = *(const LAS v2u*)(pa + 4); af[ks] = __builtin_bit_cast(bf16x8, (v4u){lo.x, lo.y, hi.x, hi.y}); } }
#pragma unroll
                for (int nt = 0; nt < 4; ++nt) { f32x4 acc = {0.f, 0.f, 0.f, 0.f};
#pragma unroll
                    for (int ks = 0; ks < 4; ++ks) acc = __builtin_amdgcn_mfma_f32_16x16x32_bf16(af[ks], bfr[nt * 4 + ks], acc, 0, 0, 0);
                    const int j = 16 * nt + c16; const float gj = sgc[j];
#pragma unroll
                    for (int rr = 0; rr < 4; ++rr) { const int i = 16 * mt + 4 * q4 + rr; const float dec = j <= i ? __expf(sgc[i] - gj) : 0.f;
                        if (mat == 0) Xa[i * 68 + j] = (bf16)f2bf(acc[rr] * dec); else Lm[i * 64 + j] = j < i ? acc[rr] * dec * sbeta[i] : 0.f; } } } }
        __syncthreads();
        if (act) { write_frags<4, 2, 256>(Xa, 68, (bf16*)(rec + REC_AF), lt); write_frags<8, 2, 256>(Xk, 68, (bf16*)(rec + REC_KF), lt); }
        { const int c = lt;
            int vz = 0; asm volatile("" : "+v"(vz));
            const LAS float* sbeta = sbeta_u + vz; const LAS float* seg = seg_u + vz; const LAS float* Lm = Lm_u + vz;
            if (kind == 0) { float x[64]; const LAS bf16* src = c < 128 ? Xv + c : Xkr + (c - 128);
#pragma unroll
                for (int i = 0; i < 64; ++i) { float rhs = bf2f(src[i * 132]) * sbeta[i]; if (c >= 128) rhs *= seg[i]; x[i] = rhs; }
                { f32x4 la[8], lb[8]; c1_load<1, 0>(la, Lm); C1Rows<1>::run(x, la, lb, Lm); }
                if (c < 128) { const int nt = c >> 4, cc = c & 15;
                    if (act) {
#pragma unroll
                    for (int mt = 0; mt < 4; ++mt)
#pragma unroll
                        for (int qq = 0; qq < 4; ++qq) *(f32x4*)(rec + REC_U + (size_t)(((nt * 4 + mt) * 64) + 16 * qq + cc) * 16) = (f32x4){x[16 * mt + 4 * qq], x[16 * mt + 4 * qq + 1], x[16 * mt + 4 * qq + 2], x[16 * mt + 4 * qq + 3]}; }
                } else {
#pragma unroll
                    for (int i = 0; i < 64; ++i) Xw[i * 132 + (c - 128)] = (bf16)f2bf(x[i]); }
            } else if (c < 128 && act) { const int nt = c >> 4, cc = c & 15;
#pragma unroll 1
                for (int i4 = 0; i4 < 16; ++i4) { const int mt = i4 >> 2, qq = i4 & 3; const LAS bf16* p = Xv + (4 * i4) * 132 + c;
                    *(f32x4*)(rec + REC_U + (size_t)(((nt * 4 + mt) * 64) + 16 * qq + cc) * 16) = (f32x4){bf2f(p[0]), bf2f(p[132]), bf2f(p[264]), bf2f(p[396])}; } }
        }
        __syncthreads();
        if (kind == 0 && act) write_frags<4, 4, 256>(Xw, 132, (bf16*)(rec + REC_WF), lt);
        __syncthreads();
    }
}
__device__ __forceinline__ bf16x8 pack_b(const f32x4 a, const f32x4 b) {
    v4u w; w.x = pg8::cvt_pk_bf16(a[0], a[1]); w.y = pg8::cvt_pk_bf16(a[2], a[3]); w.z = pg8::cvt_pk_bf16(b[0], b[1]); w.w = pg8::cvt_pk_bf16(b[2], b[3]); return __builtin_bit_cast(bf16x8, w); }
__device__ __forceinline__ void scan_dma(const unsigned char* rec, int pair, LAS unsigned char* buf, int wave, int lane) {
#pragma unroll
    for (int k = 0; k < 8; ++k) { const int i = wave * 8 + k;
        const unsigned char* src = i < 56 ? rec + i * 1024 : rec + REC_U + pair * 8192 + (i - 56) * 1024;
        __builtin_amdgcn_global_load_lds((const unsigned*)(src + lane * 16), (LAS unsigned*)(buf + i * 1024), 16, 0, 0); }
}
template <int BUF>
__device__ __forceinline__ void scan_step(LAS unsigned char* lds, f32x4 (&S)[8], const int kind, const float gt, float* op, const int wave, const int lane) {
    const LAS unsigned char* buf = lds + BUF * 65536;
    const LAS bf16x8* Qf = (const LAS bf16x8*)(buf + REC_QF) + lane; const LAS bf16x8* Kf = (const LAS bf16x8*)(buf + REC_KF) + lane;
    const LAS bf16x8* Af = (const LAS bf16x8*)(buf + REC_AF) + lane; const LAS bf16x8* Wf = (const LAS bf16x8*)(buf + REC_WF) + lane;
    const LAS f32x4* Uf = (const LAS f32x4*)(buf + 57344 + wave * 4096) + lane;
    bf16x8 Sb[4];
#pragma unroll
    for (int ks = 0; ks < 4; ++ks) Sb[ks] = pack_b(S[2 * ks], S[2 * ks + 1]);
    f32x4 vn[4]; bf16x8 fa[16], fb[8];
#pragma unroll
    for (int mt = 0; mt < 4; ++mt) vn[mt] = Uf[mt * 64];
    if (kind == 0) {
#pragma unroll
        for (int i = 0; i < 16; ++i) fa[i] = Wf[i * 64];
        __builtin_amdgcn_sched_barrier(0);
#pragma unroll
        for (int mt = 0; mt < 4; ++mt) { f32x4 acc = {0.f, 0.f, 0.f, 0.f};
#pragma unroll
            for (int ks = 0; ks < 4; ++ks) acc = __builtin_amdgcn_mfma_f32_16x16x32_bf16(fa[mt * 4 + ks], Sb[ks], acc, 0, 0, 0);
            vn[mt] = vn[mt] - acc; } }
#pragma unroll
    for (int i = 0; i < 16; ++i) fa[i] = Qf[i * 64];
#pragma unroll
    for (int i = 0; i < 8; ++i) fb[i] = Af[i * 64];
    __builtin_amdgcn_sched_barrier(0);
    bf16x8 Vb[2]; Vb[0] = pack_b(vn[0], vn[1]); Vb[1] = pack_b(vn[2], vn[3]);
    f32x4 o[4];
#pragma unroll
    for (int mt = 0; mt < 4; ++mt) { o[mt] = (f32x4){0.f, 0.f, 0.f, 0.f};
#pragma unroll
        for (int ks = 0; ks < 4; ++ks) o[mt] = __builtin_amdgcn_mfma_f32_16x16x32_bf16(fa[mt * 4 + ks], Sb[ks], o[mt], 0, 0, 0);
#pragma unroll
        for (int kt = 0; kt < 2; ++kt) o[mt] = __builtin_amdgcn_mfma_f32_16x16x32_bf16(fb[mt * 2 + kt], Vb[kt], o[mt], 0, 0, 0); }
    __builtin_amdgcn_sched_barrier(0);
#pragma unroll
    for (int i = 0; i < 16; ++i) fa[i] = Kf[i * 64];
#pragma unroll
    for (int mt = 0; mt < 4; ++mt) { float* p = op + (size_t)mt * 16 * 1024; p[0] = o[mt][0]; p[1024] = o[mt][1]; p[2048] = o[mt][2]; p[3072] = o[mt][3]; }
    __builtin_amdgcn_sched_barrier(0);
#pragma unroll
    for (int m8 = 0; m8 < 8; ++m8) { f32x4 a = S[m8] * gt;
#pragma unroll
        for (int kt = 0; kt < 2; ++kt) a = __builtin_amdgcn_mfma_f32_16x16x32_bf16(fa[m8 * 2 + kt], Vb[kt], a, 0, 0, 0);
        S[m8] = a; }
}
__device__ __forceinline__ void phase_scan(Frame& F, int l) {
    float* obuf = (float*)(WSP + SC_OBUF); const float* gtot = (const float*)(WSP + MS_GTOT);
    const int lane = F.lane, c16 = lane & 15, q4 = lane >> 4, wave = F.wave;
    for (int cb = F.blk; cb < 256; cb += F.G) {
        const int grp = (cb & 7) * 8 + (cb >> 5), pair = (cb >> 3) & 3, kind = grp >> 5, bh = grp & 31, b = bh >> 2, h = bh & 3, s8 = pair * 2 + wave;
        const unsigned char* rec0 = WSP + SC_PRE + (size_t)(kind * 1024 + bh * 32) * REC_BYTES;
        const float gtv = gtot[kind * 1024 + bh * 32 + (lane & 31)];
        float* op0 = obuf + (size_t)(b * SEQ + 4 * q4) * 1024 + kind * 512 + h * HD + 16 * s8 + c16;
        f32x4 S[8];
#pragma unroll
        for (int i = 0; i < 8; ++i) S[i] = (f32x4){0.f, 0.f, 0.f, 0.f};
        scan_dma(rec0, pair, F.lds, wave, lane);
#pragma unroll 1
        for (int n = 0; n < NCHUNK; n += 2) {
            asm volatile("s_waitcnt vmcnt(0)" ::: "memory"); __builtin_amdgcn_s_barrier(); asm volatile("" ::: "memory");
            scan_dma(rec0 + (size_t)(n + 1) * REC_BYTES, pair, F.lds + 65536, wave, lane);
            if (wave < 2) scan_step<0>(F.lds, S, kind, __shfl(gtv, n), op0 + (size_t)n * CH * 1024, wave, lane);
            asm volatile("s_waitcnt vmcnt(0)" ::: "memory"); __builtin_amdgcn_s_barrier(); asm volatile("" ::: "memory");
            if (n + 2 < NCHUNK) scan_dma(rec0 + (size_t)(n + 2) * REC_BYTES, pair, F.lds, wave, lane);
            if (wave < 2) scan_step<1>(F.lds, S, kind, __shfl(gtv, n + 1), op0 + (size_t)(n + 1) * CH * 1024, wave, lane);
        }
        asm volatile("s_waitcnt vmcnt(0) lgkmcnt(0)" ::: "memory"); __builtin_amdgcn_s_barrier(); asm volatile("" ::: "memory");
    }
}

__device__ __forceinline__ void scan_dma8(const unsigned char* rec, LAS unsigned char* buf, int wave, int lane) {
#pragma unroll
    for (int k = 0; k < 7; ++k) { const int i = wave * 7 + k;
        __builtin_amdgcn_global_load_lds((const unsigned*)(rec + i * 1024 + lane * 16), (LAS unsigned*)(buf + i * 1024), 16, 0, 0); }
}
template <int BUF>
__device__ __forceinline__ void scan_step8(LAS unsigned char* lds, f32x4 (&S)[8], f32x4 (&un)[4], const unsigned char* unext, const int kind, const float gt, float* op, const int lane) {
    const LAS unsigned char* buf = lds + BUF * 65536;
    const LAS bf16x8* Qf = (const LAS bf16x8*)(buf + REC_QF) + lane; const LAS bf16x8* Kf = (const LAS bf16x8*)(buf + REC_KF) + lane;
    const LAS bf16x8* Af = (const LAS bf16x8*)(buf + REC_AF) + lane; const LAS bf16x8* Wf = (const LAS bf16x8*)(buf + REC_WF) + lane;
    bf16x8 Sb[4];
#pragma unroll
    for (int ks = 0; ks < 4; ++ks) Sb[ks] = pack_b(S[2 * ks], S[2 * ks + 1]);
    f32x4 vn[4]; bf16x8 fa[16], fb[8];
#pragma unroll
    for (int mt = 0; mt < 4; ++mt) vn[mt] = un[mt];
    if (unext) {
#pragma unroll
        for (int mt = 0; mt < 4; ++mt) un[mt] = *(const f32x4*)(unext + mt * 1024); }
    if (kind == 0) {
#pragma unroll
        for (int i = 0; i < 16; ++i) fa[i] = Wf[i * 64];
        __builtin_amdgcn_sched_barrier(0);
#pragma unroll
        for (int mt = 0; mt < 4; ++mt) { f32x4 acc = {0.f, 0.f, 0.f, 0.f};
#pragma unroll
            for (int ks = 0; ks < 4; ++ks) acc = __builtin_amdgcn_mfma_f32_16x16x32_bf16(fa[mt * 4 + ks], Sb[ks], acc, 0, 0, 0);
            vn[mt] = vn[mt] - acc; } }
#pragma unroll
    for (int i = 0; i < 16; ++i) fa[i] = Qf[i * 64];
#pragma unroll
    for (int i = 0; i < 8; ++i) fb[i] = Af[i * 64];
    __builtin_amdgcn_sched_barrier(0);
    bf16x8 Vb[2]; Vb[0] = pack_b(vn[0], vn[1]); Vb[1] = pack_b(vn[2], vn[3]);
    f32x4 o[4];
#pragma unroll
    for (int mt = 0; mt < 4; ++mt) { o[mt] = (f32x4){0.f, 0.f, 0.f, 0.f};
#pragma unroll
        for (int ks = 0; ks < 4; ++ks) o[mt] = __builtin_amdgcn_mfma_f32_16x16x32_bf16(fa[mt * 4 + ks], Sb[ks], o[mt], 0, 0, 0);
#pragma unroll
        for (int kt = 0; kt < 2; ++kt) o[mt] = __builtin_amdgcn_mfma_f32_16x16x32_bf16(fb[mt * 2 + kt], Vb[kt], o[mt], 0, 0, 0); }
    __builtin_amdgcn_sched_barrier(0);
#pragma unroll
    for (int i = 0; i < 16; ++i) fa[i] = Kf[i * 64];
#pragma unroll
    for (int mt = 0; mt < 4; ++mt) { float* p = op + (size_t)mt * 16 * 1024; p[0] = o[mt][0]; p[1024] = o[mt][1]; p[2048] = o[mt][2]; p[3072] = o[mt][3]; }
    __builtin_amdgcn_sched_barrier(0);
#pragma unroll
    for (int m8 = 0; m8 < 8; ++m8) { f32x4 a = S[m8] * gt;
#pragma unroll
        for (int kt = 0; kt < 2; ++kt) a = __builtin_amdgcn_mfma_f32_16x16x32_bf16(fa[m8 * 2 + kt], Vb[kt], a, 0, 0, 0);
        S[m8] = a; }
}
__device__ __forceinline__ void phase_scan8(Frame& F, int l) {
    float* obuf = (float*)(WSP + SC_OBUF); const float* gtot = (const float*)(WSP + MS_GTOT);
    const int lane = F.lane, c16 = lane & 15, q4 = lane >> 4, wave = F.wave;
    const int grp = (F.blk & 7) * 8 + (F.blk >> 3), kind = grp >> 5, bh = grp & 31, b = bh >> 2, h = bh & 3;
    const unsigned char* rec0 = WSP + SC_PRE + (size_t)(kind * 1024 + bh * 32) * REC_BYTES;
    const float gtv = gtot[kind * 1024 + bh * 32 + (lane & 31)];
    float* op0 = obuf + (size_t)(b * SEQ + 4 * q4) * 1024 + kind * 512 + h * HD + 16 * wave + c16;
    const unsigned char* up = rec0 + REC_U + wave * 4096 + lane * 16;
    f32x4 S[8], ua[4];
#pragma unroll
    for (int i = 0; i < 8; ++i) S[i] = (f32x4){0.f, 0.f, 0.f, 0.f};
#pragma unroll
    for (int mt = 0; mt < 4; ++mt) ua[mt] = *(const f32x4*)(up + mt * 1024);
    scan_dma8(rec0, F.lds, wave, lane);
#pragma unroll 1
    for (int n = 0; n < NCHUNK; n += 2) {
        asm volatile("s_waitcnt vmcnt(0)" ::: "memory"); __builtin_amdgcn_s_barrier(); asm volatile("" ::: "memory");
        scan_dma8(rec0 + (size_t)(n + 1) * REC_BYTES, F.lds + 65536, wave, lane);
        scan_step8<0>(F.lds, S, ua, up + (size_t)(n + 1) * REC_BYTES, kind, __shfl(gtv, n), op0 + (size_t)n * CH * 1024, lane);
        asm volatile("s_waitcnt vmcnt(0)" ::: "memory"); __builtin_amdgcn_s_barrier(); asm volatile("" ::: "memory");
        if (n + 2 < NCHUNK) scan_dma8(rec0 + (size_t)(n + 2) * REC_BYTES, F.lds, wave, lane);
        scan_step8<1>(F.lds, S, ua, n + 2 < NCHUNK ? up + (size_t)(n + 2) * REC_BYTES : nullptr, kind, __shfl(gtv, n + 1), op0 + (size_t)(n + 1) * CH * 1024, lane);
    }
    asm volatile("s_waitcnt vmcnt(0) lgkmcnt(0)" ::: "memory"); __builtin_amdgcn_s_barrier(); asm volatile("" ::: "memory");
}

constexpr int AT_STAGE = 32768, AT_TB = 4 * AT_STAGE;
__device__ __forceinline__ void attn_dma(const bf16* ktile, const bf16* vtile, const unsigned (&koff)[2], const unsigned voff, LAS unsigned char* st, int wave) {
#pragma unroll
    for (int k = 0; k < 2; ++k) __builtin_amdgcn_global_load_lds((const unsigned*)((const char*)ktile + koff[k]), (LAS unsigned*)(st + (2 * wave + k) * 1024), 16, 0, 0);
#pragma unroll
    for (int k = 0; k < 2; ++k) __builtin_amdgcn_global_load_lds((const unsigned*)((const char*)vtile + voff + k * 1024), (LAS unsigned*)(st + 16384 + (2 * wave + k) * 1024), 16, 0, 0);
}
template <int STG>
__device__ __forceinline__ void attn_tile(LAS unsigned char* lds, const int (&kx)[4], const bf16x8 (&Qb)[4], f32x4 (&oacc)[8], float& m, float& lsum, const bool band, const int dn, const int rb0, const LAS float* tb, const int lane) {
    const LAS unsigned char* st = lds + STG * AT_STAGE;
    bf16x8 fr[16];
#pragma unroll
    for (int mt = 0; mt < 4; ++mt)
#pragma unroll
        for (int ks = 0; ks < 4; ++ks) fr[mt * 4 + ks] = *(const LAS bf16x8*)(st + mt * 4096 + kx[ks]);
    __builtin_amdgcn_sched_barrier(0);
    f32x4 sc[4];
#pragma unroll
    for (int mt = 0; mt < 4; ++mt) { sc[mt] = (f32x4){0.f, 0.f, 0.f, 0.f};
#pragma unroll
        for (int ks = 0; ks < 4; ++ks) sc[mt] = __builtin_amdgcn_mfma_f32_16x16x32_bf16(fr[mt * 4 + ks], Qb[ks], sc[mt], 0, 0, 0); }
    __builtin_amdgcn_sched_barrier(0);
#pragma unroll
    for (int i = 0; i < 16; ++i) fr[i] = *(const LAS bf16x8*)(st + 16384 + (i * 64 + lane) * 16);
    __builtin_amdgcn_sched_barrier(0);
    if (band) {
        if (dn >= 3) { const float bc = tb[256];
#pragma unroll
            for (int mt = 0; mt < 4; ++mt) sc[mt] = sc[mt] + bc; }
        else { const int rb = 64 * dn + rb0;
#pragma unroll
            for (int mt = 0; mt < 4; ++mt)
#pragma unroll
                for (int rr = 0; rr < 4; ++rr) { int idx = rb - 16 * mt - rr; idx = idx < 0 ? 0 : (idx > 256 ? 256 : idx); sc[mt][rr] += tb[idx]; } } }
    float mx = fmaxf(fmaxf(fmaxf(sc[0][0], sc[0][1]), fmaxf(sc[0][2], sc[0][3])), fmaxf(fmaxf(sc[1][0], sc[1][1]), fmaxf(sc[1][2], sc[1][3])));
    mx = fmaxf(mx, fmaxf(fmaxf(fmaxf(sc[2][0], sc[2][1]), fmaxf(sc[2][2], sc[2][3])), fmaxf(fmaxf(sc[3][0], sc[3][1]), fmaxf(sc[3][2], sc[3][3]))));
    mx = fmaxf(mx, __shfl_xor(mx, 16)); mx = fmaxf(mx, __shfl_xor(mx, 32));
    const float mn = fmaxf(m, mx), alpha = __expf(m - mn); m = mn;
    float ps = 0.f;
#pragma unroll
    for (int mt = 0; mt < 4; ++mt)
#pragma unroll
        for (int rr = 0; rr < 4; ++rr) { const float e = __expf(sc[mt][rr] - mn); sc[mt][rr] = e; ps += e; }
    lsum = lsum * alpha + ps;
#pragma unroll
    for (int i = 0; i < 8; ++i) oacc[i] = oacc[i] * alpha;
    bf16x8 Pb[2]; Pb[0] = pack_b(sc[0], sc[1]); Pb[1] = pack_b(sc[2], sc[3]);
#pragma unroll
    for (int m8 = 0; m8 < 8; ++m8)
#pragma unroll
        for (int kt = 0; kt < 2; ++kt) oacc[m8] = __builtin_amdgcn_mfma_f32_16x16x32_bf16(fr[m8 * 2 + kt], Pb[kt], oacc[m8], 0, 0, 0);
}
__device__ __forceinline__ void phase_attn(Frame& F, int l, const bool shared_step) {
    KARGS();
    const bf16* proj = (const bf16*)(WSP + SC_PROJ); const bf16* kvm = (const bf16*)(WSP + MS_KVM) + (size_t)l * MROWS * 1024; bf16* mix = (bf16*)(WSP + WS_HB);
    const bf16* vct = (const bf16*)(WSP + SC_VCT); const bf16* vmt = (const bf16*)(WSP + MS_VMT);
    const float* relb = IN(I_RELB) + (size_t)l * NH * RELW;
    const int lane = F.lane, c16 = lane & 15, q4 = lane >> 4, w4 = F.wave & 3, g = F.wave >> 2, wave = F.wave;
    LAS float* tb = (LAS float*)(F.lds + AT_TB);
    int kx[4];
#pragma unroll
    for (int ks = 0; ks < 4; ++ks) kx[ks] = c16 * 256 + (((4 * ks + q4) ^ c16) << 4);
    const int vcu = (F.G & 7) == 0 ? (F.blk & 7) * (F.G >> 3) + (F.blk >> 3) : F.blk;
    const int lb = (F.blk >> 3) - 8;
    for (int it = 0; ; ++it) {
        int p;
        if (shared_step) {
            int j;
            if (it < 5) j = it * 24 + lb; else { if (it > 5 || lb < 8 || lb >= 16) break; j = 112 + lb; }
            int kd, bhl, pn;
            if (j < 48) { kd = 0; bhl = j / 12; pn = 4 + (j - bhl * 12); }
            else if (j < 60) { kd = 0; bhl = (j - 48) & 3; pn = 3 - ((j - 48) >> 2); }
            else if (j < 124) { kd = 1; bhl = (j - 60) >> 4; pn = (j - 60) & 15; }
            else { kd = 0; bhl = j - 124; pn = 0; }
            p = kd * 512 + ((F.blk & 7) * 4 + bhl) * 16 + pn;
        } else { p = vcu + it * F.G; if (p >= 1024) break; }
        const int u0 = 2 * p, kind = u0 >> 10, r = u0 & 1023, b = r >> 7, h = (r >> 5) & 3, n0 = r & 31, n = n0 + g;
        const int cs = kind == 0 ? (n0 - NPREV < 0 ? 0 : n0 - NPREV) : 0, nts = kind == 0 ? n0 + 2 - cs : 4;
        const int c0 = kind == 0 ? (n - NPREV < 0 ? 0 : n - NPREV) : 0, lo = c0 - cs, hi = kind == 0 ? n + 1 - cs : 4;
        const int tq = b * SEQ + n * CH + 16 * w4;
        const bf16* qrow = proj + (size_t)(tq + c16) * NPROJ + (kind == 0 ? C_QC : C_QM) + h * HD + 8 * q4;
        const bf16* kbase = kind == 0 ? proj + (size_t)(b * SEQ + cs * CH) * NPROJ + C_KC + h * HD : kvm + (size_t)(b * NMEM) * 1024 + h * HD;
        const int ldk = kind == 0 ? NPROJ : 1024;
        const bf16* vtb = kind == 0 ? vct + (size_t)((b * NH + h) * NCHUNK + cs) * 8192 : vmt + (size_t)((b * NH + h) * 4) * 8192;
        bf16x8 Qb[4];
#pragma unroll
        for (int ks = 0; ks < 4; ++ks) Qb[ks] = *(const bf16x8*)(qrow + 32 * ks);
        float tbv = 0.f;
        if (kind == 0 && wave < 5) { const int idx = lane + 64 * wave; tbv = relb[h * RELW + (idx < RELW ? idx : RELW - 1)]; }
        asm volatile("s_waitcnt vmcnt(0)" ::: "memory");
        if (kind == 0 && wave < 5) { const int idx = lane + 64 * wave; if (idx < RELW) tb[idx] = tbv; }
        f32x4 oacc[8];
#pragma unroll
        for (int i = 0; i < 8; ++i) oacc[i] = (f32x4){0.f, 0.f, 0.f, 0.f};
        float m = -1.0e30f, lsum = 0.f;
        const int rb0 = 16 * w4 + c16 - 4 * q4 + 128;
        unsigned koff[2];
#pragma unroll
        for (int k = 0; k < 2; ++k) { const int row = 8 * wave + 4 * k + q4; koff[k] = (unsigned)(row * ldk + ((c16 ^ (row & 15)) << 3)) * 2u; }
        const unsigned voff = (unsigned)((2 * wave) * 64 + lane) * 16u;
#define AT_ISSUE(tile, stg) do { const int tc_ = (tile) < nts ? (tile) : nts - 1; attn_dma(kbase + (size_t)tc_ * CH * ldk, vtb + (size_t)tc_ * 8192, koff, voff, F.lds + (stg) * AT_STAGE, wave); } while (0)
#define AT_STEP(k) do { asm volatile("s_waitcnt vmcnt(8) lgkmcnt(0)" ::: "memory"); __builtin_amdgcn_s_barrier(); asm volatile("" ::: "memory"); \
            AT_ISSUE(ti + (k) + 3, ((k) + 3) & 3); \
            if (ti + (k) >= lo && ti + (k) < hi) attn_tile<(k)>(F.lds, kx, Qb, oacc, m, lsum, kind == 0, n - (cs + ti + (k)), rb0, tb, lane); } while (0)
        AT_ISSUE(0, 0); AT_ISSUE(1, 1); AT_ISSUE(2, 2);
#pragma unroll 1
        for (int ti = 0; ti < nts; ti += 4) {
            AT_STEP(0);
            if (ti + 1 < nts) AT_STEP(1);
            if (ti + 2 < nts) AT_STEP(2);
            if (ti + 3 < nts) AT_STEP(3);
        }
#undef AT_STEP
#undef AT_ISSUE
        lsum += __shfl_xor(lsum, 16); lsum += __shfl_xor(lsum, 32);
        const float inv = 1.0f / lsum;
        const int ocol = (kind == 0 ? 1024 : 1536) + h * HD + 4 * q4;
#pragma unroll
        for (int m8 = 0; m8 < 8; ++m8) { const f32x4 o = oacc[m8] * inv; *(v2u*)((unsigned char*)mix + img_off(tq + c16, (ocol + 16 * m8) * 2, D * 2)) = (v2u){pg8::cvt_pk_bf16(o[0], o[1]), pg8::cvt_pk_bf16(o[2], o[3])}; }
        asm volatile("s_waitcnt vmcnt(0) lgkmcnt(0)" ::: "memory"); __builtin_amdgcn_s_barrier(); asm volatile("" ::: "memory");
    }
}

__device__ __forceinline__ void phase_post(Frame& F, int l) {
    KARGS();
    const bf16* proj = (const bf16*)(WSP + SC_PROJ); const float* obuf = (const float*)(WSP + SC_OBUF); bf16* mix = (bf16*)(WSP + WS_HB);
    const int gw = F.blk * NWAVES + F.wave, NGW = F.G * NWAVES, lane = F.lane, li = lane & 15, d0 = li * 8, h = lane >> 4;
    const int kind = gw & 1, tstart = gw >> 1, tstride = NGW >> 1;
    float gv[8]; { const float* gn = kind == 0 ? IN(I_DNG) + l * HD + d0 : IN(I_RNG) + l * GW + h * HD + d0;
#pragma unroll
        for (int j = 0; j < 8; ++j) gv[j] = gn[j]; }
    for (int tb = tstart; tb < T; tb += 4 * tstride) {
        f32x4 a0[4], a1[4]; v4u zz[4];
#pragma unroll
        for (int u = 0; u < 4; ++u) { const int t = tb + u * tstride; a0[u] = *(const f32x4*)(obuf + (size_t)t * 1024 + kind * 512 + lane * 8); a1[u] = *(const f32x4*)(obuf + (size_t)t * 1024 + kind * 512 + lane * 8 + 4);
            zz[u] = *(const v4u*)(proj + (size_t)t * NPROJ + (kind == 0 ? C_ZA : C_GB) + lane * 8); }
#pragma unroll
        for (int u = 0; u < 4; ++u) { const int t = tb + u * tstride;
            float o[8] = {a0[u].x, a0[u].y, a0[u].z, a0[u].w, a1[u].x, a1[u].y, a1[u].z, a1[u].w}; float z[8]; unpack8(zz[u], z);
            if (kind == 0) { float ss = 0.f;
#pragma unroll
                for (int j = 0; j < 8; ++j) ss += o[j] * o[j];
                const float r = rsqrtf(grp16_sum(ss) * (1.0f / HD) + EPS);
#pragma unroll
                for (int j = 0; j < 8; ++j) o[j] = o[j] * r * gv[j] * silu_f(z[j]);
            } else { float sm = 0.f;
#pragma unroll
                for (int j = 0; j < 8; ++j) sm += o[j];
                const float mu = grp16_sum(sm) * (1.0f / HD); float sv = 0.f;
#pragma unroll
                for (int j = 0; j < 8; ++j) { o[j] -= mu; sv += o[j] * o[j]; }
                const float r = rsqrtf(grp16_sum(sv) * (1.0f / HD) + EPS);
#pragma unroll
                for (int j = 0; j < 8; ++j) o[j] = o[j] * r * gv[j] * silu_f(z[j]); }
            *(v4u*)((unsigned char*)mix + img_off(t, (kind * 512 + lane * 8) * 2, D * 2)) = pack8(o); }
    }
}

__device__ __forceinline__ void phase_route(Frame& F) {
    LAS int* lc = (LAS int*)F.lds;
    LAS int* base = lc + 2048;
    LAS int* tot = base + 8; LAS int* tst = tot + 8; LAS int* spos = tst + 16;
    const int* cnt = (const int*)(WSP + MS_CNT); const int* tope = (const int*)(WSP + MS_TOPE); const float* topg = (const float*)(WSP + MS_TOPG);
    int* pos = (int*)(WSP + MS_POS); float* rowg = (float*)(WSP + MS_ROWG); int* tile = (int*)(WSP + MS_TILE);
    const bf16* h2 = (const bf16*)(WSP + WS_HB); bf16* xs = (bf16*)(WSP + SC_XS);
    const int rpb = T / F.G;
    for (int i = F.tid; i < F.G * 8; i += NTHREADS) lc[i] = cnt[i];
    __syncthreads();
    if (F.tid < 8) { int before = 0, total = 0; for (int bI = 0; bI < F.G; ++bI) { const int c = lc[bI * 8 + F.tid]; if (bI < F.blk) before += c; total += c; } base[F.tid] = before; tot[F.tid] = total; }
    __syncthreads();
    if (F.tid == 0) { int ts = 0; for (int e = 0; e < 8; ++e) { tst[e] = ts; ts += (tot[e] + 255) >> 8; } tst[8] = ts;
        if (F.blk == 0) tile[0] = ts; }
    __syncthreads();
    if (F.blk == 0 && F.tid < tst[8]) { int e = 0;
#pragma unroll 1
        for (int q = 1; q < 8; ++q) e += (F.tid >= tst[q]) ? 1 : 0;
        tile[16 + F.tid] = e; }
    if (F.tid < 8) { int cursor = tst[F.tid] * 256 + base[F.tid];
        for (int i = 0; i < 2 * rpb; ++i) { const int tok = F.blk * rpb + (i >> 1); if (tope[tok * 2 + (i & 1)] == F.tid) { spos[i] = cursor; pos[tok * 2 + (i & 1)] = cursor; rowg[cursor] = topg[tok * 2 + (i & 1)]; ++cursor; } } }
    __syncthreads();
    unsigned char* xs8 = (unsigned char*)xs; const float* sa = (const float*)(WSP + MS_SA); float* sxs = (float*)(WSP + MS_SXS);
    for (int i = F.wave; i < 2 * rpb; i += NWAVES) { const int tok = F.blk * rpb + (i >> 1), prow = spos[i];
        v4u w[2];
#pragma unroll
        for (int j = 0; j < 2; ++j) w[j] = *(const v4u*)((const unsigned char*)h2 + img_off(tok, 1024 * j + 16 * F.lane, D));
#pragma unroll
        for (int j = 0; j < 2; ++j) *(v4u*)(xs8 + img_off(prow, 1024 * j + 16 * F.lane, D)) = w[j];
        if (F.lane == 0) sxs[prow] = sa[tok]; }
    const unsigned z0 = (unsigned)F.tid >> 31;
    if (F.blk < 8) { const int e = F.blk, lo = tst[e] * 256 + tot[e], hi = tst[e + 1] * 256;
        for (int r = lo + F.wave; r < hi; r += NWAVES) { rowg[r] = 0.f; if (F.lane == 0) sxs[r] = 0.f;
#pragma unroll
            for (int j = 0; j < 2; ++j) *(v4u*)(xs8 + img_off(r, 1024 * j + 16 * F.lane, D)) = (v4u){z0, z0, z0, z0}; } }
    __syncthreads();
}
__device__ __forceinline__ void phase_combine(Frame& F) {
    const int* pos = (const int*)(WSP + MS_POS); const bf16* Y = (const bf16*)(WSP + SC_Y); const bf16* x3 = (const bf16*)(WSP + WS_XB) + (size_t)T * D;
    const int gw = F.blk * NWAVES + F.wave, NGW = F.G * NWAVES;
    for (int t = gw; t < T; t += NGW) { const int p0 = pos[t * 2], p1 = pos[t * 2 + 1];
        f32x4* o = (f32x4*)(OUTP + (size_t)t * D) + F.lane; const v2u* xr = (const v2u*)(x3 + (size_t)t * D) + F.lane; const v2u* y0 = (const v2u*)(Y + (size_t)p0 * D) + F.lane; const v2u* y1 = (const v2u*)(Y + (size_t)p1 * D) + F.lane;
#pragma unroll
        for (int j = 0; j < 8; ++j) { const v2u xx = xr[64 * j], a = y0[64 * j], c = y1[64 * j]; f32x4 x;
            x.x = bflo(xx.x) + bflo(a.x) + bflo(c.x); x.y = bfhi(xx.x) + bfhi(a.x) + bfhi(c.x); x.z = bflo(xx.y) + bflo(a.y) + bflo(c.y); x.w = bfhi(xx.y) + bfhi(a.y) + bfhi(c.y); o[64 * j] = x; } }
}

constexpr int STEPS_PER_LAYER = 12, N_STEPS = 1 + 2 * STEPS_PER_LAYER;
__global__ void __launch_bounds__(NTHREADS, 2) fwd(Args args) {
    extern __shared__ __attribute__((aligned(16))) unsigned char lds_raw[];
    Frame F; F.lds = (LAS unsigned char*)lds_raw; F.tid = threadIdx.x; F.lane = F.tid & 63; F.wave = __builtin_amdgcn_readfirstlane(F.tid >> 6); F.G = gridDim.x; F.blk = blockIdx.x;
    F.ap = (const __attribute__((address_space(4))) Args*)__builtin_amdgcn_kernarg_segment_ptr();
    F.out = (GAS float*)args.out; F.ws = (GAS unsigned char*)args.ws;
    volatile LAS unsigned* MISC = (volatile LAS unsigned*)(F.lds + LDS_CTL_OFF);
    if (F.tid < 64) MISC[F.tid] = 0u;
    __syncthreads();
    XcdBarrier bar = xcd_barrier_post((unsigned*)(WSP + WS_CTL) + CW_BAR, MISC + 8);
    const int lo = args.step_lo, hi = args.step_hi;
    bool first = true;
#ifndef ONLY
#define ONLY -1
#endif
#define EN(j) (ONLY < 0 || ONLY == (j))
#define FRESH() Frame P = F; asm volatile("" : "+s"(P.ws), "+s"(P.out), "+s"(P.ap), "+s"(P.blk), "+s"(P.G), "+s"(P.wave), "+v"(P.tid), "+v"(P.lane))
#define STEP(k) if (lo <= (k) && (k) < hi && (first ? (first = false, true) : (xcd_barrier(bar), true)))
    STEP(0) { FRESH(); if (EN(0)) phase_p0(P); }
#pragma unroll 1
    for (int l = 0; l < 2; ++l) {
        const int sb = 1 + l * STEPS_PER_LAYER;
        STEP(sb + 0) { FRESH(); { Frame& F = P; KARGS(); const void* xin = l == 0 ? (const void*)IN(I_X) : (const void*)(WSP + WS_XB); if (EN(1)) {
                if (l == 0) {
                    pg8::PlainSched S; S.A = nullptr; S.B = nullptr; S.nM = 0; S.nN = 0; S.G = F.G; S.c = F.blk; S.tstep = (size_t)256 * D * 2;
                    S.A2 = (const char*)(WSP + MS_MEMH); S.B2 = (const char*)(WSP + WS_WMKV); S.a2stride = (size_t)MROWS * D * 2; S.b2stride = (size_t)1024 * D * 2; S.n2 = 2;
                    pg8::EpiProj E{(bf16*)(WSP + SC_PROJ), (bf16*)(WSP + MS_KVM), (size_t)MROWS * 1024, nullptr, 1.0f};
                    pg8::gemm_phase<0>(F.lds, F.tid, D * 2, S, E);
                    if (F.blk >= 64) phase_rmsnorm(F, xin, l, IN(I_NMIXG) + (size_t)l * D, (bf16*)(WSP + WS_HB), 1, l, F.blk - 64, F.G - 64);
                } else phase_rmsnorm(F, xin, l, IN(I_NMIXG) + (size_t)l * D, (bf16*)(WSP + WS_HB), 1, l, (F.G & 7) == 0 ? (F.blk & 7) * (F.G >> 3) + (F.blk >> 3) : F.blk, F.G); } } }
        STEP(sb + 1) { FRESH(); Frame& F = P;
#if W_IN_I8
            pg8::PlainSched S; S.A = (const char*)(WSP + WS_HB); S.B = (const char*)(WSP + WS_WIN) + (size_t)l * NPROJ * D; S.nM = T / 256; S.nN = NPROJ / 256; S.G = F.G; S.c = F.blk; S.tstep = (size_t)256 * D;
            S.A2 = nullptr; S.B2 = nullptr; S.a2stride = 0; S.b2stride = 0; S.n2 = 0;
            pg8::EpiProj E{(bf16*)(WSP + SC_PROJ), (bf16*)(WSP + MS_KVM), (size_t)MROWS * 1024, (const float*)(WSP + MS_SA), INV_SW_D};
            if (EN(2)) pg8::gemm_phase<2>(F.lds, F.tid, D, S, E);
#else
            pg8::PlainSched S; S.A = (const char*)(WSP + WS_HB); S.B = (const char*)(WSP + WS_WIN) + (size_t)l * NPROJ * D * 2; S.nM = T / 256; S.nN = NPROJ / 256; S.G = F.G; S.c = F.blk; S.tstep = (size_t)256 * D * 2;
            S.A2 = nullptr; S.B2 = nullptr; S.a2stride = 0; S.b2stride = 0; S.n2 = 0;
            pg8::EpiProj E{(bf16*)(WSP + SC_PROJ), (bf16*)(WSP + MS_KVM), (size_t)MROWS * 1024, nullptr, 1.0f};
            if (EN(2)) pg8::gemm_phase<0>(F.lds, F.tid, D * 2, S, E);
#endif
        }
        STEP(sb + 2) { FRESH(); if (EN(3)) phase_prep(P, l); }
        STEP(sb + 3) { FRESH(); if (EN(4)) phase_c1(P, l); }
        STEP(sb + 4) { FRESH(); if (EN(5)) {
            const bool sh = P.G == 256, sc = (P.blk >> 3) < 8;
            if (!sh || !sc) phase_attn(P, l, sh);
            if (!sh) phase_scan(P, l); else if (sc) phase_scan8(P, l);
        } }
        STEP(sb + 5) { FRESH(); if (EN(6)) phase_post(P, l); }
        STEP(sb + 6) { FRESH(); Frame& F = P; KARGS(); const void* xin = l == 0 ? (const void*)IN(I_X) : (const void*)(WSP + WS_XB);
            bf16* xmid = l == 0 ? (bf16*)OUTP : (bf16*)(WSP + WS_XB) + (size_t)T * D;
            pg8::PlainSched S; S.A = (const char*)(WSP + WS_HB); S.B = (const char*)(WSP + WS_WOUT) + (size_t)l * D * D * 2; S.nM = T / 256; S.nN = D / 256; S.G = F.G; S.c = F.blk; S.tstep = (size_t)256 * D * 2;
            S.A2 = nullptr; S.B2 = nullptr; S.a2stride = 0; S.b2stride = 0; S.n2 = 0;
            pg8::EpiRes E{xin, l, xmid};
            if (EN(7)) pg8::gemm_phase<0>(F.lds, F.tid, D * 2, S, E);
        }
        STEP(sb + 7) { FRESH(); { Frame& F = P; KARGS(); if (EN(8)) phase_rmsnorm(F, l == 0 ? (const void*)OUTP : (const void*)((bf16*)(WSP + WS_XB) + (size_t)T * D), 1, IN(I_NFFG) + (size_t)l * D, (bf16*)(WSP + WS_HB), l == 0 ? 0 : 2, l, (l == 0 && (F.G & 7) == 0) ? (F.blk & 7) * (F.G >> 3) + (F.blk >> 3) : F.blk, F.G); } }
        if (l == 1) { STEP(sb + 8) { FRESH(); if (EN(9)) phase_route(P); } }
        STEP(sb + 9) { FRESH(); Frame& F = P;
            pg8::GroupSched S; S.G = F.G; S.c = F.blk; S.tstep = (size_t)256 * D;
            if (l == 0) { S.A = (const char*)(WSP + WS_HB); S.B = (const char*)(WSP + WS_WGU); S.tile_e = nullptr; S.nrt = T / 256; S.nN = 2 * DFF / 256; S.estride = 0; }
            else { S.A = (const char*)(WSP + SC_XS); S.B = (const char*)(WSP + WS_MGU); S.tile_e = (const int*)(WSP + MS_TILE) + 16; S.nrt = ((const int*)(WSP + MS_TILE))[0]; S.nN = 2 * DFFE / 256; S.estride = (size_t)2 * DFFE * D; }
            pg8::EpiSwiglu E{l == 0 ? (bf16*)(WSP + SC_ACT) : (bf16*)(WSP + SC_MACT), l == 0 ? DFF : DFFE, INV_SW_D, l, l == 0 ? (const float*)(WSP + MS_SA) : (const float*)(WSP + MS_SXS)};
            if (EN(10)) pg8::gemm_phase<2>(F.lds, F.tid, D, S, E);
        }
        STEP(sb + 10) { FRESH(); Frame& F = P;
            pg8::GroupSched S; S.G = F.G; S.c = F.blk; S.nN = D / 256;
            pg8::EpiDown E{(const bf16*)OUTP, (bf16*)(WSP + WS_XB), (bf16*)(WSP + SC_Y), (const float*)(WSP + MS_ROWG), l};
            if (l == 0) { S.A = (const char*)(WSP + SC_ACT); S.B = (const char*)(WSP + WS_WDN); S.tile_e = nullptr; S.nrt = T / 256; S.estride = 0; S.tstep = (size_t)256 * DFF * 2;
                if (EN(11)) pg8::gemm_phase<0>(F.lds, F.tid, DFF * 2, S, E); }
            else { S.A = (const char*)(WSP + SC_MACT); S.B = (const char*)(WSP + WS_MDN); S.tile_e = (const int*)(WSP + MS_TILE) + 16; S.nrt = ((const int*)(WSP + MS_TILE))[0]; S.estride = (size_t)D * DFFE; S.tstep = (size_t)256 * DFFE;
                if (EN(11)) pg8::gemm_phase<1>(F.lds, F.tid, DFFE, S, E); }
        }
        if (l == 1) { STEP(sb + 11) { FRESH(); if (EN(12)) phase_combine(P); } }
    }
#undef STEP
}

extern "C" void kernel_launch(void* const* d_in, const int* in_sizes, int n_in, void* d_out, int out_size, void* d_ws, size_t ws_size, hipStream_t stream) {
    static int grid = 0;
    if (grid == 0) {
        if (n_in != 25 || out_size != T * D || ws_size < WS_END) { fprintf(stderr, "kernel_launch: unexpected shapes (n_in %d, out %d, ws %zu < %zu)\n", n_in, out_size, ws_size, (size_t)WS_END); grid = -1; return; }
        int dev = 0, cus = 0, per_cu = 0;
        if (hipGetDevice(&dev) != hipSuccess || hipDeviceGetAttribute(&cus, hipDeviceAttributeMultiprocessorCount, dev) != hipSuccess) { grid = -1; return; }
        if (hipFuncSetAttribute((const void*)fwd, hipFuncAttributeMaxDynamicSharedMemorySize, LDS_BYTES) != hipSuccess) { fprintf(stderr, "kernel_launch: hipFuncSetAttribute failed\n"); grid = -1; return; }
        if (hipOccupancyMaxActiveBlocksPerMultiprocessor(&per_cu, (const void*)fwd, NTHREADS, LDS_BYTES) != hipSuccess || per_cu < 1) { fprintf(stderr, "kernel_launch: occupancy query says %d\n", per_cu); }
        (void)hipGetLastError();
        grid = cus;
        if (T % grid != 0) { fprintf(stderr, "kernel_launch: grid %d does not divide T\n", grid); grid = -1; return; }
    }
    if (grid < 0) return;
    (void)in_sizes;
    if (hipMemsetAsync((char*)d_ws + WS_CTL, 0, CTL_ZERO_BYTES, stream) != hipSuccess) return;
    Args a{};
    for (int i = 0; i < 25; ++i) a.in[i] = (const float*)d_in[i];
    a.out = (float*)d_out; a.ws = (unsigned char*)d_ws; a.pad0 = 3;
#if ONE_LAUNCH
    a.step_lo = 0; a.step_hi = N_STEPS;
    hipLaunchKernelGGL(fwd, dim3(grid), dim3(NTHREADS), LDS_BYTES, stream, a);
#ifdef PROBE_STEPS
    { const int ps[] = PROBE_STEPS; for (int s : ps) { a.step_lo = s; a.step_hi = s + 1; a.pad0 = PROBE_MASK; hipLaunchKernelGGL(fwd, dim3(grid), dim3(NTHREADS), LDS_BYTES, stream, a); } }
#endif
#else
    for (int s = 0; s < N_STEPS; ++s) {
        if (s >= 1 && s < 1 + STEPS_PER_LAYER && ((s - 1) == 8 || (s - 1) == 11)) continue;
        a.step_lo = s; a.step_hi = s + 1;
        hipLaunchKernelGGL(fwd, dim3(grid), dim3(NTHREADS), LDS_BYTES, stream, a);
    }
#endif
}
```

```cpp
#include <hip/hip_runtime.h>
#include <cstdio>
#include <cstdint>

#ifndef W_IN_I8
#define W_IN_I8 1
#endif
#ifndef PROBE_MASK
#define PROBE_MASK 3
#endif
#ifndef NAIVE_ATTN
#define NAIVE_ATTN 0
#endif
#ifndef NAIVE_RECUR
#define NAIVE_RECUR 0
#endif
#ifndef ONE_LAUNCH
#define ONE_LAUNCH 1
#endif

#define GAS __attribute__((address_space(1)))
#define LAS __attribute__((address_space(3)))
typedef unsigned short bf16;
typedef unsigned v4u __attribute__((ext_vector_type(4)));
typedef unsigned v2u __attribute__((ext_vector_type(2)));
typedef float f32x4 __attribute__((ext_vector_type(4)));
typedef short bf16x8 __attribute__((ext_vector_type(8)));
typedef int i32x4 __attribute__((ext_vector_type(4)));

constexpr int D = 2048, NB = 8, SEQ = 2048, T = NB * SEQ, NH = 4, HD = 128, GW = 512, DIN = 6152, NPROJ = 6144;
constexpr int CH = 64, NCHUNK = SEQ / CH, NMEM = 256, MROWS = NB * NMEM, NPREV = 8;
constexpr int DFF = 5632, NE = 8, DFFE = 7168, RELW = 257;
constexpr int XS_ROWS = 2 * T + NE * 256;
constexpr float EPS = 1e-6f;
constexpr int C_QA = 0, C_KA = 512, C_VA = 1024, C_ZA = 1536, C_QB = 2048, C_KB = 2560, C_VB = 3072, C_GB = 3584, C_QC = 4096, C_KC = 4608, C_VC = 5120, C_QM = 5632;

constexpr size_t MiB = 1u << 20;
constexpr size_t WS_CTL = 0, CTL_ZERO_BYTES = 64 * 1024;
constexpr size_t WS_WIN = 1 * MiB;
constexpr size_t WS_WMKV = WS_WIN + 48 * MiB;
constexpr size_t WS_WOUT = WS_WMKV + 8 * MiB;
constexpr size_t WS_WGU = WS_WOUT + 16 * MiB;
constexpr size_t WS_WDN = WS_WGU + 44 * MiB;
constexpr size_t WS_MGU = WS_WDN + 22 * MiB;
constexpr size_t WS_MDN = WS_MGU + 448 * MiB;
constexpr size_t WS_HB = WS_MDN + 224 * MiB;
constexpr size_t WS_XB = WS_HB + 64 * MiB;
constexpr size_t WS_MISC = WS_XB + 128 * MiB;
constexpr size_t WS_SCR = WS_MISC + 40 * MiB;
constexpr size_t WS_END = WS_SCR + 748 * MiB;
static_assert(WS_HB == 811 * MiB && WS_END == 1791 * MiB, "ws map");
constexpr size_t MS_MEMH = WS_MISC;
constexpr size_t MS_KVM = WS_MISC + 16 * MiB;
constexpr size_t MS_VMT = WS_MISC + 24 * MiB;
constexpr size_t MS_GATES = WS_MISC + 28 * MiB;
constexpr size_t MS_ROPE = WS_MISC + 29 * MiB;
constexpr size_t MS_TOPE = WS_MISC + 30 * MiB;
constexpr size_t MS_TOPG = MS_TOPE + 128 * 1024;
constexpr size_t MS_POS = MS_TOPG + 128 * 1024;
constexpr size_t MS_ROWG = MS_POS + 128 * 1024;
constexpr size_t MS_CNT = MS_ROWG + 256 * 1024;
constexpr size_t MS_TILE = MS_CNT + 64 * 1024;
constexpr size_t SC_PROJ = WS_SCR;
constexpr size_t SC_CONVA = WS_SCR + 192 * MiB;
constexpr size_t SC_VCT = WS_SCR + 240 * MiB;
constexpr size_t SC_OBUF = WS_SCR + 256 * MiB;
constexpr size_t SC_PRE = WS_SCR + 320 * MiB;
constexpr int REC_BYTES = 90112, REC_QF = 0, REC_KF = 16384, REC_AF = 32768, REC_WF = 40960, REC_U = 57344;
constexpr size_t MS_GTOT = WS_MISC + 32 * MiB;
constexpr size_t MS_SA = WS_MISC + 33 * MiB;
constexpr size_t MS_SXS = WS_MISC + 34 * MiB;
constexpr float SW_D = 127.0f * 45.254833995939045f / 6.0f, INV_SW_D = 1.0f / SW_D;
constexpr size_t SC_ACT = WS_SCR;
constexpr size_t SC_XS = WS_SCR;
constexpr size_t SC_MACT = WS_SCR + 136 * MiB;
constexpr size_t SC_Y = WS_SCR + 612 * MiB;
constexpr int CW_BAR = 4096;

constexpr int LDS_BYTES = 163840;
constexpr int LDS_CTL_OFF = 162816;
constexpr int NWAVES = 8, NTHREADS = 512;

__device__ __forceinline__ unsigned f2bf(float f) { unsigned u = __builtin_bit_cast(unsigned, f); return (u + 0x7fffu + ((u >> 16) & 1u)) >> 16; }
__device__ __forceinline__ unsigned pk2(float lo, float hi) { return f2bf(lo) | (f2bf(hi) << 16); }
__device__ __forceinline__ float bflo(unsigned w) { return __builtin_bit_cast(float, w << 16); }
__device__ __forceinline__ float bfhi(unsigned w) { return __builtin_bit_cast(float, w & 0xffff0000u); }
__device__ __forceinline__ float bf2f(bf16 b) { return __builtin_bit_cast(float, ((unsigned)b) << 16); }
__device__ __forceinline__ float wave_sum(float v) {
#pragma unroll
    for (int o = 1; o < 64; o <<= 1) v += __shfl_xor(v, o);
    return v;
}
__device__ __forceinline__ float wave_max(float v) {
#pragma unroll
    for (int o = 1; o < 64; o <<= 1) v = fmaxf(v, __shfl_xor(v, o));
    return v;
}
__device__ __forceinline__ float grp16_sum(float v) {
#pragma unroll
    for (int o = 1; o < 16; o <<= 1) v += __shfl_xor(v, o);
    return v;
}
__device__ __forceinline__ float silu_f(float x) { return x / (1.0f + __expf(-x)); }
__device__ __forceinline__ void unpack8(const v4u w, float (&f)[8]) {
    f[0] = bflo(w.x); f[1] = bfhi(w.x); f[2] = bflo(w.y); f[3] = bfhi(w.y); f[4] = bflo(w.z); f[5] = bfhi(w.z); f[6] = bflo(w.w); f[7] = bfhi(w.w);
}
__device__ __forceinline__ v4u pack8(const float (&f)[8]) { v4u w; w.x = pk2(f[0], f[1]); w.y = pk2(f[2], f[3]); w.z = pk2(f[4], f[5]); w.w = pk2(f[6], f[7]); return w; }

#define XB_TMO      128
#define XB_XCNT(j)  (256  + 64 * (j))
#define XB_XSUB(j)  (1280 + 64 * (j))
#define XB_XGEN(j)  (2304 + 64 * (j))
#define XB_TOP      3328
#define XB_TOPGEN   3392
#define XCD_BAR_WORDS 3456
#define XB_SPIN_CAP (1u << 18)
__device__ __forceinline__ unsigned xb_ld(unsigned* p)              { return __hip_atomic_load(p, __ATOMIC_RELAXED, __HIP_MEMORY_SCOPE_AGENT); }
__device__ __forceinline__ unsigned xb_add(unsigned* p, unsigned v) { return __hip_atomic_fetch_add(p, v, __ATOMIC_RELAXED, __HIP_MEMORY_SCOPE_AGENT); }
__device__ __forceinline__ unsigned xb_xcc_id() { return (unsigned)__builtin_amdgcn_s_getreg((3 << 11) | 20) & 0xFu; }
#define XB_SPIN(cond, bar) do { unsigned _sp = 0; while (cond) { __builtin_amdgcn_s_sleep(1); \
    if ((++_sp & 255u) == 0u) { if (xb_ld(&(bar)[XB_TMO])) break; if (_sp > XB_SPIN_CAP) { atomicAdd(&(bar)[XB_TMO], 1u); break; } } } } while (0)
struct XcdBarrier { unsigned* bar; unsigned x; volatile LAS unsigned* st; };
__device__ __forceinline__ XcdBarrier xcd_barrier_post(unsigned* bar, volatile LAS unsigned* st) {
    XcdBarrier b; b.bar = bar; b.x = xb_xcc_id(); b.st = st;
    if (threadIdx.x == 0) (void)xb_add(&bar[XB_XCNT(b.x)], 1u);
    return b;
}
__device__ __forceinline__ void xcd_barrier_complete(unsigned* bar, unsigned x, unsigned& nloc, unsigned& nx) {
    const unsigned G = gridDim.x * gridDim.y * gridDim.z;
    unsigned sum, cnt, mine, sp = 0u;
    for (;;) {
        sum = 0u; cnt = 0u; mine = 0u;
#pragma unroll
        for (unsigned j = 0; j < 16; ++j) { const unsigned c = xb_ld(&bar[XB_XCNT(j)]); sum += c; cnt += (c > 0u) ? 1u : 0u; mine = (j == x) ? c : mine; }
        if (sum == G) break;
        __builtin_amdgcn_s_sleep(1);
        if ((++sp & 255u) == 0u) { if (xb_ld(&bar[XB_TMO])) break; if (sp > XB_SPIN_CAP) { atomicAdd(&bar[XB_TMO], 1u); break; } }
    }
    nloc = mine > 0u ? mine : 1u; nx = cnt > 0u ? cnt : 1u;
}
__device__ __forceinline__ void xcd_barrier(const XcdBarrier& b) {
    asm volatile("s_waitcnt vmcnt(0)" ::: "memory");
    __syncthreads();
    if (threadIdx.x == 0) {
        unsigned* bar = b.bar;
        __builtin_amdgcn_s_waitcnt(0);
        unsigned nloc = b.st[0], nx = b.st[1];
        if (nloc == 0u) { xcd_barrier_complete(bar, b.x, nloc, nx); b.st[0] = nloc; b.st[1] = nx; }
        const unsigned old = xb_add(&bar[XB_XSUB(b.x)], 1u);
        const unsigned gen = old / nloc;
        if (old + 1u == (gen + 1u) * nloc) {
            __builtin_amdgcn_fence(__ATOMIC_RELEASE, "agent");
            asm volatile("s_waitcnt vmcnt(0)" ::: "memory");
            const unsigned og = xb_add(&bar[XB_TOP], 1u);
            const unsigned tg = og / nx;
            if (og + 1u == (tg + 1u) * nx) xb_add(&bar[XB_TOPGEN], 1u);
            else XB_SPIN(xb_ld(&bar[XB_TOPGEN]) == tg, bar);
            __builtin_amdgcn_fence(__ATOMIC_ACQUIRE, "agent");
            xb_add(&bar[XB_XGEN(b.x)], 1u);
            asm volatile("s_waitcnt vmcnt(0)" ::: "memory");
        } else {
            XB_SPIN(xb_ld(&bar[XB_XGEN(b.x)]) == gen, bar);
            __builtin_amdgcn_fence(__ATOMIC_ACQUIRE, "agent");
            asm volatile("s_waitcnt vmcnt(0)" ::: "memory");
        }
    }
    __syncthreads();
}

namespace pg8 {
constexpr int BM = 256, BK = 64, HALF = 128, HTB = HALF * BK * 2, STAGE_BYTES = 8 * HTB, NXCD = 8, WGM = 8;
__host__ __device__ __forceinline__ int lds_byte(int r, int c) { const int st = (r >> 4) * 2 + (c >> 5), rr = r & 15, cc = c & 31, ob = rr * 64 + cc * 2; return st * 1024 + (ob ^ (((ob >> 9) & 1) << 5)); }
__host__ __device__ __forceinline__ void stage_rc(int b, int& R, int& C) { const int st = b / 1024, sb = b % 1024, swz = sb ^ (((sb >> 9) & 1) << 5); R = (st >> 1) * 16 + swz / 64; C = (st & 1) * 32 + (swz % 64) / 2; }
__host__ __device__ __forceinline__ int perm32(int rho) { const int n = rho >> 4, i = rho & 15; return 8 * (i >> 2) + 4 * n + (i & 3); }
__device__ __forceinline__ size_t img_off(int row, int kb, int RB) {
    return (size_t)(row >> 8) * ((size_t)256 * RB) + (size_t)(kb >> 7) * 32768 + (size_t)(((row >> 7) & 1) * 16384 + lds_byte(row & 127, (kb & 127) >> 1));
}
__device__ __forceinline__ int wslot(int n) { const int w = n & 31; return (n & ~31) + 16 * ((w >> 2) & 1) + 4 * (w >> 3) + (w & 3); }

__device__ __forceinline__ f32x4 tof(const f32x4 v) { return v; }
__device__ __forceinline__ f32x4 tof(const i32x4 v) { return __builtin_convertvector(v, f32x4); }
__device__ __forceinline__ unsigned cvt_pk_bf16(float lo, float hi) { unsigned r; asm volatile("v_cvt_pk_bf16_f32 %0, %1, %2" : "=v"(r) : "v"(lo), "v"(hi)); return r; }

struct GUnit { const char* A; const char* B; int pm, pn, aux; };
__device__ __forceinline__ void static_map(int L, int nM, int nN, int& pm, int& pn) {
    const int nwg = nM * nN; int wgid = L;
    { const int q = nwg / NXCD, r = nwg % NXCD, xcd = wgid % NXCD, off = wgid / NXCD; wgid = (xcd < r ? xcd * (q + 1) : r * (q + 1) + (xcd - r) * q) + off; }
    const int nig = WGM * nN, gid = wgid / nig, fm = gid * WGM, gsz = (nM - fm) < WGM ? (nM - fm) : WGM;
    pm = fm + ((wgid % nig) % gsz); pn = (wgid % nig) / gsz;
}

typedef int v8i __attribute__((ext_vector_type(8)));
__device__ __forceinline__ v8i cat8(const bf16x8 a, const bf16x8 b) { const v4u x = __builtin_bit_cast(v4u, a), y = __builtin_bit_cast(v4u, b); return (v8i){(int)x.x, (int)x.y, (int)x.z, (int)x.w, (int)y.x, (int)y.y, (int)y.z, (int)y.w}; }
template <int M_> struct AccSel { typedef f32x4 type; };
template <> struct AccSel<2> { typedef i32x4 type; };
template <int MODE, class Epi, class Sched>
__device__ __forceinline__ void gemm_phase(LAS unsigned char* lds, const int tid, const int RB, const Sched& S, const Epi& E) {
    constexpr bool FP8 = MODE == 1; typedef typename AccSel<MODE>::type AccT;
    const int wid = __builtin_amdgcn_readfirstlane(tid >> 6), lane = tid & 63, wr = wid >> 2, wc = wid & 3, fr = lane & 15, fq = lane >> 4;
    const int nt = RB / 128;
    unsigned voffA[2], voffB[2];
#pragma unroll
    for (int i = 0; i < 2; ++i) { voffA[i] = (unsigned)(tid * 16 + i * 8192); voffB[i] = voffA[i]; }
    const size_t kstep = (size_t)32768;
    const size_t hstep = (size_t)16384;
    const unsigned ldsw = (unsigned)wid * 1024u;
    const int aoff = lds_byte(wr * 64 + fr, fq * 8), boff = lds_byte(wc * 32 + fr, fq * 8);
#define PG8_SA(b, h) (((b) * 2 + (h)) * HTB)
#define PG8_SB(b, h) ((4 + (b) * 2 + (h)) * HTB)
#define PG8_STAGE(bufoff, gbase, voff) do { _Pragma("unroll") for (int _i = 0; _i < 2; ++_i) \
        __builtin_amdgcn_global_load_lds((const unsigned*)((const char*)(gbase) + (voff)[_i]), (LAS unsigned*)(lds + (bufoff) + ldsw + _i * 8192), 16, 0, 0); } while (0)
#define PG8_LD8(p) ({ const v4u lo_ = *(const LAS v4u*)(p), hi_ = *(const LAS v4u*)((p) + 1024); (v8i){(int)lo_.x, (int)lo_.y, (int)lo_.z, (int)lo_.w, (int)hi_.x, (int)hi_.y, (int)hi_.z, (int)hi_.w}; })
#define PG8_LDA(dst, b, h) do { _Pragma("unroll") for (int m = 0; m < 4; ++m) { if constexpr (FP8) dst##8[m] = PG8_LD8(lds + PG8_SA(b, h) + aoff + m * 2048); else { _Pragma("unroll") for (int k = 0; k < 2; ++k) dst[m][k] = *(const LAS bf16x8*)(lds + PG8_SA(b, h) + aoff + m * 2048 + k * 1024); } } } while (0)
#define PG8_LDB(dst, b, h) do { _Pragma("unroll") for (int n = 0; n < 2; ++n) { if constexpr (FP8) dst##8[n] = PG8_LD8(lds + PG8_SB(b, h) + boff + n * 2048); else { _Pragma("unroll") for (int k = 0; k < 2; ++k) dst[n][k] = *(const LAS bf16x8*)(lds + PG8_SB(b, h) + boff + n * 2048 + k * 1024); } } } while (0)
#define PG8_MMA(ai, bj, At, Bt) do { __builtin_amdgcn_s_setprio(1); _Pragma("unroll") for (int m = 0; m < 4; ++m) _Pragma("unroll") for (int n = 0; n < 2; ++n) { \
        if constexpr (FP8) asm volatile("v_mfma_scale_f32_16x16x128_f8f6f4 %0, %1, %2, %0, %3, %3 op_sel_hi:[0,0,0]" : "+v"(acc[ai][bj][m][n]) : "v"(Bt##8[n]), "v"(At##8[m]), "v"(scl1));   \
        else if constexpr (MODE == 2) { _Pragma("unroll") for (int k = 0; k < 2; ++k) acc[ai][bj][m][n] = __builtin_amdgcn_mfma_i32_16x16x64_i8(__builtin_bit_cast(i32x4, Bt[n][k]), __builtin_bit_cast(i32x4, At[m][k]), acc[ai][bj][m][n], 0, 0, 0); } \
        else { _Pragma("unroll") for (int k = 0; k < 2; ++k) acc[ai][bj][m][n] = __builtin_amdgcn_mfma_f32_16x16x32_bf16(Bt[n][k], At[m][k], acc[ai][bj][m][n], 0, 0, 0); } } __builtin_amdgcn_s_setprio(0); } while (0)
#define PG8_WAIT_V(n) asm volatile("s_waitcnt vmcnt(" #n ")" ::: "memory")
#define PG8_WAIT_L(n) asm volatile("s_waitcnt lgkmcnt(" #n ")" ::: "memory")
#define PG8_BAR __builtin_amdgcn_s_barrier()
#define PG8_SCHED __builtin_amdgcn_sched_barrier(0)
    GUnit cur, nxt; int ui = 0;
    if (!S.next(0, cur)) return;
    AccT acc[2][2][4][2];
#pragma unroll
    for (int a = 0; a < 2; ++a)
#pragma unroll
        for (int b = 0; b < 2; ++b)
#pragma unroll
            for (int m = 0; m < 4; ++m)
#pragma unroll
                for (int n = 0; n < 2; ++n) acc[a][b][m][n] = (AccT){0, 0, 0, 0};
    bf16x8 At[4][2], B0[2][2], B1[2][2]; v8i At8[4], B08[2], B18[2];
    const unsigned scl1 = 0x7f7f7f7fu;
    const char* cA = cur.A; const char* cB = cur.B;
    PG8_STAGE(PG8_SB(0, 0), cB, voffB); PG8_STAGE(PG8_SB(0, 1), cB + hstep, voffB); PG8_STAGE(PG8_SA(0, 0), cA, voffA); PG8_STAGE(PG8_SA(0, 1), cA + hstep, voffA);
    if (wr == 1) PG8_BAR;
    PG8_WAIT_V(2); PG8_BAR;
    PG8_STAGE(PG8_SB(1, 0), cB + kstep, voffB); PG8_STAGE(PG8_SA(1, 0), cA + kstep, voffA); PG8_STAGE(PG8_SB(1, 1), cB + hstep + kstep, voffB);
    PG8_WAIT_V(6); PG8_BAR;
    for (;;) {
        const bool has_next = S.next(ui + 1, nxt);
        const char* nA = has_next ? nxt.A : cA; const char* nB = has_next ? nxt.B : cB;
        for (int t = 0; t < nt; t += 2) {
            const bool last = (t == nt - 2);
            const char* a1 = cA + (size_t)(t + 1) * kstep;
            const char* a2 = last ? nA : cA + (size_t)(t + 2) * kstep; const char* b2 = last ? nB : cB + (size_t)(t + 2) * kstep;
            const char* a3 = a2 + kstep; const char* b3 = b2 + kstep;
            PG8_LDB(B0, 0, 0); PG8_LDB(B1, 0, 1); PG8_SCHED; PG8_LDA(At, 0, 0); PG8_STAGE(PG8_SA(1, 1), a1 + hstep, voffA);
            PG8_WAIT_V(8); PG8_WAIT_L(0); PG8_BAR; PG8_MMA(0, 0, At, B0); PG8_MMA(0, 1, At, B1); PG8_BAR; PG8_SCHED;
            PG8_LDA(At, 0, 1); PG8_STAGE(PG8_SB(0, 0), b2, voffB); PG8_STAGE(PG8_SB(0, 1), b2 + hstep, voffB); PG8_STAGE(PG8_SA(0, 0), a2, voffA);
            PG8_WAIT_V(8); PG8_WAIT_L(0); PG8_BAR; PG8_MMA(1, 0, At, B0); PG8_MMA(1, 1, At, B1); PG8_BAR; PG8_SCHED;
            PG8_LDB(B0, 1, 0); PG8_LDB(B1, 1, 1); PG8_SCHED; PG8_LDA(At, 1, 0); PG8_STAGE(PG8_SA(0, 1), a2 + hstep, voffA);
            PG8_WAIT_V(8); PG8_WAIT_L(0); PG8_BAR; PG8_MMA(0, 0, At, B0); PG8_MMA(0, 1, At, B1); PG8_BAR; PG8_SCHED;
            PG8_LDA(At, 1, 1); PG8_STAGE(PG8_SB(1, 0), b3, voffB); PG8_STAGE(PG8_SB(1, 1), b3 + hstep, voffB); PG8_STAGE(PG8_SA(1, 0), a3, voffA);
            PG8_WAIT_V(8); PG8_WAIT_L(0); PG8_BAR; PG8_MMA(1, 0, At, B0); PG8_MMA(1, 1, At, B1); PG8_BAR; PG8_SCHED;
        }
        if constexpr (FP8) asm volatile("s_nop 15\n\ts_nop 15" ::: "memory");
        if (wr == 0) PG8_BAR;
        E(acc, cur, wr, wc, fr, fq);
        if (!has_next) break;
#pragma unroll
        for (int a = 0; a < 2; ++a)
#pragma unroll
            for (int b = 0; b < 2; ++b)
#pragma unroll
                for (int m = 0; m < 4; ++m)
#pragma unroll
                    for (int n = 0; n < 2; ++n) acc[a][b][m][n] = (AccT){0, 0, 0, 0};
        cur = nxt; cA = nA; cB = nB; ++ui;
        if (wr == 1) PG8_BAR;
    }
    PG8_WAIT_V(0);
    PG8_BAR;
#undef PG8_SA
#undef PG8_SB
#undef PG8_STAGE
#undef PG8_LDA
#undef PG8_LDB
#undef PG8_MMA
#undef PG8_WAIT_V
#undef PG8_WAIT_L
#undef PG8_BAR
#undef PG8_SCHED
}

struct PlainSched {
    const char* A; const char* B; int nM, nN, G, c; size_t tstep;
    const char* A2; const char* B2; size_t a2stride, b2stride; int n2;
    __device__ __forceinline__ bool next(int i, GUnit& u) const {
        const int L = i * G + c, n1 = nM * nN;
        if (L < n1) { static_map(L, nM, nN, u.pm, u.pn); u.A = A + (size_t)u.pm * tstep; u.B = B + (size_t)u.pn * tstep; u.aux = 0; return true; }
        const int L2 = L - n1; if (L2 >= n2 * 32) return false;
        const int j = L2 >> 5, r = L2 & 31; u.pm = r & 7; u.pn = r >> 3; u.aux = 1 + j;
        u.A = A2 + (size_t)j * a2stride + (size_t)u.pm * tstep; u.B = B2 + (size_t)j * b2stride + (size_t)u.pn * tstep; return true;
    }
};
struct GroupSched {
    const char* A; const char* B; const int* tile_e; int nrt, nN, G, c; size_t tstep, estride;
    __device__ __forceinline__ bool next(int i, GUnit& u) const {
        const int L = i * G + c; if (L >= nrt * nN) return false;
        static_map(L, nrt, nN, u.pm, u.pn);
        const int e = tile_e ? tile_e[u.pm] : 0; u.aux = e;
        u.A = A + (size_t)u.pm * tstep; u.B = B + (size_t)e * estride + (size_t)u.pn * tstep; return true;
    }
};

struct EpiProj {
    bf16* proj; bf16* kvm0; size_t kvm_stride; const float* rowscale; float cscale;
    template <class AccT> __device__ __forceinline__ void operator()(const AccT (&acc)[2][2][4][2], const GUnit& u, int wr, int wc, int fr, int fq) const {
        bf16* base = u.aux == 0 ? proj : kvm0 + (size_t)(u.aux - 1) * kvm_stride; const int ldc = u.aux == 0 ? NPROJ : 1024;
        const int row0 = u.pm * BM + wr * 64 + fr, col0 = u.pn * BM + wc * 32 + 8 * fq;
        float rs[2][4];
#pragma unroll
        for (int ai = 0; ai < 2; ++ai)
#pragma unroll
            for (int m = 0; m < 4; ++m) rs[ai][m] = rowscale ? rowscale[row0 + ai * HALF + m * 16] * cscale : 1.0f;
        __builtin_amdgcn_sched_barrier(0);
#pragma unroll
        for (int ai = 0; ai < 2; ++ai)
#pragma unroll
            for (int m = 0; m < 4; ++m) { const int row = row0 + ai * HALF + m * 16; bf16* rowp = base + (size_t)row * ldc + col0;
#pragma unroll
                for (int bj = 0; bj < 2; ++bj) { const f32x4 v0 = tof(acc[ai][bj][m][0]) * rs[ai][m], v1 = tof(acc[ai][bj][m][1]) * rs[ai][m];
                    v4u w; w.x = cvt_pk_bf16(v0[0], v0[1]); w.y = cvt_pk_bf16(v0[2], v0[3]); w.z = cvt_pk_bf16(v1[0], v1[1]); w.w = cvt_pk_bf16(v1[2], v1[3]);
                    *(v4u*)(rowp + bj * HALF) = w; } }
    }
};
struct EpiRes {
    const void* res; int res_bf16; bf16* out; const float* rowscale; float cscale;
    template <class AccT> __device__ __forceinline__ void operator()(const AccT (&acc)[2][2][4][2], const GUnit& u, int wr, int wc, int fr, int fq) const {
        const int row0 = u.pm * BM + wr * 64 + fr, col0 = u.pn * BM + wc * 32 + 8 * fq;
#pragma unroll
        for (int ai = 0; ai < 2; ++ai) {
            f32x4 rr[4][2][2]; float rs[4];
#pragma unroll
            for (int m = 0; m < 4; ++m) { const size_t off = (size_t)(row0 + ai * HALF + m * 16) * D + col0; rs[m] = rowscale ? rowscale[row0 + ai * HALF + m * 16] * cscale : 1.0f;
#pragma unroll
                for (int bj = 0; bj < 2; ++bj) { if (res_bf16) { rr[m][bj][0] = __builtin_bit_cast(f32x4, *(const v4u*)((const bf16*)res + off + bj * HALF)); rr[m][bj][1] = rr[m][bj][0]; }
                    else { rr[m][bj][0] = *(const f32x4*)((const float*)res + off + bj * HALF); rr[m][bj][1] = *(const f32x4*)((const float*)res + off + bj * HALF + 4); } } }
            __builtin_amdgcn_sched_barrier(0);
#pragma unroll
            for (int m = 0; m < 4; ++m) { const size_t off = (size_t)(row0 + ai * HALF + m * 16) * D + col0;
#pragma unroll
                for (int bj = 0; bj < 2; ++bj) { f32x4 a0, a1;
                    if (res_bf16) { const v4u w = __builtin_bit_cast(v4u, rr[m][bj][0]); a0 = (f32x4){bflo(w.x), bfhi(w.x), bflo(w.y), bfhi(w.y)}; a1 = (f32x4){bflo(w.z), bfhi(w.z), bflo(w.w), bfhi(w.w)}; } else { a0 = rr[m][bj][0]; a1 = rr[m][bj][1]; }
                    const f32x4 v0 = a0 + tof(acc[ai][bj][m][0]) * rs[m], v1 = a1 + tof(acc[ai][bj][m][1]) * rs[m];
                    v4u w; w.x = cvt_pk_bf16(v0[0], v0[1]); w.y = cvt_pk_bf16(v0[2], v0[3]); w.z = cvt_pk_bf16(v1[0], v1[1]); w.w = cvt_pk_bf16(v1[2], v1[3]);
                    *(v4u*)(out + off + bj * HALF) = w; } }
            __builtin_amdgcn_sched_barrier(0);
        }
    }
};
struct EpiSwiglu {
    bf16* act; int ldc; float inscale; int fp8out; const float* rowscale;
    template <class AccT> __device__ __forceinline__ void operator()(const AccT (&acc)[2][2][4][2], const GUnit& u, int wr, int wc, int fr, int fq) const {
        const int row0 = u.pm * BM + wr * 64 + fr, col0 = u.pn * HALF + wc * 32 + 8 * fq;
        float rsv[2][4];
#pragma unroll
        for (int ai = 0; ai < 2; ++ai)
#pragma unroll
            for (int m = 0; m < 4; ++m) rsv[ai][m] = rowscale ? rowscale[row0 + ai * HALF + m * 16] * inscale : inscale;
        __builtin_amdgcn_sched_barrier(0);
#pragma unroll
        for (int ai = 0; ai < 2; ++ai)
#pragma unroll
            for (int m = 0; m < 4; ++m) { float o[8]; const float rs = rsv[ai][m];
#pragma unroll
                for (int n = 0; n < 2; ++n)
#pragma unroll
                    for (int j = 0; j < 4; ++j) { const float g = (float)acc[ai][0][m][n][j] * rs, up = (float)acc[ai][1][m][n][j] * rs; o[4 * n + j] = g * up * __builtin_amdgcn_rcpf(1.0f + __expf(-g)); }
                if (fp8out) {
#pragma unroll
                    for (int j = 0; j < 8; ++j) o[j] = fminf(fmaxf(o[j] * 8.0f, -448.0f), 448.0f);
                    unsigned w0 = 0, w1 = 0; w0 = __builtin_amdgcn_cvt_pk_fp8_f32(o[0], o[1], w0, false); w0 = __builtin_amdgcn_cvt_pk_fp8_f32(o[2], o[3], w0, true);
                    w1 = __builtin_amdgcn_cvt_pk_fp8_f32(o[4], o[5], w1, false); w1 = __builtin_amdgcn_cvt_pk_fp8_f32(o[6], o[7], w1, true);
                    *(v2u*)((unsigned char*)act + img_off(row0 + ai * HALF + m * 16, col0, ldc)) = (v2u){w0, w1};
                } else {
                v4u w; w.x = cvt_pk_bf16(o[0], o[1]); w.y = cvt_pk_bf16(o[2], o[3]); w.z = cvt_pk_bf16(o[4], o[5]); w.w = cvt_pk_bf16(o[6], o[7]);
                *(v4u*)((unsigned char*)act + img_off(row0 + ai * HALF + m * 16, col0 * 2, ldc * 2)) = w; } }
    }
};
struct EpiDown {
    const bf16* res; bf16* out; bf16* Y; const float* rowgate; int moe;
    template <class AccT> __device__ __forceinline__ void operator()(const AccT (&acc)[2][2][4][2], const GUnit& u, int wr, int wc, int fr, int fq) const {
        const int row0 = u.pm * BM + wr * 64 + fr, col0 = u.pn * BM + wc * 32 + 8 * fq;
        if (!moe) {
#pragma unroll
            for (int ai = 0; ai < 2; ++ai) {
                v4u rw[4][2];
#pragma unroll
                for (int m = 0; m < 4; ++m)
#pragma unroll
                    for (int bj = 0; bj < 2; ++bj) rw[m][bj] = *(const v4u*)(res + (size_t)(row0 + ai * HALF + m * 16) * D + col0 + bj * HALF);
                __builtin_amdgcn_sched_barrier(0);
#pragma unroll
                for (int m = 0; m < 4; ++m) { const size_t off = (size_t)(row0 + ai * HALF + m * 16) * D + col0;
#pragma unroll
                    for (int bj = 0; bj < 2; ++bj) { const v4u w0 = rw[m][bj];
                        const f32x4 v0 = (f32x4){bflo(w0.x), bfhi(w0.x), bflo(w0.y), bfhi(w0.y)} + tof(acc[ai][bj][m][0]), v1 = (f32x4){bflo(w0.z), bfhi(w0.z), bflo(w0.w), bfhi(w0.w)} + tof(acc[ai][bj][m][1]);
                        v4u w; w.x = cvt_pk_bf16(v0[0], v0[1]); w.y = cvt_pk_bf16(v0[2], v0[3]); w.z = cvt_pk_bf16(v1[0], v1[1]); w.w = cvt_pk_bf16(v1[2], v1[3]);
                        *(v4u*)(out + off + bj * HALF) = w; } }
                __builtin_amdgcn_sched_barrier(0);
            }
        } else {
            float gv[2][4];
#pragma unroll
            for (int ai = 0; ai < 2; ++ai)
#pragma unroll
                for (int m = 0; m < 4; ++m) gv[ai][m] = rowgate[row0 + ai * HALF + m * 16] * (1.0f / 512.0f);
            __builtin_amdgcn_sched_barrier(0);
#pragma unroll
            for (int ai = 0; ai < 2; ++ai)
#pragma unroll
                for (int m = 0; m < 4; ++m) { const int row = row0 + ai * HALF + m * 16; const float g = gv[ai][m]; bf16* rowp = Y + (size_t)row * D + col0;
#pragma unroll
                    for (int bj = 0; bj < 2; ++bj) { const f32x4 v0 = tof(acc[ai][bj][m][0]) * g, v1 = tof(acc[ai][bj][m][1]) * g;
                        v4u w; w.x = cvt_pk_bf16(v0[0], v0[1]); w.y = cvt_pk_bf16(v0[2], v0[3]); w.z = cvt_pk_bf16(v1[0], v1[1]); w.w = cvt_pk_bf16(v1[2], v1[3]);
                        *(v4u*)(rowp + bj * HALF) = w; } }
        }
    }
};
}

using pg8::img_off; using pg8::wslot;
struct Args { const float* in[25]; float* out; unsigned char* ws; int step_lo, step_hi; int pad0, pad1; };
struct Frame {
    LAS unsigned char* lds; int tid, lane, wave, G, blk;
    const __attribute__((address_space(4))) Args* ap; GAS float* out; GAS unsigned char* ws;
};
#define KARGS() const __attribute__((address_space(4))) Args* ap_ = F.ap; asm volatile("" : "+s"(ap_))
#define IN(i) (ap_->in[i])
#define WSP ((unsigned char*)F.ws)
#define OUTP ((float*)F.out)
enum { I_X = 0, I_MEM, I_NMIXG, I_NMEMG, I_WIN, I_CONVW, I_ALOG, I_DTB, I_DNG, I_RNG, I_AQG, I_AKG, I_RELB, I_MQG, I_MKG, I_WMKV, I_WOUT, I_NFFG, I_FWG, I_FWU, I_FWD, I_RW, I_MWG, I_MWU, I_MWD };

__device__ __forceinline__ void p0_item(const float* W, int ldw, int K, int nblk, bf16* WT, int row_off, int mode, LAS float* scr, int item, int lane) {
    const int kb = item / nblk, nb = item % nblk, k0 = 64 * kb, n0 = 32 * nb;
    const int drow0 = mode == 0 ? row_off + n0 : ((n0 >> 7) * 256 + (mode - 1) * 128 + (n0 & 127));
    float tv[32];
#pragma unroll
    for (int i = 0; i < 32; ++i) { const int kk = 2 * i + (lane >> 5); tv[i] = __builtin_nontemporal_load(W + (size_t)(k0 + kk) * ldw + n0 + (lane & 31));   }
#pragma unroll
    for (int i = 0; i < 32; ++i) { const int kk = 2 * i + (lane >> 5); scr[kk * 33 + (lane & 31)] = tv[i]; }
    asm volatile("s_waitcnt lgkmcnt(0)" ::: "memory");
    const int c = lane & 7;
#pragma unroll
    for (int j = 0; j < 4; ++j) { const int n = (lane >> 3) + 8 * j; const LAS float* s = scr + (8 * c) * 33 + n;
        v4u o; o.x = pk2(s[0 * 33], s[1 * 33]); o.y = pk2(s[2 * 33], s[3 * 33]); o.z = pk2(s[4 * 33], s[5 * 33]); o.w = pk2(s[6 * 33], s[7 * 33]);
        *(v4u*)((unsigned char*)WT + img_off(wslot(drow0 + n), (k0 + 8 * c) * 2, K * 2)) = o; }
    asm volatile("s_waitcnt lgkmcnt(0)" ::: "memory");
}
__device__ __forceinline__ unsigned pk4_fp8(float a, float b, float c, float d) { unsigned w = 0; w = __builtin_amdgcn_cvt_pk_fp8_f32(a, b, w, false); w = __builtin_amdgcn_cvt_pk_fp8_f32(c, d, w, true); return w; }
__device__ __forceinline__ unsigned pk4_i8(float a, float b, float c, float d) {
    const int x = (int)rintf(fminf(fmaxf(a, -127.f), 127.f)), y = (int)rintf(fminf(fmaxf(b, -127.f), 127.f)), z = (int)rintf(fminf(fmaxf(c, -127.f), 127.f)), w = (int)rintf(fminf(fmaxf(d, -127.f), 127.f));
    return (unsigned)(x & 255) | ((unsigned)(y & 255) << 8) | ((unsigned)(z & 255) << 16) | ((unsigned)w << 24); }
__device__ __forceinline__ void p0_item8(const float* W, int ldw, int K, int nblk, unsigned char* WT, int row_off, int mode, int fmt, LAS float* scr, int item, int lane) {
    const int kb = item / nblk, nb = item % nblk, k0 = 64 * kb, n0 = 32 * nb;
    const int drow0 = mode == 0 ? row_off + n0 : ((n0 >> 7) * 256 + (mode - 1) * 128 + (n0 & 127));
    const float wsc = fmt == 1 ? 64.0f : SW_D;
    float tv[32];
#pragma unroll
    for (int i = 0; i < 32; ++i) { const int kk = 2 * i + (lane >> 5); tv[i] = __builtin_nontemporal_load(W + (size_t)(k0 + kk) * ldw + n0 + (lane & 31));   }
#pragma unroll
    for (int i = 0; i < 32; ++i) { const int kk = 2 * i + (lane >> 5); scr[kk * 33 + (lane & 31)] = tv[i] * wsc; }
    asm volatile("s_waitcnt lgkmcnt(0)" ::: "memory");
    const int c = lane & 7;
#pragma unroll
    for (int j = 0; j < 4; ++j) { const int n = (lane >> 3) + 8 * j; const LAS float* s = scr + (8 * c) * 33 + n;
        v2u o; if (fmt == 1) { o.x = pk4_fp8(s[0 * 33], s[1 * 33], s[2 * 33], s[3 * 33]); o.y = pk4_fp8(s[4 * 33], s[5 * 33], s[6 * 33], s[7 * 33]); }
        else { o.x = pk4_i8(s[0 * 33], s[1 * 33], s[2 * 33], s[3 * 33]); o.y = pk4_i8(s[4 * 33], s[5 * 33], s[6 * 33], s[7 * 33]); }
        *(v2u*)(WT + img_off(wslot(drow0 + n), k0 + 8 * c, K)) = o; }
    asm volatile("s_waitcnt lgkmcnt(0)" ::: "memory");
}
__device__ __forceinline__ void phase_p0(Frame& F) {
    KARGS();
    LAS float* scr = (LAS float*)(F.lds + F.wave * 16384);
    const int gw = F.blk * NWAVES + F.wave, NGW = F.G * NWAVES;
    constexpr int I_MOE1 = 32 * 224, I_MOE = 3 * I_MOE1;
    constexpr int N_MOE = NE * I_MOE;
    constexpr int I_L = 2048 + 4096 + 1024 + 2048;
    constexpr int I_FF = 32 * 176;
    constexpr int NITEMS = N_MOE + 2 * I_L + 3 * I_FF;
    for (int it = gw; it < NITEMS; it += NGW) {
        int r = it;
        if (r < N_MOE) { const int e = r / I_MOE, q = r % I_MOE, which = q / I_MOE1, idx = q % I_MOE1;
            if (which < 2) p0_item8((which == 0 ? IN(I_MWG) : IN(I_MWU)) + (size_t)e * D * DFFE, DFFE, D, DFFE / 32, WSP + WS_MGU + (size_t)e * 2 * DFFE * D, 0, 1 + which, 2, scr, idx, F.lane);
            else p0_item8(IN(I_MWD) + (size_t)e * DFFE * D, D, DFFE, D / 32, WSP + WS_MDN + (size_t)e * D * DFFE, 0, 0, 1, scr, idx, F.lane);
            continue; }
        r -= N_MOE;
        if (r < 2 * I_L) { const int l = r / I_L; int q = r % I_L;
            const float* win = IN(I_WIN) + (size_t)l * D * DIN; unsigned char* wint = WSP + WS_WIN + (size_t)l * NPROJ * D;
#if W_IN_I8
            if (q < 2048) { p0_item8(win, DIN, D, 64, wint, 0, 0, 2, scr, q, F.lane); continue; } q -= 2048;
            if (q < 4096) { p0_item8(win + 2056, DIN, D, 128, wint, 2048, 0, 2, scr, q, F.lane); continue; } q -= 4096;
#else
            if (q < 2048) { p0_item(win, DIN, D, 64, (bf16*)(WSP + WS_WIN) + (size_t)l * NPROJ * D, 0, 0, scr, q, F.lane); continue; } q -= 2048;
            if (q < 4096) { p0_item(win + 2056, DIN, D, 128, (bf16*)(WSP + WS_WIN) + (size_t)l * NPROJ * D, 2048, 0, scr, q, F.lane); continue; } q -= 4096;
#endif
            if (q < 1024) { p0_item(IN(I_WMKV) + (size_t)l * D * 1024, 1024, D, 32, (bf16*)(WSP + WS_WMKV) + (size_t)l * 1024 * D, 0, 0, scr, q, F.lane); continue; } q -= 1024;
            p0_item(IN(I_WOUT) + (size_t)l * D * D, D, D, 64, (bf16*)(WSP + WS_WOUT) + (size_t)l * D * D, 0, 0, scr, q, F.lane); continue; }
        r -= 2 * I_L;
        if (r < I_FF) { p0_item8(IN(I_FWG), DFF, D, DFF / 32, WSP + WS_WGU, 0, 1, 2, scr, r, F.lane); continue; } r -= I_FF;
        if (r < I_FF) { p0_item8(IN(I_FWU), DFF, D, DFF / 32, WSP + WS_WGU, 0, 2, 2, scr, r, F.lane); continue; } r -= I_FF;
        p0_item(IN(I_FWD), D, DFF, D / 32, (bf16*)(WSP + WS_WDN), 0, 0, scr, r, F.lane);
    }
    { float* rc = (float*)(WSP + MS_ROPE); float* rs = rc + SEQ * 64;
      for (int idx = F.blk * NTHREADS + F.tid; idx < SEQ * 64; idx += F.G * NTHREADS) { const int pos = idx >> 6, i = idx & 63;
          const double inv = exp(-(double)i * (9.210340371976184 / 64.0)); const double ang = (double)pos * inv; rc[idx] = (float)cos(ang); rs[idx] = (float)sin(ang); } }
    for (int m = gw; m < 2 * MROWS; m += NGW) { const int l = m / MROWS, row = m % MROWS;
        const f32x4* xr = (const f32x4*)(IN(I_MEM) + (size_t)row * D) + F.lane; const f32x4* gr = (const f32x4*)(IN(I_NMEMG) + (size_t)l * D) + F.lane;
        f32x4 v[8]; float ss = 0.f;
#pragma unroll
        for (int j = 0; j < 8; ++j) { v[j] = xr[64 * j]; ss += (v[j].x * v[j].x + v[j].y * v[j].y) + (v[j].z * v[j].z + v[j].w * v[j].w); }
        const float r = rsqrtf(wave_sum(ss) * (1.0f / D) + EPS);
        unsigned char* o = WSP + MS_MEMH + (size_t)l * MROWS * D * 2;
#pragma unroll
        for (int j = 0; j < 8; ++j) { const f32x4 g = gr[64 * j]; v2u w; w.x = pk2(v[j].x * r * g.x, v[j].y * r * g.y); w.y = pk2(v[j].z * r * g.z, v[j].w * r * g.w); *(v2u*)(o + img_off(row, 512 * j + 8 * F.lane, D * 2)) = w; }
    }
}

__device__ __forceinline__ void phase_rmsnorm(Frame& F, const void* x, int xbf, const float* gain, bf16* out, int mode, int l, int bi, int nb) {
    KARGS();
    LAS float* w8 = (LAS float*)F.lds;
    LAS int* lcnt = (LAS int*)(F.lds + 65536);
    if (mode != 0) {
        for (int idx = F.tid; idx < D * 8; idx += NTHREADS) { const int d = idx >> 3, e = idx & 7;
            w8[e * D + d] = mode == 1 ? IN(I_WIN)[(size_t)l * D * DIN + (size_t)d * DIN + 2048 + e] : IN(I_RW)[d * 8 + e]; }
        if (F.tid < 8) lcnt[F.tid] = 0;
        __syncthreads();
    }
    const int rpb = (T + nb - 1) / nb, row_lo = bi * rpb, nrows = row_lo + rpb <= T ? rpb : (T - row_lo > 0 ? T - row_lo : 0);
    f32x4 g[8];
#pragma unroll
    for (int j = 0; j < 8; ++j) g[j] = ((const f32x4*)gain)[64 * j + F.lane];
    f32x4 nv[8];
#define RMS_LOADROW(rr) do { if (xbf) { const v2u* xr_ = (const v2u*)((const bf16*)x + (size_t)(rr) * D) + F.lane; \
        _Pragma("unroll") for (int j = 0; j < 8; ++j) { const v2u w_ = xr_[64 * j]; nv[j] = (f32x4){bflo(w_.x), bfhi(w_.x), bflo(w_.y), bfhi(w_.y)}; } } \
      else { const f32x4* xr_ = (const f32x4*)((const float*)x + (size_t)(rr) * D) + F.lane; _Pragma("unroll") for (int j = 0; j < 8; ++j) nv[j] = xr_[64 * j]; } } while (0)
    if (F.wave < nrows) RMS_LOADROW(row_lo + F.wave);
    for (int rl = F.wave; rl < nrows; rl += NWAVES) {
        const int row = row_lo + rl;
        f32x4 v[8]; float ss = 0.f;
#pragma unroll
        for (int j = 0; j < 8; ++j) { v[j] = nv[j]; ss += (v[j].x * v[j].x + v[j].y * v[j].y) + (v[j].z * v[j].z + v[j].w * v[j].w); }
        { const int rn = rl + NWAVES < nrows ? row + NWAVES : row; RMS_LOADROW(rn); }
        const float r = rsqrtf(wave_sum(ss) * (1.0f / D) + EPS);
        float amax = 0.f;
#pragma unroll
        for (int j = 0; j < 8; ++j) { v[j] = v[j] * r * g[j]; amax = fmaxf(amax, fmaxf(fmaxf(fabsf(v[j].x), fabsf(v[j].y)), fmaxf(fabsf(v[j].z), fabsf(v[j].w)))); }
        if (!W_IN_I8 && mode == 1) {
#pragma unroll
            for (int j = 0; j < 8; ++j) { v2u w; w.x = pk2(v[j].x, v[j].y); w.y = pk2(v[j].z, v[j].w); *(v2u*)((unsigned char*)out + img_off(row, 512 * j + 8 * F.lane, D * 2)) = w; }
        } else {
        amax = wave_max(amax); const float qs = amax > 0.f ? 127.0f / amax : 0.f;
        if (F.lane == 0) ((float*)(WSP + MS_SA))[row] = amax * (1.0f / 127.0f);
#pragma unroll
        for (int j = 0; j < 8; ++j) *(unsigned*)((unsigned char*)out + img_off(row, 256 * j + 4 * F.lane, D)) = pk4_i8(v[j].x * qs, v[j].y * qs, v[j].z * qs, v[j].w * qs);
        }
        if (mode != 0) {
            float myval = 0.f;
#pragma unroll 1
            for (int e = 0; e < 8; ++e) { float s = 0.f;
#pragma unroll
                for (int j = 0; j < 8; ++j) { const f32x4 w = *(const LAS f32x4*)(w8 + e * D + 256 * j + 4 * F.lane); s += (v[j].x * w.x + v[j].y * w.y) + (v[j].z * w.z + v[j].w * w.w); }
                s = wave_sum(s); if (F.lane == e) myval = s; }
            if (mode == 1) {
                if (F.lane < 8) { float res;
                    if (F.lane < 4) { const float a = IN(I_ALOG)[l * NH + F.lane], db = IN(I_DTB)[l * NH + F.lane]; const float z = myval + db; const float sp = z > 20.f ? z : log1pf(expf(z)); res = -expf(a) * sp; }
                    else res = 1.0f / (1.0f + expf(-myval));
                    ((float*)(WSP + MS_GATES))[(size_t)row * 8 + F.lane] = res; }
            } else {
                float dt[8];
#pragma unroll
                for (int e = 0; e < 8; ++e) dt[e] = __shfl(myval, e);
                int e0 = 0; float l0 = dt[0];
#pragma unroll
                for (int e = 1; e < 8; ++e) if (dt[e] > l0) { l0 = dt[e]; e0 = e; }
                int e1 = -1; float l1 = -3.0e38f;
#pragma unroll
                for (int e = 0; e < 8; ++e) if (e != e0 && dt[e] > l1) { l1 = dt[e]; e1 = e; }
                if (F.lane == 0) { const float ex = expf(l1 - l0); const float g0 = 1.0f / (1.0f + ex), g1 = ex / (1.0f + ex);
                    ((int*)(WSP + MS_TOPE))[row * 2] = e0; ((int*)(WSP + MS_TOPE))[row * 2 + 1] = e1;
                    ((float*)(WSP + MS_TOPG))[row * 2] = g0; ((float*)(WSP + MS_TOPG))[row * 2 + 1] = g1;
                    __hip_atomic_fetch_add(&lcnt[e0], 1, __ATOMIC_RELAXED, __HIP_MEMORY_SCOPE_WORKGROUP); __hip_atomic_fetch_add(&lcnt[e1], 1, __ATOMIC_RELAXED, __HIP_MEMORY_SCOPE_WORKGROUP); }
            }
        }
    }
    if (mode == 2) { __syncthreads(); if (F.tid < 8) ((int*)(WSP + MS_CNT))[F.blk * 8 + F.tid] = lcnt[F.tid]; }
    __syncthreads();
}

__device__ __forceinline__ void phase_prep(Frame& F, int l) {
    KARGS();
    bf16* proj = (bf16*)(WSP + SC_PROJ); bf16* conva = (bf16*)(WSP + SC_CONVA); bf16* kvm = (bf16*)(WSP + MS_KVM) + (size_t)l * MROWS * 1024;
    const float* convw = IN(I_CONVW) + (size_t)l * 4 * 1536;
    const float* rc = (const float*)(WSP + MS_ROPE); const float* rs = rc + SEQ * 64;
    const int gw = F.blk * NWAVES + F.wave, NGW = F.G * NWAVES;
    const int lane = F.lane, li = lane & 15, d0 = li * 8;
    const float qscale = 0.08838834764831845f;
    LAS bf16* vt = (LAS bf16*)(F.lds + F.wave * 16896);
    for (int it = T * 8 + gw; it < T * 8 + MROWS + 1152; it += NGW) {
        if (it >= T * 8 + MROWS) {
            const int vi = it - (T * 8 + MROWS); const bf16* src; bf16* dst; int lds_;
            if (vi < 1024) { const int b = vi >> 7, h = (vi >> 5) & 3, c = vi & 31; src = proj + (size_t)(b * SEQ + c * CH) * NPROJ + C_VC + h * HD; lds_ = NPROJ; dst = (bf16*)(WSP + SC_VCT) + (size_t)vi * 8192; }
            else { const int mi = vi - 1024, b = mi >> 4, h = (mi >> 2) & 3, c = mi & 3; src = kvm + (size_t)(b * NMEM + c * CH) * 1024 + 512 + h * HD; lds_ = 1024; dst = (bf16*)(WSP + MS_VMT) + (size_t)mi * 8192; }
#pragma unroll 4
            for (int i = 0; i < 16; ++i) { const int row = 4 * i + (lane >> 4); const v4u w = *(const v4u*)(src + (size_t)row * lds_ + li * 8);
                LAS v2u* d = (LAS v2u*)(vt + row * 132 + li * 8); d[0] = (v2u){w.x, w.y}; d[1] = (v2u){w.z, w.w}; }
            asm volatile("s_waitcnt lgkmcnt(0)" ::: "memory");
            const int q4 = lane >> 4;
#pragma unroll 2
            for (int f = 0; f < 16; ++f) { const int mt8 = f >> 1, kt = f & 1; const LAS bf16* p = vt + (32 * kt + 4 * q4) * 132 + 16 * mt8 + li;
                v4u w; w.x = (unsigned)p[0] | ((unsigned)p[132] << 16); w.y = (unsigned)p[2 * 132] | ((unsigned)p[3 * 132] << 16);
                w.z = (unsigned)p[16 * 132] | ((unsigned)p[17 * 132] << 16); w.w = (unsigned)p[18 * 132] | ((unsigned)p[19 * 132] << 16);
                *(v4u*)(dst + (size_t)(f * 64 + lane) * 8) = w; }
            asm volatile("s_waitcnt lgkmcnt(0)" ::: "memory");
            continue; }
        if (it >= T * 8) {
            const int row = it - T * 8; bf16* p = kvm + (size_t)row * 1024 + lane * 8; float f[8]; unpack8(*(const v4u*)p, f);
            float ss = 0.f;
#pragma unroll
            for (int j = 0; j < 8; ++j) ss += f[j] * f[j];
            const float r = rsqrtf(grp16_sum(ss) * (1.0f / HD) + EPS); const float* gn = IN(I_MKG) + l * HD + d0;
#pragma unroll
            for (int j = 0; j < 8; ++j) f[j] = f[j] * r * gn[j];
            *(v4u*)p = pack8(f); continue; }
    }
    const int grp = gw & 7, tstart = gw >> 3, tstride = NGW >> 3;
    if (grp < 3) {
        const int c0 = grp * 512 + lane * 8; float w[4][8];
#pragma unroll
        for (int tap = 0; tap < 4; ++tap) { const f32x4 w0 = *(const f32x4*)(convw + tap * 1536 + c0), w1 = *(const f32x4*)(convw + tap * 1536 + c0 + 4);
            w[tap][0] = w0.x; w[tap][1] = w0.y; w[tap][2] = w0.z; w[tap][3] = w0.w; w[tap][4] = w1.x; w[tap][5] = w1.y; w[tap][6] = w1.z; w[tap][7] = w1.w; }
        for (int tb = tstart; tb < T; tb += 4 * tstride) {
            v4u xin[4][4];
#pragma unroll
            for (int u = 0; u < 4; ++u) { const int t = tb + u * tstride, pos = t & (SEQ - 1);
#pragma unroll
                for (int tap = 0; tap < 4; ++tap) { const int dp = pos - 3 + tap; const int tt = dp >= 0 ? t - 3 + tap : t;
                    xin[u][tap] = *(const v4u*)(proj + (size_t)tt * NPROJ + c0); } }
#pragma unroll
            for (int u = 0; u < 4; ++u) { const int t = tb + u * tstride, pos = t & (SEQ - 1); float a[8];
#pragma unroll
                for (int j = 0; j < 8; ++j) a[j] = 0.f;
#pragma unroll
                for (int tap = 0; tap < 4; ++tap) { float f[8]; unpack8(xin[u][tap], f); const float en = (pos - 3 + tap >= 0) ? 1.f : 0.f;
#pragma unroll
                    for (int j = 0; j < 8; ++j) a[j] += f[j] * (w[tap][j] * en); }
#pragma unroll
                for (int j = 0; j < 8; ++j) a[j] = silu_f(a[j]);
                if (grp < 2) { float ss = 0.f;
#pragma unroll
                    for (int j = 0; j < 8; ++j) ss += a[j] * a[j];
                    float r = rsqrtf(grp16_sum(ss) + EPS); if (grp == 0) r *= qscale;
#pragma unroll
                    for (int j = 0; j < 8; ++j) a[j] *= r; }
                *(v4u*)(conva + (size_t)t * 1536 + c0) = pack8(a); }
        }
    } else if (grp < 5) {
        const int i0 = (li & 7) * 8; const int col = (grp == 3 ? C_QB : C_KB) + lane * 8;
        for (int tb = tstart; tb < T; tb += 4 * tstride) {
            v4u xin[4]; f32x4 cs[4][4];
#pragma unroll
            for (int u = 0; u < 4; ++u) { const int t = tb + u * tstride, pos = t & (SEQ - 1); xin[u] = *(const v4u*)(proj + (size_t)t * NPROJ + col);
                cs[u][0] = *(const f32x4*)(rc + pos * 64 + i0); cs[u][1] = *(const f32x4*)(rc + pos * 64 + i0 + 4); cs[u][2] = *(const f32x4*)(rs + pos * 64 + i0); cs[u][3] = *(const f32x4*)(rs + pos * 64 + i0 + 4); }
#pragma unroll
            for (int u = 0; u < 4; ++u) { const int t = tb + u * tstride; float f[8], o[8]; unpack8(xin[u], f);
                const float c[8] = {cs[u][0].x, cs[u][0].y, cs[u][0].z, cs[u][0].w, cs[u][1].x, cs[u][1].y, cs[u][1].z, cs[u][1].w}, sn[8] = {cs[u][2].x, cs[u][2].y, cs[u][2].z, cs[u][2].w, cs[u][3].x, cs[u][3].y, cs[u][3].z, cs[u][3].w};
#pragma unroll
                for (int j = 0; j < 8; ++j) { const float other = __shfl_xor(f[j], 8); o[j] = li < 8 ? f[j] * c[j] - other * sn[j] : f[j] * c[j] + other * sn[j]; }
                if (grp == 4) {
#pragma unroll
                    for (int j = 0; j < 8; ++j) o[j] *= qscale; }
                *(v4u*)(proj + (size_t)t * NPROJ + col) = pack8(o); }
        }
    } else {
        const int col = (grp == 5 ? C_QC : (grp == 6 ? C_KC : C_QM)) + lane * 8; const float* gn = (grp == 5 ? IN(I_AQG) : (grp == 6 ? IN(I_AKG) : IN(I_MQG))) + l * HD + d0;
        float gv[8];
#pragma unroll
        for (int j = 0; j < 8; ++j) gv[j] = gn[j] * (grp != 6 ? qscale : 1.0f);
        for (int tb = tstart; tb < T; tb += 4 * tstride) {
            v4u xin[4];
#pragma unroll
            for (int u = 0; u < 4; ++u) xin[u] = *(const v4u*)(proj + (size_t)(tb + u * tstride) * NPROJ + col);
#pragma unroll
            for (int u = 0; u < 4; ++u) { float f[8]; unpack8(xin[u], f); float ss = 0.f;
#pragma unroll
                for (int j = 0; j < 8; ++j) ss += f[j] * f[j];
                const float r = rsqrtf(grp16_sum(ss) * (1.0f / HD) + EPS);
#pragma unroll
                for (int j = 0; j < 8; ++j) f[j] = f[j] * r * gv[j];
                *(v4u*)(proj + (size_t)(tb + u * tstride) * NPROJ + col) = pack8(f); }
        }
    }
}

__device__ __forceinline__ void phase_attn_naive(Frame& F, int l) {
    KARGS();
    const bf16* proj = (const bf16*)(WSP + SC_PROJ); const bf16* kvm = (const bf16*)(WSP + MS_KVM) + (size_t)l * MROWS * 1024; bf16* mix = (bf16*)(WSP + WS_HB);
    LAS float* sq = (LAS float*)F.lds + F.wave * 128;
    LAS float* sp = (LAS float*)(F.lds + 4096) + F.wave * 640;
    const float* relb = IN(I_RELB) + (size_t)l * NH * RELW;
    for (int u = F.blk; u < 2 * NB * NH * NCHUNK; u += F.G) {
        const int kind = u / (NB * NH * NCHUNK), r = u % (NB * NH * NCHUNK), b = r / (NH * NCHUNK), h = (r / NCHUNK) % NH, n = r % NCHUNK;
        const int c0 = kind == 0 ? (n - NPREV < 0 ? 0 : n - NPREV) : 0; const int nk = kind == 0 ? CH * (n - c0 + 1) : NMEM;
        const bf16* kb = kind == 0 ? proj + (size_t)(b * SEQ + c0 * CH) * NPROJ + C_KC + h * HD : kvm + (size_t)(b * NMEM) * 1024 + h * HD;
        const bf16* vb = kind == 0 ? proj + (size_t)(b * SEQ + c0 * CH) * NPROJ + C_VC + h * HD : kvm + (size_t)(b * NMEM) * 1024 + 512 + h * HD;
        const int ld = kind == 0 ? NPROJ : 1024;
        for (int qi = 0; qi < 8; ++qi) {
            const int ql = F.wave * 8 + qi, t = b * SEQ + n * CH + ql;
            const bf16* qp = proj + (size_t)t * NPROJ + (kind == 0 ? C_QC : C_QM) + h * HD;
            { const unsigned w = ((const unsigned*)qp)[F.lane]; sq[2 * F.lane] = bflo(w); sq[2 * F.lane + 1] = bfhi(w); }
            asm volatile("s_waitcnt lgkmcnt(0)" ::: "memory");
            float mx = -3.0e38f;
            for (int kk = F.lane; kk < nk; kk += 64) { const v4u* kr = (const v4u*)(kb + (size_t)kk * ld); float s = 0.f;
#pragma unroll
                for (int c = 0; c < 16; ++c) { float f[8]; unpack8(kr[c], f);
#pragma unroll
                    for (int j = 0; j < 8; ++j) s += f[j] * sq[c * 8 + j]; }
                if (kind == 0) { int rel = (n * CH + ql) - (c0 * CH + kk); rel = rel < -128 ? -128 : (rel > 128 ? 128 : rel); s += relb[h * RELW + rel + 128]; }
                sp[kk] = s; mx = fmaxf(mx, s); }
            mx = wave_max(mx); float sum = 0.f;
            for (int kk = F.lane; kk < nk; kk += 64) { const float p = __expf(sp[kk] - mx); sp[kk] = p; sum += p; }
            sum = wave_sum(sum); const float inv = 1.0f / sum;
            asm volatile("s_waitcnt lgkmcnt(0)" ::: "memory");
            float o0 = 0.f, o1 = 0.f;
            for (int kk = 0; kk < nk; ++kk) { const float p = sp[kk]; const unsigned w = *(const unsigned*)(vb + (size_t)kk * ld + 2 * F.lane); o0 += p * bflo(w); o1 += p * bfhi(w); }
            *(unsigned*)(mix + (size_t)t * D + (kind == 0 ? 1024 : 1536) + h * HD + 2 * F.lane) = pk2(o0 * inv, o1 * inv);
            asm volatile("s_waitcnt lgkmcnt(0)" ::: "memory");
        }
    }
}

__device__ __forceinline__ void phase_recur_naive(Frame& F, int l) {
    if (F.blk >= 2 * NB * NH) return;
    const int kind = F.blk / (NB * NH), b = (F.blk / NH) % NB, h = F.blk % NH;
    const bf16* proj = (const bf16*)(WSP + SC_PROJ); const bf16* conva = (const bf16*)(WSP + SC_CONVA); const float* gates = (const float*)(WSP + MS_GATES);
    float* obuf = (float*)(WSP + SC_OBUF);
    LAS float* sk = (LAS float*)F.lds; LAS float* sqv = sk + 128; LAS float* sv = sk + 256; LAS float* red = sk + 384; LAS float* red2 = sk + 896; LAS float* sab = sk + 1408;
    const int v = F.tid & 127, kg = F.tid >> 7;
    float s[32];
#pragma unroll
    for (int i = 0; i < 32; ++i) s[i] = 0.f;
    const float gam = 1.0f - exp2f(-5.0f - (float)h);
    const bf16* qb = kind == 0 ? conva + C_QA + h * HD : proj + C_QB + h * HD; const bf16* kb = kind == 0 ? conva + 512 + h * HD : proj + C_KB + h * HD; const bf16* vb = kind == 0 ? conva + 1024 + h * HD : proj + C_VB + h * HD;
    const int ld = kind == 0 ? 1536 : NPROJ;
    bf16 pk_ = 0, pq_ = 0, pv_ = 0; float pg_ = 0.f, pb_ = 0.f;
    { const int t = b * SEQ; if (F.tid < 128) { pk_ = kb[(size_t)t * ld + F.tid]; pq_ = qb[(size_t)t * ld + F.tid]; pv_ = vb[(size_t)t * ld + F.tid]; } if (kind == 0) { pg_ = gates[(size_t)t * 8 + h]; pb_ = gates[(size_t)t * 8 + 4 + h]; } }
    for (int tt = 0; tt < SEQ; ++tt) {
        const int t = b * SEQ + tt;
        if (F.tid < 128) { sk[F.tid] = bf2f(pk_); sqv[F.tid] = bf2f(pq_); sv[F.tid] = bf2f(pv_); }
        if (F.tid == 0) { if (kind == 0) { sab[0] = expf(pg_); sab[1] = pb_; } else { sab[0] = gam; sab[1] = 0.f; } }
        if (tt + 1 < SEQ) { const int t1 = t + 1; if (F.tid < 128) { pk_ = kb[(size_t)t1 * ld + F.tid]; pq_ = qb[(size_t)t1 * ld + F.tid]; pv_ = vb[(size_t)t1 * ld + F.tid]; } if (kind == 0) { pg_ = gates[(size_t)t1 * 8 + h]; pb_ = gates[(size_t)t1 * 8 + 4 + h]; } }
        __syncthreads();
        const float a = sab[0], bb = sab[1], bp = kind == 0 ? bb : 1.0f;
        float part = 0.f;
#pragma unroll
        for (int i = 0; i < 32; ++i) part += sk[kg * 32 + i] * s[i];
        red[kg * 128 + v] = part;
        __syncthreads();
        const float ks = (red[v] + red[128 + v]) + (red[256 + v] + red[384 + v]);
        const float dl = bp * sv[v] - a * bb * ks;
        float p2 = 0.f;
#pragma unroll
        for (int i = 0; i < 32; ++i) { s[i] = a * s[i] + sk[kg * 32 + i] * dl; p2 += sqv[kg * 32 + i] * s[i]; }
        red2[kg * 128 + v] = p2;
        __syncthreads();
        if (kg == 0) obuf[(size_t)t * 1024 + kind * 512 + h * HD + v] = (red2[v] + red2[128 + v]) + (red2[256 + v] + red2[384 + v]);
    }
}


template <int MT, int KS, int NTHR>
__device__ __forceinline__ void write_frags(const LAS bf16* X, int ldx, bf16* dst, int t0) {
    v2u lo[MT * KS * 64 / NTHR], hi[MT * KS * 64 / NTHR];
#pragma unroll
    for (int it = 0; it < MT * KS * 64 / NTHR; ++it) { const int idx = t0 + it * NTHR, ln = idx & 63, ks = (idx >> 6) % KS, mt = (idx >> 6) / KS, c16 = ln & 15, q4 = ln >> 4;
        const LAS bf16* p = X + (16 * mt + c16) * ldx + 32 * ks + 4 * q4; lo[it] = *(const LAS v2u*)p; hi[it] = *(const LAS v2u*)(p + 16); }
#pragma unroll
    for (int it = 0; it < MT * KS * 64 / NTHR; ++it) { const int idx = t0 + it * NTHR; *(v4u*)(dst + (size_t)idx * 8) = (v4u){lo[it].x, lo[it].y, hi[it].x, hi[it].y}; }
}
template <int I, int H> __device__ __forceinline__ void c1_load(f32x4 (&dst)[8], const LAS float* Lm) {
#pragma unroll
    for (int jj = 0; jj < 8; ++jj) { constexpr int dummy = 0; const int j4 = 8 * H + jj; if (j4 < (I + 3) / 4) dst[jj] = *(const LAS f32x4*)(Lm + I * 64 + 4 * j4); (void)dummy; }
}
template <int I, int H> __device__ __forceinline__ void c1_comp(const f32x4 (&src)[8], const float (&x)[64], float& a0, float& a1, float& a2, float& a3) {
#pragma unroll
    for (int jj = 0; jj < 8; ++jj) { const int j4 = 8 * H + jj; if (j4 < (I + 3) / 4) { const f32x4 lv = src[jj];
        if (4 * j4 + 0 < I) a0 += lv.x * x[4 * j4 + 0]; if (4 * j4 + 1 < I) a1 += lv.y * x[4 * j4 + 1]; if (4 * j4 + 2 < I) a2 += lv.z * x[4 * j4 + 2]; if (4 * j4 + 3 < I) a3 += lv.w * x[4 * j4 + 3]; } }
}
template <int I> struct C1Rows {
    static __device__ __forceinline__ void run(float (&x)[64], f32x4 (&la)[8], f32x4 (&lb)[8], const LAS float* Lm) {
        float a0 = 0.f, a1 = 0.f, a2 = 0.f, a3 = 0.f;
        c1_load<I, 1>(lb, Lm);
        __builtin_amdgcn_sched_barrier(0);
        c1_comp<I, 0>(la, x, a0, a1, a2, a3);
        __builtin_amdgcn_sched_barrier(0);
        if (I + 1 < 64) c1_load<(I + 1 < 64 ? I + 1 : 63), 0>(la, Lm);
        __builtin_amdgcn_sched_barrier(0);
        c1_comp<I, 1>(lb, x, a0, a1, a2, a3);
        x[I] = x[I] - ((a0 + a1) + (a2 + a3));
        __builtin_amdgcn_sched_barrier(0);
        C1Rows<I + 1>::run(x, la, lb, Lm);
    }
};
template <> struct C1Rows<64> { static __device__ __forceinline__ void run(float (&)[64], f32x4 (&)[8], f32x4 (&)[8], const LAS float*) {} };
constexpr int C1_HSZ = 77824;
__device__ __forceinline__ void phase_c1(Frame& F, int l) {
    const bf16* proj = (const bf16*)(WSP + SC_PROJ); const bf16* conva = (const bf16*)(WSP + SC_CONVA); const float* gates = (const float*)(WSP + MS_GATES);
    const int lane = F.lane, wave = F.wave, c16 = lane & 15, q4 = lane >> 4;
    const int hb = wave >> 2, lw = wave & 3, lt = F.tid & 255;
    LAS unsigned char* hl = F.lds + hb * C1_HSZ;
    LAS float* Lm = (LAS float*)hl; LAS float* Lm_u = Lm;
    LAS bf16* Xa = (LAS bf16*)(hl + 16384);
    LAS bf16* Xk = (LAS bf16*)(hl + 25088);
    LAS float* sgc = (LAS float*)(hl + 42496); LAS float* sbeta = sgc + 64; LAS float* seg = sgc + 128; LAS float* sbeta_u = sbeta; LAS float* seg_u = seg;
    LAS bf16* Xkr = (LAS bf16*)(hl + 43264);
    LAS bf16* Xw = Xkr;
    LAS bf16* Xv = (LAS bf16*)(hl + 60160);
    for (int u0 = F.blk; u0 < 2048; u0 += 2 * F.G) {
        const int uu = u0 + hb * F.G; const bool act = uu < 2048; const int u = act ? uu : 0;
        const int kind = u >> 10, r = u & 1023, b = r >> 7, h = (r >> 5) & 3, n = r & 31, t0 = b * SEQ + n * CH;
        const bf16* qb = kind == 0 ? conva + h * HD : proj + C_QB + h * HD; const bf16* kb = kind == 0 ? conva + 512 + h * HD : proj + C_KB + h * HD; const bf16* vb = kind == 0 ? conva + 1024 + h * HD : proj + C_VB + h * HD;
        const int ld = kind == 0 ? 1536 : NPROJ;
        unsigned char* rec = WSP + SC_PRE + (size_t)(kind * 1024 + (b * NH + h) * 32 + n) * REC_BYTES;
        bf16x8 qa[4];
        { const bf16* xq = qb + (size_t)(t0 + 16 * lw + c16) * ld + 8 * q4;
#pragma unroll
          for (int ks = 0; ks < 4; ++ks) qa[ks] = *(const bf16x8*)(xq + 32 * ks); }
        v4u qv[4], kv[4], vv[4];
        { const int row = lt >> 2, cb = (lt & 3) * 32; const size_t o = (size_t)(t0 + row) * ld + cb;
#pragma unroll
          for (int i = 0; i < 4; ++i) { qv[i] = *(const v4u*)(qb + o + 8 * i); kv[i] = *(const v4u*)(kb + o + 8 * i); vv[i] = *(const v4u*)(vb + o + 8 * i); } }
        if (lw == 0) { float g, be;
            if (kind == 0) { g = gates[(size_t)(t0 + lane) * 8 + h]; be = gates[(size_t)(t0 + lane) * 8 + 4 + h]; } else { g = log1pf(-exp2f(-5.0f - (float)h)); be = 1.0f; }
#pragma unroll
            for (int o = 1; o < 64; o <<= 1) { const float y = __shfl_up(g, o); if (lane >= o) g += y; }
            sgc[lane] = g; sbeta[lane] = be; seg[lane] = __expf(g);
            if (lane == 63 && act) ((float*)(WSP + MS_GTOT))[kind * 1024 + (b * NH + h) * 32 + n] = __expf(g); }
        __syncthreads();
        { const int row = lt >> 2, ksq = lt & 3, cb = ksq * 32; const float eq = seg[row], ek = __expf(sgc[63] - sgc[row]);
          float f[32];
#pragma unroll
          for (int i = 0; i < 4; ++i) { float t8[8]; unpack8(qv[i], t8);
#pragma unroll
              for (int j = 0; j < 8; ++j) f[8 * i + j] = t8[j] * eq; }
          if (act) { bf16* dq = (bf16*)(rec + REC_QF) + (size_t)((((row >> 4) * 4 + ksq) * 64) + (row & 15)) * 8;
#pragma unroll
              for (int qq = 0; qq < 4; ++qq) *(v4u*)(dq + (size_t)qq * 16 * 8) = (v4u){pk2(f[4 * qq], f[4 * qq + 1]), pk2(f[4 * qq + 2], f[4 * qq + 3]), pk2(f[16 + 4 * qq], f[16 + 4 * qq + 1]), pk2(f[16 + 4 * qq + 2], f[16 + 4 * qq + 3])}; }
          { LAS v2u* d = (LAS v2u*)(Xkr + row * 132 + cb);
#pragma unroll
            for (int i = 0; i < 4; ++i) { d[2 * i] = (v2u){kv[i].x, kv[i].y}; d[2 * i + 1] = (v2u){kv[i].z, kv[i].w}; } }
          { LAS v2u* d = (LAS v2u*)(Xv + row * 132 + cb);
#pragma unroll
            for (int i = 0; i < 4; ++i) { d[2 * i] = (v2u){vv[i].x, vv[i].y}; d[2 * i + 1] = (v2u){vv[i].z, vv[i].w}; } }
#pragma unroll
          for (int i = 0; i < 4; ++i) { float t8[8]; unpack8(kv[i], t8);
#pragma unroll
              for (int j = 0; j < 8; ++j) Xk[(cb + 8 * i + j) * 68 + row] = (bf16)f2bf(t8[j] * ek); } }
        __syncthreads();
        { const int mt = lw;
            bf16x8 bfr[16];
#pragma unroll
            for (int nt = 0; nt < 4; ++nt)
#pragma unroll
                for (int ks = 0; ks < 4; ++ks) { const LAS bf16* pb = Xkr + (16 * nt + c16) * 132 + 32 * ks + 8 * q4; const v2u lo = *(const LAS v2u*)pb, hi = *(const LAS v2u*)(pb + 4); bfr[nt * 4 + ks] = __builtin_bit_cast(bf16x8, (v4u){lo.x, lo.y, hi.x, hi.y}); }
#pragma unroll 1
            for (int mat = 0; mat < (kind == 0 ? 2 : 1); ++mat) {
                bf16x8 af[4];
                if (mat == 0) {
#pragma unroll
                    for (int ks = 0; ks < 4; ++ks) af[ks] = qa[ks];
                } else {
#pragma unroll
                    for (int ks = 0; ks < 4; ++ks) { const LAS bf16* pa = Xkr + (16 * mt + c16) * 132 + 32 * ks + 8 * q4; const v2u lo = *(const LAS v2u*)pa, hi = *(const LAS v2u*)(pa + 4); af[ks] = __builtin_bit_cast(bf16x8, (v4u){lo.x, lo.y, hi.x, hi.y}); } }
#pragma unroll
                for (int nt = 0; nt < 4; ++nt) { f32x4 acc = {0.f, 0.f, 0.f, 0.f};
#pragma unroll
                    for (int ks = 0; ks < 4; ++ks) acc = __builtin_amdgcn_mfma_f32_16x16x32_bf16(af[ks], bfr[nt * 4 + ks], acc, 0, 0, 0);
                    const int j = 16 * nt + c16; const float gj = sgc[j];
#pragma unroll
                    for (int rr = 0; rr < 4; ++rr) { const int i = 16 * mt + 4 * q4 + rr; const float dec = j <= i ? __expf(sgc[i] - gj) : 0.f;
                        if (mat == 0) Xa[i * 68 + j] = (bf16)f2bf(acc[rr] * dec); else Lm[i * 64 + j] = j < i ? acc[rr] * dec * sbeta[i] : 0.f; } } } }
        __syncthreads();
        if (act) { write_frags<4, 2, 256>(Xa, 68, (bf16*)(rec + REC_AF), lt); write_frags<8, 2, 256>(Xk, 68, (bf16*)(rec + REC_KF), lt); }
        { const int c = lt;
            int vz = 0; asm volatile("" : "+v"(vz));
            const LAS float* sbeta = sbeta_u + vz; const LAS float* seg = seg_u + vz; const LAS float* Lm = Lm_u + vz;
            if (kind == 0) { float x[64]; const LAS bf16* src = c < 128 ? Xv + c : Xkr + (c - 128);
#pragma unroll
                for (int i = 0; i < 64; ++i) { float rhs = bf2f(src[i * 132]) * sbeta[i]; if (c >= 128) rhs *= seg[i]; x[i] = rhs; }
                { f32x4 la[8], lb[8]; c1_load<1, 0>(la, Lm); C1Rows<1>::run(x, la, lb, Lm); }
                if (c < 128) { const int nt = c >> 4, cc = c & 15;
                    if (act) {
#pragma unroll
                    for (int mt = 0; mt < 4; ++mt)
#pragma unroll
                        for (int qq = 0; qq < 4; ++qq) *(f32x4*)(rec + REC_U + (size_t)(((nt * 4 + mt) * 64) + 16 * qq + cc) * 16) = (f32x4){x[16 * mt + 4 * qq], x[16 * mt + 4 * qq + 1], x[16 * mt + 4 * qq + 2], x[16 * mt + 4 * qq + 3]}; }
                } else {
#pragma unroll
                    for (int i = 0; i < 64; ++i) Xw[i * 132 + (c - 128)] = (bf16)f2bf(x[i]); }
            } else if (c < 128 && act) { const int nt = c >> 4, cc = c & 15;
#pragma unroll 1
                for (int i4 = 0; i4 < 16; ++i4) { const int mt = i4 >> 2, qq = i4 & 3; const LAS bf16* p = Xv + (4 * i4) * 132 + c;
                    *(f32x4*)(rec + REC_U + (size_t)(((nt * 4 + mt) * 64) + 16 * qq + cc) * 16) = (f32x4){bf2f(p[0]), bf2f(p[132]), bf2f(p[264]), bf2f(p[396])}; } }
        }
        __syncthreads();
        if (kind == 0 && act) write_frags<4, 4, 256>(Xw, 132, (bf16*)(rec + REC_WF), lt);
        __syncthreads();
    }
}
__device__ __forceinline__ bf16x8 pack_b(const f32x4 a, const f32x4 b) {
    v4u w; w.x = pg8::cvt_pk_bf16(a[0], a[1]); w.y = pg8::cvt_pk_bf16(a[2], a[3]); w.z = pg8::cvt_pk_bf16(b[0], b[1]); w.w = pg8::cvt_pk_bf16(b[2], b[3]); return __builtin_bit_cast(bf16x8, w); }
__device__ __forceinline__ void scan_dma(const unsigned char* rec, int pair, LAS unsigned char* buf, int wave, int lane) {
#pragma unroll
    for (int k = 0; k < 8; ++k) { const int i = wave * 8 + k;
        const unsigned char* src = i < 56 ? rec + i * 1024 : rec + REC_U + pair * 8192 + (i - 56) * 1024;
        __builtin_amdgcn_global_load_lds((const unsigned*)(src + lane * 16), (LAS unsigned*)(buf + i * 1024), 16, 0, 0); }
}
template <int BUF>
__device__ __forceinline__ void scan_step(LAS unsigned char* lds, f32x4 (&S)[8], const int kind, const float gt, float* op, const int wave, const int lane) {
    const LAS unsigned char* buf = lds + BUF * 65536;
    const LAS bf16x8* Qf = (const LAS bf16x8*)(buf + REC_QF) + lane; const LAS bf16x8* Kf = (const LAS bf16x8*)(buf + REC_KF) + lane;
    const LAS bf16x8* Af = (const LAS bf16x8*)(buf + REC_AF) + lane; const LAS bf16x8* Wf = (const LAS bf16x8*)(buf + REC_WF) + lane;
    const LAS f32x4* Uf = (const LAS f32x4*)(buf + 57344 + wave * 4096) + lane;
    bf16x8 Sb[4];
#pragma unroll
    for (int ks = 0; ks < 4; ++ks) Sb[ks] = pack_b(S[2 * ks], S[2 * ks + 1]);
    f32x4 vn[4]; bf16x8 fa[16], fb[8];
#pragma unroll
    for (int mt = 0; mt < 4; ++mt) vn[mt] = Uf[mt * 64];
    if (kind == 0) {
#pragma unroll
        for (int i = 0; i < 16; ++i) fa[i] = Wf[i * 64];
        __builtin_amdgcn_sched_barrier(0);
#pragma unroll
        for (int mt = 0; mt < 4; ++mt) { f32x4 acc = {0.f, 0.f, 0.f, 0.f};
#pragma unroll
            for (int ks = 0; ks < 4; ++ks) acc = __builtin_amdgcn_mfma_f32_16x16x32_bf16(fa[mt * 4 + ks], Sb[ks], acc, 0, 0, 0);
            vn[mt] = vn[mt] - acc; } }
#pragma unroll
    for (int i = 0; i < 16; ++i) fa[i] = Qf[i * 64];
#pragma unroll
    for (int i = 0; i < 8; ++i) fb[i] = Af[i * 64];
    __builtin_amdgcn_sched_barrier(0);
    bf16x8 Vb[2]; Vb[0] = pack_b(vn[0], vn[1]); Vb[1] = pack_b(vn[2], vn[3]);
    f32x4 o[4];
#pragma unroll
    for (int mt = 0; mt < 4; ++mt) { o[mt] = (f32x4){0.f, 0.f, 0.f, 0.f};
#pragma unroll
        for (int ks = 0; ks < 4; ++ks) o[mt] = __builtin_amdgcn_mfma_f32_16x16x32_bf16(fa[mt * 4 + ks], Sb[ks], o[mt], 0, 0, 0);
#pragma unroll
        for (int kt = 0; kt < 2; ++kt) o[mt] = __builtin_amdgcn_mfma_f32_16x16x32_bf16(fb[mt * 2 + kt], Vb[kt], o[mt], 0, 0, 0); }
    __builtin_amdgcn_sched_barrier(0);
#pragma unroll
    for (int i = 0; i < 16; ++i) fa[i] = Kf[i * 64];
#pragma unroll
    for (int mt = 0; mt < 4; ++mt) { float* p = op + (size_t)mt * 16 * 1024; p[0] = o[mt][0]; p[1024] = o[mt][1]; p[2048] = o[mt][2]; p[3072] = o[mt][3]; }
    __builtin_amdgcn_sched_barrier(0);
#pragma unroll
    for (int m8 = 0; m8 < 8; ++m8) { f32x4 a = S[m8] * gt;
#pragma unroll
        for (int kt = 0; kt < 2; ++kt) a = __builtin_amdgcn_mfma_f32_16x16x32_bf16(fa[m8 * 2 + kt], Vb[kt], a, 0, 0, 0);
        S[m8] = a; }
}
__device__ __forceinline__ void phase_scan(Frame& F, int l) {
    float* obuf = (float*)(WSP + SC_OBUF); const float* gtot = (const float*)(WSP + MS_GTOT);
    const int lane = F.lane, c16 = lane & 15, q4 = lane >> 4, wave = F.wave;
    for (int cb = F.blk; cb < 256; cb += F.G) {
        const int grp = (cb & 7) * 8 + (cb >> 5), pair = (cb >> 3) & 3, kind = grp >> 5, bh = grp & 31, b = bh >> 2, h = bh & 3, s8 = pair * 2 + wave;
        const unsigned char* rec0 = WSP + SC_PRE + (size_t)(kind * 1024 + bh * 32) * REC_BYTES;
        const float gtv = gtot[kind * 1024 + bh * 32 + (lane & 31)];
        float* op0 = obuf + (size_t)(b * SEQ + 4 * q4) * 1024 + kind * 512 + h * HD + 16 * s8 + c16;
        f32x4 S[8];
#pragma unroll
        for (int i = 0; i < 8; ++i) S[i] = (f32x4){0.f, 0.f, 0.f, 0.f};
        scan_dma(rec0, pair, F.lds, wave, lane);
#pragma unroll 1
        for (int n = 0; n < NCHUNK; n += 2) {
            asm volatile("s_waitcnt vmcnt(0)" ::: "memory"); __builtin_amdgcn_s_barrier(); asm volatile("" ::: "memory");
            scan_dma(rec0 + (size_t)(n + 1) * REC_BYTES, pair, F.lds + 65536, wave, lane);
            if (wave < 2) scan_step<0>(F.lds, S, kind, __shfl(gtv, n), op0 + (size_t)n * CH * 1024, wave, lane);
            asm volatile("s_waitcnt vmcnt(0)" ::: "memory"); __builtin_amdgcn_s_barrier(); asm volatile("" ::: "memory");
            if (n + 2 < NCHUNK) scan_dma(rec0 + (size_t)(n + 2) * REC_BYTES, pair, F.lds, wave, lane);
            if (wave < 2) scan_step<1>(F.lds, S, kind, __shfl(gtv, n + 1), op0 + (size_t)(n + 1) * CH * 1024, wave, lane);
        }
        asm volatile("s_waitcnt vmcnt(0) lgkmcnt(0)" ::: "memory"); __builtin_amdgcn_s_barrier(); asm volatile("" ::: "memory");
    }
}

__device__ __forceinline__ void scan_dma8(const unsigned char* rec, LAS unsigned char* buf, int wave, int lane) {
#pragma unroll
    for (int k = 0; k < 7; ++k) { const int i = wave * 7 + k;
        __builtin_amdgcn_global_load_lds((const unsigned*)(rec + i * 1024 + lane * 16), (LAS unsigned*)(buf + i * 1024), 16, 0, 2  ); }
}
template <int BUF>
__device__ __forceinline__ void scan_step8(LAS unsigned char* lds, f32x4 (&S)[8], f32x4 (&un)[4], const unsigned char* unext, const int kind, const float gt, float* op, const int lane) {
    const LAS unsigned char* buf = lds + BUF * 65536;
    const LAS bf16x8* Qf = (const LAS bf16x8*)(buf + REC_QF) + lane; const LAS bf16x8* Kf = (const LAS bf16x8*)(buf + REC_KF) + lane;
    const LAS bf16x8* Af = (const LAS bf16x8*)(buf + REC_AF) + lane; const LAS bf16x8* Wf = (const LAS bf16x8*)(buf + REC_WF) + lane;
    bf16x8 Sb[4];
#pragma unroll
    for (int ks = 0; ks < 4; ++ks) Sb[ks] = pack_b(S[2 * ks], S[2 * ks + 1]);
    f32x4 vn[4]; bf16x8 fa[16], fb[8];
#pragma unroll
    for (int mt = 0; mt < 4; ++mt) vn[mt] = un[mt];
    if (unext) {
#pragma unroll
        for (int mt = 0; mt < 4; ++mt) un[mt] = __builtin_nontemporal_load((const f32x4*)(unext + mt * 1024)); }
    if (kind == 0) {
#pragma unroll
        for (int i = 0; i < 16; ++i) fa[i] = Wf[i * 64];
        __builtin_amdgcn_sched_barrier(0);
#pragma unroll
        for (int mt = 0; mt < 4; ++mt) { f32x4 acc = {0.f, 0.f, 0.f, 0.f};
#pragma unroll
            for (int ks = 0; ks < 4; ++ks) acc = __builtin_amdgcn_mfma_f32_16x16x32_bf16(fa[mt * 4 + ks], Sb[ks], acc, 0, 0, 0);
            vn[mt] = vn[mt] - acc; } }
#pragma unroll
    for (int i = 0; i < 16; ++i) fa[i] = Qf[i * 64];
#pragma unroll
    for (int i = 0; i < 8; ++i) fb[i] = Af[i * 64];
    __builtin_amdgcn_sched_barrier(0);
    bf16x8 Vb[2]; Vb[0] = pack_b(vn[0], vn[1]); Vb[1] = pack_b(vn[2], vn[3]);
    f32x4 o[4];
#pragma unroll
    for (int mt = 0; mt < 4; ++mt) { o[mt] = (f32x4){0.f, 0.f, 0.f, 0.f};
#pragma unroll
        for (int ks = 0; ks < 4; ++ks) o[mt] = __builtin_amdgcn_mfma_f32_16x16x32_bf16(fa[mt * 4 + ks], Sb[ks], o[mt], 0, 0, 0);
#pragma unroll
        for (int kt = 0; kt < 2; ++kt) o[mt] = __builtin_amdgcn_mfma_f32_16x16x32_bf16(fb[mt * 2 + kt], Vb[kt], o[mt], 0, 0, 0); }
    __builtin_amdgcn_sched_barrier(0);
#pragma unroll
    for (int i = 0; i < 16; ++i) fa[i] = Kf[i * 64];
#pragma unroll
    for (int mt = 0; mt < 4; ++mt) { float* p = op + (size_t)mt * 16 * 1024; p[0] = o[mt][0]; p[1024] = o[mt][1]; p[2048] = o[mt][2]; p[3072] = o[mt][3]; }
    __builtin_amdgcn_sched_barrier(0);
#pragma unroll
    for (int m8 = 0; m8 < 8; ++m8) { f32x4 a = S[m8] * gt;
#pragma unroll
        for (int kt = 0; kt < 2; ++kt) a = __builtin_amdgcn_mfma_f32_16x16x32_bf16(fa[m8 * 2 + kt], Vb[kt], a, 0, 0, 0);
        S[m8] = a; }
}
__device__ __forceinline__ void phase_scan8(Frame& F, int l) {
    float* obuf = (float*)(WSP + SC_OBUF); const float* gtot = (const float*)(WSP + MS_GTOT);
    const int lane = F.lane, c16 = lane & 15, q4 = lane >> 4, wave = F.wave;
    const int grp = (F.blk & 7) * 8 + (F.blk >> 3), kind = grp >> 5, bh = grp & 31, b = bh >> 2, h = bh & 3;
    const unsigned char* rec0 = WSP + SC_PRE + (size_t)(kind * 1024 + bh * 32) * REC_BYTES;
    const float gtv = gtot[kind * 1024 + bh * 32 + (lane & 31)];
    float* op0 = obuf + (size_t)(b * SEQ + 4 * q4) * 1024 + kind * 512 + h * HD + 16 * wave + c16;
    const unsigned char* up = rec0 + REC_U + wave * 4096 + lane * 16;
    f32x4 S[8], ua[4];
#pragma unroll
    for (int i = 0; i < 8; ++i) S[i] = (f32x4){0.f, 0.f, 0.f, 0.f};
#pragma unroll
    for (int mt = 0; mt < 4; ++mt) ua[mt] = __builtin_nontemporal_load((const f32x4*)(up + mt * 1024));
    scan_dma8(rec0, F.lds, wave, lane);
#pragma unroll 1
    for (int n = 0; n < NCHUNK; n += 2) {
        asm volatile("s_waitcnt vmcnt(0)" ::: "memory"); __builtin_amdgcn_s_barrier(); asm volatile("" ::: "memory");
        scan_dma8(rec0 + (size_t)(n + 1) * REC_BYTES, F.lds + 65536, wave, lane);
        scan_step8<0>(F.lds, S, ua, up + (size_t)(n + 1) * REC_BYTES, kind, __shfl(gtv, n), op0 + (size_t)n * CH * 1024, lane);
        asm volatile("s_waitcnt vmcnt(0)" ::: "memory"); __builtin_amdgcn_s_barrier(); asm volatile("" ::: "memory");
        if (n + 2 < NCHUNK) scan_dma8(rec0 + (size_t)(n + 2) * REC_BYTES, F.lds, wave, lane);
        scan_step8<1>(F.lds, S, ua, n + 2 < NCHUNK ? up + (size_t)(n + 2) * REC_BYTES : nullptr, kind, __shfl(gtv, n + 1), op0 + (size_t)(n + 1) * CH * 1024, lane);
    }
    asm volatile("s_waitcnt vmcnt(0) lgkmcnt(0)" ::: "memory"); __builtin_amdgcn_s_barrier(); asm volatile("" ::: "memory");
}

constexpr int AT_STAGE = 32768, AT_TB = 4 * AT_STAGE;
__device__ __forceinline__ void attn_dma(const bf16* ktile, const bf16* vtile, const unsigned (&koff)[2], const unsigned voff, LAS unsigned char* st, int wave) {
#pragma unroll
    for (int k = 0; k < 2; ++k) __builtin_amdgcn_global_load_lds((const unsigned*)((const char*)ktile + koff[k]), (LAS unsigned*)(st + (2 * wave + k) * 1024), 16, 0, 0);
#pragma unroll
    for (int k = 0; k < 2; ++k) __builtin_amdgcn_global_load_lds((const unsigned*)((const char*)vtile + voff + k * 1024), (LAS unsigned*)(st + 16384 + (2 * wave + k) * 1024), 16, 0, 0);
}
template <int STG>
__device__ __forceinline__ void attn_tile(LAS unsigned char* lds, const int (&kx)[4], const bf16x8 (&Qb)[4], f32x4 (&oacc)[8], float& m, float& lsum, const bool band, const int dn, const int rb0, const LAS float* tb, const int lane) {
    const LAS unsigned char* st = lds + STG * AT_STAGE;
    bf16x8 fr[16];
#pragma unroll
    for (int mt = 0; mt < 4; ++mt)
#pragma unroll
        for (int ks = 0; ks < 4; ++ks) fr[mt * 4 + ks] = *(const LAS bf16x8*)(st + mt * 4096 + kx[ks]);
    __builtin_amdgcn_sched_barrier(0);
    f32x4 sc[4];
#pragma unroll
    for (int mt = 0; mt < 4; ++mt) { sc[mt] = (f32x4){0.f, 0.f, 0.f, 0.f};
#pragma unroll
        for (int ks = 0; ks < 4; ++ks) sc[mt] = __builtin_amdgcn_mfma_f32_16x16x32_bf16(fr[mt * 4 + ks], Qb[ks], sc[mt], 0, 0, 0); }
    __builtin_amdgcn_sched_barrier(0);
#pragma unroll
    for (int i = 0; i < 16; ++i) fr[i] = *(const LAS bf16x8*)(st + 16384 + (i * 64 + lane) * 16);
    __builtin_amdgcn_sched_barrier(0);
    if (band) {
        if (dn >= 3) { const float bc = tb[256];
#pragma unroll
            for (int mt = 0; mt < 4; ++mt) sc[mt] = sc[mt] + bc; }
        else { const int rb = 64 * dn + rb0;
#pragma unroll
            for (int mt = 0; mt < 4; ++mt)
#pragma unroll
                for (int rr = 0; rr < 4; ++rr) { int idx = rb - 16 * mt - rr; idx = idx < 0 ? 0 : (idx > 256 ? 256 : idx); sc[mt][rr] += tb[idx]; } } }
    float mx = fmaxf(fmaxf(fmaxf(sc[0][0], sc[0][1]), fmaxf(sc[0][2], sc[0][3])), fmaxf(fmaxf(sc[1][0], sc[1][1]), fmaxf(sc[1][2], sc[1][3])));
    mx = fmaxf(mx, fmaxf(fmaxf(fmaxf(sc[2][0], sc[2][1]), fmaxf(sc[2][2], sc[2][3])), fmaxf(fmaxf(sc[3][0], sc[3][1]), fmaxf(sc[3][2], sc[3][3]))));
    mx = fmaxf(mx, __shfl_xor(mx, 16)); mx = fmaxf(mx, __shfl_xor(mx, 32));
    const float mn = fmaxf(m, mx), alpha = __expf(m - mn); m = mn;
    float ps = 0.f;
#pragma unroll
    for (int mt = 0; mt < 4; ++mt)
#pragma unroll
        for (int rr = 0; rr < 4; ++rr) { const float e = __expf(sc[mt][rr] - mn); sc[mt][rr] = e; ps += e; }
    lsum = lsum * alpha + ps;
#pragma unroll
    for (int i = 0; i < 8; ++i) oacc[i] = oacc[i] * alpha;
    bf16x8 Pb[2]; Pb[0] = pack_b(sc[0], sc[1]); Pb[1] = pack_b(sc[2], sc[3]);
#pragma unroll
    for (int m8 = 0; m8 < 8; ++m8)
#pragma unroll
        for (int kt = 0; kt < 2; ++kt) oacc[m8] = __builtin_amdgcn_mfma_f32_16x16x32_bf16(fr[m8 * 2 + kt], Pb[kt], oacc[m8], 0, 0, 0);
}
__device__ __forceinline__ void phase_attn(Frame& F, int l, const bool shared_step) {
    KARGS();
    const bf16* proj = (const bf16*)(WSP + SC_PROJ); const bf16* kvm = (const bf16*)(WSP + MS_KVM) + (size_t)l * MROWS * 1024; bf16* mix = (bf16*)(WSP + WS_HB);
    const bf16* vct = (const bf16*)(WSP + SC_VCT); const bf16* vmt = (const bf16*)(WSP + MS_VMT);
    const float* relb = IN(I_RELB) + (size_t)l * NH * RELW;
    const int lane = F.lane, c16 = lane & 15, q4 = lane >> 4, w4 = F.wave & 3, g = F.wave >> 2, wave = F.wave;
    LAS float* tb = (LAS float*)(F.lds + AT_TB);
    int kx[4];
#pragma unroll
    for (int ks = 0; ks < 4; ++ks) kx[ks] = c16 * 256 + (((4 * ks + q4) ^ c16) << 4);
    const int vcu = (F.G & 7) == 0 ? (F.blk & 7) * (F.G >> 3) + (F.blk >> 3) : F.blk;
    const int lb = (F.blk >> 3) - 8;
    for (int it = 0; ; ++it) {
        int p;
        if (shared_step) {
            int j;
            if (it < 5) j = it * 24 + lb; else { if (it > 5 || lb < 8 || lb >= 16) break; j = 112 + lb; }
            int kd, bhl, pn;
            if (j < 48) { kd = 0; bhl = j / 12; pn = 4 + (j - bhl * 12); }
            else if (j < 60) { kd = 0; bhl = (j - 48) & 3; pn = 3 - ((j - 48) >> 2); }
            else if (j < 124) { kd = 1; bhl = (j - 60) >> 4; pn = (j - 60) & 15; }
            else { kd = 0; bhl = j - 124; pn = 0; }
            p = kd * 512 + ((F.blk & 7) * 4 + bhl) * 16 + pn;
        } else { p = vcu + it * F.G; if (p >= 1024) break; }
        const int u0 = 2 * p, kind = u0 >> 10, r = u0 & 1023, b = r >> 7, h = (r >> 5) & 3, n0 = r & 31, n = n0 + g;
        const int cs = kind == 0 ? (n0 - NPREV < 0 ? 0 : n0 - NPREV) : 0, nts = kind == 0 ? n0 + 2 - cs : 4;
        const int c0 = kind == 0 ? (n - NPREV < 0 ? 0 : n - NPREV) : 0, lo = c0 - cs, hi = kind == 0 ? n + 1 - cs : 4;
        const int tq = b * SEQ + n * CH + 16 * w4;
        const bf16* qrow = proj + (size_t)(tq + c16) * NPROJ + (kind == 0 ? C_QC : C_QM) + h * HD + 8 * q4;
        const bf16* kbase = kind == 0 ? proj + (size_t)(b * SEQ + cs * CH) * NPROJ + C_KC + h * HD : kvm + (size_t)(b * NMEM) * 1024 + h * HD;
        const int ldk = kind == 0 ? NPROJ : 1024;
        const bf16* vtb = kind == 0 ? vct + (size_t)((b * NH + h) * NCHUNK + cs) * 8192 : vmt + (size_t)((b * NH + h) * 4) * 8192;
        bf16x8 Qb[4];
#pragma unroll
        for (int ks = 0; ks < 4; ++ks) Qb[ks] = *(const bf16x8*)(qrow + 32 * ks);
        float tbv = 0.f;
        if (kind == 0 && wave < 5) { const int idx = lane + 64 * wave; tbv = relb[h * RELW + (idx < RELW ? idx : RELW - 1)]; }
        asm volatile("s_waitcnt vmcnt(0)" ::: "memory");
        if (kind == 0 && wave < 5) { const int idx = lane + 64 * wave; if (idx < RELW) tb[idx] = tbv; }
        f32x4 oacc[8];
#pragma unroll
        for (int i = 0; i < 8; ++i) oacc[i] = (f32x4){0.f, 0.f, 0.f, 0.f};
        float m = -1.0e30f, lsum = 0.f;
        const int rb0 = 16 * w4 + c16 - 4 * q4 + 128;
        unsigned koff[2];
#pragma unroll
        for (int k = 0; k < 2; ++k) { const int row = 8 * wave + 4 * k + q4; koff[k] = (unsigned)(row * ldk + ((c16 ^ (row & 15)) << 3)) * 2u; }
        const unsigned voff = (unsigned)((2 * wave) * 64 + lane) * 16u;
#define AT_ISSUE(tile, stg) do { const int tc_ = (tile) < nts ? (tile) : nts - 1; attn_dma(kbase + (size_t)tc_ * CH * ldk, vtb + (size_t)tc_ * 8192, koff, voff, F.lds + (stg) * AT_STAGE, wave); } while (0)
#define AT_STEP(k) do { asm volatile("s_waitcnt vmcnt(8) lgkmcnt(0)" ::: "memory"); __builtin_amdgcn_s_barrier(); asm volatile("" ::: "memory"); \
            AT_ISSUE(ti + (k) + 3, ((k) + 3) & 3); \
            if (ti + (k) >= lo && ti + (k) < hi) attn_tile<(k)>(F.lds, kx, Qb, oacc, m, lsum, kind == 0, n - (cs + ti + (k)), rb0, tb, lane); } while (0)
        AT_ISSUE(0, 0); AT_ISSUE(1, 1); AT_ISSUE(2, 2);
#pragma unroll 1
        for (int ti = 0; ti < nts; ti += 4) {
            AT_STEP(0);
            if (ti + 1 < nts) AT_STEP(1);
            if (ti + 2 < nts) AT_STEP(2);
            if (ti + 3 < nts) AT_STEP(3);
        }
#undef AT_STEP
#undef AT_ISSUE
        lsum += __shfl_xor(lsum, 16); lsum += __shfl_xor(lsum, 32);
        const float inv = 1.0f / lsum;
        const int ocol = (kind == 0 ? 1024 : 1536) + h * HD + 4 * q4;
#pragma unroll
        for (int m8 = 0; m8 < 8; ++m8) { const f32x4 o = oacc[m8] * inv; *(v2u*)((unsigned char*)mix + img_off(tq + c16, (ocol + 16 * m8) * 2, D * 2)) = (v2u){pg8::cvt_pk_bf16(o[0], o[1]), pg8::cvt_pk_bf16(o[2], o[3])}; }
        asm volatile("s_waitcnt vmcnt(0) lgkmcnt(0)" ::: "memory"); __builtin_amdgcn_s_barrier(); asm volatile("" ::: "memory");
    }
}

__device__ __forceinline__ void phase_post(Frame& F, int l) {
    KARGS();
    const bf16* proj = (const bf16*)(WSP + SC_PROJ); const float* obuf = (const float*)(WSP + SC_OBUF); bf16* mix = (bf16*)(WSP + WS_HB);
    const int gw = F.blk * NWAVES + F.wave, NGW = F.G * NWAVES, lane = F.lane, li = lane & 15, d0 = li * 8, h = lane >> 4;
    const int kind = gw & 1, tstart = gw >> 1, tstride = NGW >> 1;
    float gv[8]; { const float* gn = kind == 0 ? IN(I_DNG) + l * HD + d0 : IN(I_RNG) + l * GW + h * HD + d0;
#pragma unroll
        for (int j = 0; j < 8; ++j) gv[j] = gn[j]; }
    for (int tb = tstart; tb < T; tb += 4 * tstride) {
        f32x4 a0[4], a1[4]; v4u zz[4];
#pragma unroll
        for (int u = 0; u < 4; ++u) { const int t = tb + u * tstride; a0[u] = *(const f32x4*)(obuf + (size_t)t * 1024 + kind * 512 + lane * 8); a1[u] = *(const f32x4*)(obuf + (size_t)t * 1024 + kind * 512 + lane * 8 + 4);
            zz[u] = *(const v4u*)(proj + (size_t)t * NPROJ + (kind == 0 ? C_ZA : C_GB) + lane * 8); }
#pragma unroll
        for (int u = 0; u < 4; ++u) { const int t = tb + u * tstride;
            float o[8] = {a0[u].x, a0[u].y, a0[u].z, a0[u].w, a1[u].x, a1[u].y, a1[u].z, a1[u].w}; float z[8]; unpack8(zz[u], z);
            if (kind == 0) { float ss = 0.f;
#pragma unroll
                for (int j = 0; j < 8; ++j) ss += o[j] * o[j];
                const float r = rsqrtf(grp16_sum(ss) * (1.0f / HD) + EPS);
#pragma unroll
                for (int j = 0; j < 8; ++j) o[j] = o[j] * r * gv[j] * silu_f(z[j]);
            } else { float sm = 0.f;
#pragma unroll
                for (int j = 0; j < 8; ++j) sm += o[j];
                const float mu = grp16_sum(sm) * (1.0f / HD); float sv = 0.f;
#pragma unroll
                for (int j = 0; j < 8; ++j) { o[j] -= mu; sv += o[j] * o[j]; }
                const float r = rsqrtf(grp16_sum(sv) * (1.0f / HD) + EPS);
#pragma unroll
                for (int j = 0; j < 8; ++j) o[j] = o[j] * r * gv[j] * silu_f(z[j]); }
            *(v4u*)((unsigned char*)mix + img_off(t, (kind * 512 + lane * 8) * 2, D * 2)) = pack8(o); }
    }
}

__device__ __forceinline__ void phase_route(Frame& F) {
    LAS int* lc = (LAS int*)F.lds;
    LAS int* base = lc + 2048;
    LAS int* tot = base + 8; LAS int* tst = tot + 8; LAS int* spos = tst + 16;
    const int* cnt = (const int*)(WSP + MS_CNT); const int* tope = (const int*)(WSP + MS_TOPE); const float* topg = (const float*)(WSP + MS_TOPG);
    int* pos = (int*)(WSP + MS_POS); float* rowg = (float*)(WSP + MS_ROWG); int* tile = (int*)(WSP + MS_TILE);
    const bf16* h2 = (const bf16*)(WSP + WS_HB); bf16* xs = (bf16*)(WSP + SC_XS);
    const int rpb = T / F.G;
    for (int i = F.tid; i < F.G * 8; i += NTHREADS) lc[i] = cnt[i];
    __syncthreads();
    if (F.tid < 8) { int before = 0, total = 0; for (int bI = 0; bI < F.G; ++bI) { const int c = lc[bI * 8 + F.tid]; if (bI < F.blk) before += c; total += c; } base[F.tid] = before; tot[F.tid] = total; }
    __syncthreads();
    if (F.tid == 0) { int ts = 0; for (int e = 0; e < 8; ++e) { tst[e] = ts; ts += (tot[e] + 255) >> 8; } tst[8] = ts;
        if (F.blk == 0) tile[0] = ts; }
    __syncthreads();
    if (F.blk == 0 && F.tid < tst[8]) { int e = 0;
#pragma unroll 1
        for (int q = 1; q < 8; ++q) e += (F.tid >= tst[q]) ? 1 : 0;
        tile[16 + F.tid] = e; }
    if (F.tid < 8) { int cursor = tst[F.tid] * 256 + base[F.tid];
        for (int i = 0; i < 2 * rpb; ++i) { const int tok = F.blk * rpb + (i >> 1); if (tope[tok * 2 + (i & 1)] == F.tid) { spos[i] = cursor; pos[tok * 2 + (i & 1)] = cursor; rowg[cursor] = topg[tok * 2 + (i & 1)]; ++cursor; } } }
    __syncthreads();
    unsigned char* xs8 = (unsigned char*)xs; const float* sa = (const float*)(WSP + MS_SA); float* sxs = (float*)(WSP + MS_SXS);
    for (int i = F.wave; i < 2 * rpb; i += NWAVES) { const int tok = F.blk * rpb + (i >> 1), prow = spos[i];
        v4u w[2];
#pragma unroll
        for (int j = 0; j < 2; ++j) w[j] = *(const v4u*)((const unsigned char*)h2 + img_off(tok, 1024 * j + 16 * F.lane, D));
#pragma unroll
        for (int j = 0; j < 2; ++j) *(v4u*)(xs8 + img_off(prow, 1024 * j + 16 * F.lane, D)) = w[j];
        if (F.lane == 0) sxs[prow] = sa[tok]; }
    const unsigned z0 = (unsigned)F.tid >> 31;
    if (F.blk < 8) { const int e = F.blk, lo = tst[e] * 256 + tot[e], hi = tst[e + 1] * 256;
        for (int r = lo + F.wave; r < hi; r += NWAVES) { rowg[r] = 0.f; if (F.lane == 0) sxs[r] = 0.f;
#pragma unroll
            for (int j = 0; j < 2; ++j) *(v4u*)(xs8 + img_off(r, 1024 * j + 16 * F.lane, D)) = (v4u){z0, z0, z0, z0}; } }
    __syncthreads();
}
__device__ __forceinline__ void phase_combine(Frame& F) {
    const int* pos = (const int*)(WSP + MS_POS); const bf16* Y = (const bf16*)(WSP + SC_Y); const bf16* x3 = (const bf16*)(WSP + WS_XB) + (size_t)T * D;
    const int gw = F.blk * NWAVES + F.wave, NGW = F.G * NWAVES;
    for (int t = gw; t < T; t += NGW) { const int p0 = pos[t * 2], p1 = pos[t * 2 + 1];
        f32x4* o = (f32x4*)(OUTP + (size_t)t * D) + F.lane; const v2u* xr = (const v2u*)(x3 + (size_t)t * D) + F.lane; const v2u* y0 = (const v2u*)(Y + (size_t)p0 * D) + F.lane; const v2u* y1 = (const v2u*)(Y + (size_t)p1 * D) + F.lane;
#pragma unroll
        for (int j = 0; j < 8; ++j) { const v2u xx = xr[64 * j], a = y0[64 * j], c = y1[64 * j]; f32x4 x;
            x.x = bflo(xx.x) + bflo(a.x) + bflo(c.x); x.y = bfhi(xx.x) + bfhi(a.x) + bfhi(c.x); x.z = bflo(xx.y) + bflo(a.y) + bflo(c.y); x.w = bfhi(xx.y) + bfhi(a.y) + bfhi(c.y); o[64 * j] = x; } }
}

constexpr int STEPS_PER_LAYER = 12, N_STEPS = 1 + 2 * STEPS_PER_LAYER;
__global__ void __launch_bounds__(NTHREADS, 2) fwd(Args args) {
    extern __shared__ __attribute__((aligned(16))) unsigned char lds_raw[];
    Frame F; F.lds = (LAS unsigned char*)lds_raw; F.tid = threadIdx.x; F.lane = F.tid & 63; F.wave = __builtin_amdgcn_readfirstlane(F.tid >> 6); F.G = gridDim.x; F.blk = blockIdx.x;
    F.ap = (const __attribute__((address_space(4))) Args*)__builtin_amdgcn_kernarg_segment_ptr();
    F.out = (GAS float*)args.out; F.ws = (GAS unsigned char*)args.ws;
    volatile LAS unsigned* MISC = (volatile LAS unsigned*)(F.lds + LDS_CTL_OFF);
    if (F.tid < 64) MISC[F.tid] = 0u;
    __syncthreads();
    XcdBarrier bar = xcd_barrier_post((unsigned*)(WSP + WS_CTL) + CW_BAR, MISC + 8);
    const int lo = args.step_lo, hi = args.step_hi;
    bool first = true;
#ifndef ONLY
#define ONLY -1
#endif
#define EN(j) (ONLY < 0 || ONLY == (j))
#define FRESH() Frame P = F; asm volatile("" : "+s"(P.ws), "+s"(P.out), "+s"(P.ap), "+s"(P.blk), "+s"(P.G), "+s"(P.wave), "+v"(P.tid), "+v"(P.lane))
#define STEP(k) if (lo <= (k) && (k) < hi && (first ? (first = false, true) : (xcd_barrier(bar), true)))
    STEP(0) { FRESH(); if (EN(0)) phase_p0(P); }
#pragma unroll 1
    for (int l = 0; l < 2; ++l) {
        const int sb = 1 + l * STEPS_PER_LAYER;
        STEP(sb + 0) { FRESH(); { Frame& F = P; KARGS(); const void* xin = l == 0 ? (const void*)IN(I_X) : (const void*)(WSP + WS_XB); if (EN(1)) {
                if (l == 0) {
                    pg8::PlainSched S; S.A = nullptr; S.B = nullptr; S.nM = 0; S.nN = 0; S.G = F.G; S.c = F.blk; S.tstep = (size_t)256 * D * 2;
                    S.A2 = (const char*)(WSP + MS_MEMH); S.B2 = (const char*)(WSP + WS_WMKV); S.a2stride = (size_t)MROWS * D * 2; S.b2stride = (size_t)1024 * D * 2; S.n2 = 2;
                    pg8::EpiProj E{(bf16*)(WSP + SC_PROJ), (bf16*)(WSP + MS_KVM), (size_t)MROWS * 1024, nullptr, 1.0f};
                    pg8::gemm_phase<0>(F.lds, F.tid, D * 2, S, E);
                    if (F.blk >= 64) phase_rmsnorm(F, xin, l, IN(I_NMIXG) + (size_t)l * D, (bf16*)(WSP + WS_HB), 1, l, F.blk - 64, F.G - 64);
                } else phase_rmsnorm(F, xin, l, IN(I_NMIXG) + (size_t)l * D, (bf16*)(WSP + WS_HB), 1, l, F.blk, F.G); } } }
        STEP(sb + 1) { FRESH(); Frame& F = P;
#if W_IN_I8
            pg8::PlainSched S; S.A = (const char*)(WSP + WS_HB); S.B = (const char*)(WSP + WS_WIN) + (size_t)l * NPROJ * D; S.nM = T / 256; S.nN = NPROJ / 256; S.G = F.G; S.c = F.blk; S.tstep = (size_t)256 * D;
            S.A2 = nullptr; S.B2 = nullptr; S.a2stride = 0; S.b2stride = 0; S.n2 = 0;
            pg8::EpiProj E{(bf16*)(WSP + SC_PROJ), (bf16*)(WSP + MS_KVM), (size_t)MROWS * 1024, (const float*)(WSP + MS_SA), INV_SW_D};
            if (EN(2)) pg8::gemm_phase<2>(F.lds, F.tid, D, S, E);
#else
            pg8::PlainSched S; S.A = (const char*)(WSP + WS_HB); S.B = (const char*)(WSP + WS_WIN) + (size_t)l * NPROJ * D * 2; S.nM = T / 256; S.nN = NPROJ / 256; S.G = F.G; S.c = F.blk; S.tstep = (size_t)256 * D * 2;
            S.A2 = nullptr; S.B2 = nullptr; S.a2stride = 0; S.b2stride = 0; S.n2 = 0;
            pg8::EpiProj E{(bf16*)(WSP + SC_PROJ), (bf16*)(WSP + MS_KVM), (size_t)MROWS * 1024, nullptr, 1.0f};
            if (EN(2)) pg8::gemm_phase<0>(F.lds, F.tid, D * 2, S, E);
#endif
        }
        STEP(sb + 2) { FRESH(); if (EN(3)) phase_prep(P, l); }
        STEP(sb + 3) { FRESH(); if (EN(4)) phase_c1(P, l); }
        STEP(sb + 4) { FRESH(); if (EN(5)) {
            const bool sh = P.G == 256, sc = (P.blk >> 3) < 8;
            if (!sh || !sc) phase_attn(P, l, sh);
            if (!sh) phase_scan(P, l); else if (sc) phase_scan8(P, l);
        } }
        STEP(sb + 5) { FRESH(); if (EN(6)) phase_post(P, l); }
        STEP(sb + 6) { FRESH(); Frame& F = P; KARGS(); const void* xin = l == 0 ? (const void*)IN(I_X) : (const void*)(WSP + WS_XB);
            bf16* xmid = l == 0 ? (bf16*)OUTP : (bf16*)(WSP + WS_XB) + (size_t)T * D;
            pg8::PlainSched S; S.A = (const char*)(WSP + WS_HB); S.B = (const char*)(WSP + WS_WOUT) + (size_t)l * D * D * 2; S.nM = T / 256; S.nN = D / 256; S.G = F.G; S.c = F.blk; S.tstep = (size_t)256 * D * 2;
            S.A2 = nullptr; S.B2 = nullptr; S.a2stride = 0; S.b2stride = 0; S.n2 = 0;
            pg8::EpiRes E{xin, l, xmid};
            if (EN(7)) pg8::gemm_phase<0>(F.lds, F.tid, D * 2, S, E);
        }
        STEP(sb + 7) { FRESH(); { Frame& F = P; KARGS(); if (EN(8)) phase_rmsnorm(F, l == 0 ? (const void*)OUTP : (const void*)((bf16*)(WSP + WS_XB) + (size_t)T * D), 1, IN(I_NFFG) + (size_t)l * D, (bf16*)(WSP + WS_HB), l == 0 ? 0 : 2, l, F.blk, F.G); } }
        if (l == 1) { STEP(sb + 8) { FRESH(); if (EN(9)) phase_route(P); } }
        STEP(sb + 9) { FRESH(); Frame& F = P;
            pg8::GroupSched S; S.G = F.G; S.c = F.blk; S.tstep = (size_t)256 * D;
            if (l == 0) { S.A = (const char*)(WSP + WS_HB); S.B = (const char*)(WSP + WS_WGU); S.tile_e = nullptr; S.nrt = T / 256; S.nN = 2 * DFF / 256; S.estride = 0; }
            else { S.A = (const char*)(WSP + SC_XS); S.B = (const char*)(WSP + WS_MGU); S.tile_e = (const int*)(WSP + MS_TILE) + 16; S.nrt = ((const int*)(WSP + MS_TILE))[0]; S.nN = 2 * DFFE / 256; S.estride = (size_t)2 * DFFE * D; }
            pg8::EpiSwiglu E{l == 0 ? (bf16*)(WSP + SC_ACT) : (bf16*)(WSP + SC_MACT), l == 0 ? DFF : DFFE, INV_SW_D, l, l == 0 ? (const float*)(WSP + MS_SA) : (const float*)(WSP + MS_SXS)};
            if (EN(10)) pg8::gemm_phase<2>(F.lds, F.tid, D, S, E);
        }
        STEP(sb + 10) { FRESH(); Frame& F = P;
            pg8::GroupSched S; S.G = F.G; S.c = F.blk; S.nN = D / 256;
            pg8::EpiDown E{(const bf16*)OUTP, (bf16*)(WSP + WS_XB), (bf16*)(WSP + SC_Y), (const float*)(WSP + MS_ROWG), l};
            if (l == 0) { S.A = (const char*)(WSP + SC_ACT); S.B = (const char*)(WSP + WS_WDN); S.tile_e = nullptr; S.nrt = T / 256; S.estride = 0; S.tstep = (size_t)256 * DFF * 2;
                if (EN(11)) pg8::gemm_phase<0>(F.lds, F.tid, DFF * 2, S, E); }
            else { S.A = (const char*)(WSP + SC_MACT); S.B = (const char*)(WSP + WS_MDN); S.tile_e = (const int*)(WSP + MS_TILE) + 16; S.nrt = ((const int*)(WSP + MS_TILE))[0]; S.estride = (size_t)D * DFFE; S.tstep = (size_t)256 * DFFE;
                if (EN(11)) pg8::gemm_phase<1>(F.lds, F.tid, DFFE, S, E); }
        }
        if (l == 1) { STEP(sb + 11) { FRESH(); if (EN(12)) phase_combine(P); } }
    }
#undef STEP
}

extern "C" void kernel_launch(void* const* d_in, const int* in_sizes, int n_in, void* d_out, int out_size, void* d_ws, size_t ws_size, hipStream_t stream) {
    static int grid = 0;
    if (grid == 0) {
        if (n_in != 25 || out_size != T * D || ws_size < WS_END) { fprintf(stderr, "kernel_launch: unexpected shapes (n_in %d, out %d, ws %zu < %zu)\n", n_in, out_size, ws_size, (size_t)WS_END); grid = -1; return; }
        int dev = 0, cus = 0, per_cu = 0;
        if (hipGetDevice(&dev) != hipSuccess || hipDeviceGetAttribute(&cus, hipDeviceAttributeMultiprocessorCount, dev) != hipSuccess) { grid = -1; return; }
        if (hipFuncSetAttribute((const void*)fwd, hipFuncAttributeMaxDynamicSharedMemorySize, LDS_BYTES) != hipSuccess) { fprintf(stderr, "kernel_launch: hipFuncSetAttribute failed\n"); grid = -1; return; }
        if (hipOccupancyMaxActiveBlocksPerMultiprocessor(&per_cu, (const void*)fwd, NTHREADS, LDS_BYTES) != hipSuccess || per_cu < 1) { fprintf(stderr, "kernel_launch: occupancy query says %d\n", per_cu); }
        (void)hipGetLastError();
        grid = cus;
        if (T % grid != 0) { fprintf(stderr, "kernel_launch: grid %d does not divide T\n", grid); grid = -1; return; }
    }
    if (grid < 0) return;
    (void)in_sizes;
    if (hipMemsetAsync((char*)d_ws + WS_CTL, 0, CTL_ZERO_BYTES, stream) != hipSuccess) return;
    Args a{};
    for (int i = 0; i < 25; ++i) a.in[i] = (const float*)d_in[i];
    a.out = (float*)d_out; a.ws = (unsigned char*)d_ws; a.pad0 = 3;
#if ONE_LAUNCH
    a.step_lo = 0; a.step_hi = N_STEPS;
    hipLaunchKernelGGL(fwd, dim3(grid), dim3(NTHREADS), LDS_BYTES, stream, a);
#ifdef PROBE_STEPS
    { const int ps[] = PROBE_STEPS; for (int s : ps) { a.step_lo = s; a.step_hi = s + 1; a.pad0 = PROBE_MASK; hipLaunchKernelGGL(fwd, dim3(grid), dim3(NTHREADS), LDS_BYTES, stream, a); } }
#endif
#else
    for (int s = 0; s < N_STEPS; ++s) {
        if (s >= 1 && s < 1 + STEPS_PER_LAYER && ((s - 1) == 8 || (s - 1) == 11)) continue;
        a.step_lo = s; a.step_hi = s + 1;
        hipLaunchKernelGGL(fwd, dim3(grid), dim3(NTHREADS), LDS_BYTES, stream, a);
    }
#endif
}
```

```cpp
#include <hip/hip_runtime.h>
#include <cstdio>
#include <cstdint>

#ifndef W_IN_I8
#define W_IN_I8 1
#endif
#ifndef PROBE_MASK
#define PROBE_MASK 3
#endif
#ifndef NAIVE_ATTN
#define NAIVE_ATTN 0
#endif
#ifndef NAIVE_RECUR
#define NAIVE_RECUR 0
#endif
#ifndef ONE_LAUNCH
#define ONE_LAUNCH 1
#endif

#define GAS __attribute__((address_space(1)))
#define LAS __attribute__((address_space(3)))
typedef unsigned short bf16;
typedef unsigned v4u __attribute__((ext_vector_type(4)));
typedef unsigned v2u __attribute__((ext_vector_type(2)));
typedef float f32x4 __attribute__((ext_vector_type(4)));
typedef short bf16x8 __attribute__((ext_vector_type(8)));
typedef int i32x4 __attribute__((ext_vector_type(4)));

constexpr int D = 2048, NB = 8, SEQ = 2048, T = NB * SEQ, NH = 4, HD = 128, GW = 512, DIN = 6152, NPROJ = 6144;
constexpr int CH = 64, NCHUNK = SEQ / CH, NMEM = 256, MROWS = NB * NMEM, NPREV = 8;
constexpr int DFF = 5632, NE = 8, DFFE = 7168, RELW = 257;
constexpr int XS_ROWS = 2 * T + NE * 256;
constexpr float EPS = 1e-6f;
constexpr int C_QA = 0, C_KA = 512, C_VA = 1024, C_ZA = 1536, C_QB = 2048, C_KB = 2560, C_VB = 3072, C_GB = 3584, C_QC = 4096, C_KC = 4608, C_VC = 5120, C_QM = 5632;

constexpr size_t MiB = 1u << 20;
constexpr size_t WS_CTL = 0, CTL_ZERO_BYTES = 64 * 1024;
constexpr size_t WS_WIN = 1 * MiB;
constexpr size_t WS_WMKV = WS_WIN + 48 * MiB;
constexpr size_t WS_WOUT = WS_WMKV + 8 * MiB;
constexpr size_t WS_WGU = WS_WOUT + 16 * MiB;
constexpr size_t WS_WDN = WS_WGU + 44 * MiB;
constexpr size_t WS_MGU = WS_WDN + 22 * MiB;
constexpr size_t WS_MDN = WS_MGU + 448 * MiB;
constexpr size_t WS_HB = WS_MDN + 224 * MiB;
constexpr size_t WS_XB = WS_HB + 64 * MiB;
constexpr size_t WS_MISC = WS_XB + 128 * MiB;
constexpr size_t WS_SCR = WS_MISC + 40 * MiB;
constexpr size_t WS_END = WS_SCR + 748 * MiB;
static_assert(WS_HB == 811 * MiB && WS_END == 1791 * MiB, "ws map");
constexpr size_t MS_MEMH = WS_MISC;
constexpr size_t MS_KVM = WS_MISC + 16 * MiB;
constexpr size_t MS_VMT = WS_MISC + 24 * MiB;
constexpr size_t MS_GATES = WS_MISC + 28 * MiB;
constexpr size_t MS_ROPE = WS_MISC + 29 * MiB;
constexpr size_t MS_TOPE = WS_MISC + 30 * MiB;
constexpr size_t MS_TOPG = MS_TOPE + 128 * 1024;
constexpr size_t MS_POS = MS_TOPG + 128 * 1024;
constexpr size_t MS_ROWG = MS_POS + 128 * 1024;
constexpr size_t MS_CNT = MS_ROWG + 256 * 1024;
constexpr size_t MS_TILE = MS_CNT + 64 * 1024;
constexpr size_t SC_PROJ = WS_SCR;
constexpr size_t SC_CONVA = WS_SCR + 192 * MiB;
constexpr size_t SC_VCT = WS_SCR + 240 * MiB;
constexpr size_t SC_OBUF = WS_SCR + 256 * MiB;
constexpr size_t SC_PRE = WS_SCR + 320 * MiB;
constexpr int REC_BYTES = 90112, REC_QF = 0, REC_KF = 16384, REC_AF = 32768, REC_WF = 40960, REC_U = 57344;
constexpr size_t MS_GTOT = WS_MISC + 32 * MiB;
constexpr size_t MS_SA = WS_MISC + 33 * MiB;
constexpr size_t MS_SXS = WS_MISC + 34 * MiB;
constexpr float SW_D = 127.0f * 45.254833995939045f / 6.0f, INV_SW_D = 1.0f / SW_D;
constexpr size_t SC_ACT = WS_SCR;
constexpr size_t SC_XS = WS_SCR;
constexpr size_t SC_MACT = WS_SCR + 136 * MiB;
constexpr size_t SC_Y = WS_SCR + 612 * MiB;
constexpr int CW_BAR = 4096;

constexpr int LDS_BYTES = 163840;
constexpr int LDS_CTL_OFF = 162816;
constexpr int NWAVES = 8, NTHREADS = 512;

__device__ __forceinline__ unsigned f2bf(float f) { unsigned u = __builtin_bit_cast(unsigned, f); return (u + 0x7fffu + ((u >> 16) & 1u)) >> 16; }
__device__ __forceinline__ unsigned pk2(float lo, float hi) { return f2bf(lo) | (f2bf(hi) << 16); }
__device__ __forceinline__ float bflo(unsigned w) { return __builtin_bit_cast(float, w << 16); }
__device__ __forceinline__ float bfhi(unsigned w) { return __builtin_bit_cast(float, w & 0xffff0000u); }
__device__ __forceinline__ float bf2f(bf16 b) { return __builtin_bit_cast(float, ((unsigned)b) << 16); }
__device__ __forceinline__ float wave_sum(float v) {
#pragma unroll
    for (int o = 1; o < 64; o <<= 1) v += __shfl_xor(v, o);
    return v;
}
__device__ __forceinline__ float wave_max(float v) {
#pragma unroll
    for (int o = 1; o < 64; o <<= 1) v = fmaxf(v, __shfl_xor(v, o));
    return v;
}
__device__ __forceinline__ float grp16_sum(float v) {
#pragma unroll
    for (int o = 1; o < 16; o <<= 1) v += __shfl_xor(v, o);
    return v;
}
__device__ __forceinline__ float silu_f(float x) { return x / (1.0f + __expf(-x)); }
__device__ __forceinline__ void unpack8(const v4u w, float (&f)[8]) {
    f[0] = bflo(w.x); f[1] = bfhi(w.x); f[2] = bflo(w.y); f[3] = bfhi(w.y); f[4] = bflo(w.z); f[5] = bfhi(w.z); f[6] = bflo(w.w); f[7] = bfhi(w.w);
}
__device__ __forceinline__ v4u pack8(const float (&f)[8]) { v4u w; w.x = pk2(f[0], f[1]); w.y = pk2(f[2], f[3]); w.z = pk2(f[4], f[5]); w.w = pk2(f[6], f[7]); return w; }

#define XB_TMO      128
#define XB_XCNT(j)  (256  + 64 * (j))
#define XB_XSUB(j)  (1280 + 64 * (j))
#define XB_XGEN(j)  (2304 + 64 * (j))
#define XB_TOP      3328
#define XB_TOPGEN   3392
#define XCD_BAR_WORDS 3456
#define XB_SPIN_CAP (1u << 18)
__device__ __forceinline__ unsigned xb_ld(unsigned* p)              { return __hip_atomic_load(p, __ATOMIC_RELAXED, __HIP_MEMORY_SCOPE_AGENT); }
__device__ __forceinline__ unsigned xb_add(unsigned* p, unsigned v) { return __hip_atomic_fetch_add(p, v, __ATOMIC_RELAXED, __HIP_MEMORY_SCOPE_AGENT); }
__device__ __forceinline__ unsigned xb_xcc_id() { return (unsigned)__builtin_amdgcn_s_getreg((3 << 11) | 20) & 0xFu; }
#define XB_SPIN(cond, bar) do { unsigned _sp = 0; while (cond) { __builtin_amdgcn_s_sleep(1); \
    if ((++_sp & 255u) == 0u) { if (xb_ld(&(bar)[XB_TMO])) break; if (_sp > XB_SPIN_CAP) { atomicAdd(&(bar)[XB_TMO], 1u); break; } } } } while (0)
struct XcdBarrier { unsigned* bar; unsigned x; volatile LAS unsigned* st; };
__device__ __forceinline__ XcdBarrier xcd_barrier_post(unsigned* bar, volatile LAS unsigned* st) {
    XcdBarrier b; b.bar = bar; b.x = xb_xcc_id(); b.st = st;
    if (threadIdx.x == 0) (void)xb_add(&bar[XB_XCNT(b.x)], 1u);
    return b;
}
__device__ __forceinline__ void xcd_barrier_complete(unsigned* bar, unsigned x, unsigned& nloc, unsigned& nx) {
    const unsigned G = gridDim.x * gridDim.y * gridDim.z;
    unsigned sum, cnt, mine, sp = 0u;
    for (;;) {
        sum = 0u; cnt = 0u; mine = 0u;
#pragma unroll
        for (unsigned j = 0; j < 16; ++j) { const unsigned c = xb_ld(&bar[XB_XCNT(j)]); sum += c; cnt += (c > 0u) ? 1u : 0u; mine = (j == x) ? c : mine; }
        if (sum == G) break;
        __builtin_amdgcn_s_sleep(1);
        if ((++sp & 255u) == 0u) { if (xb_ld(&bar[XB_TMO])) break; if (sp > XB_SPIN_CAP) { atomicAdd(&bar[XB_TMO], 1u); break; } }
    }
    nloc = mine > 0u ? mine : 1u; nx = cnt > 0u ? cnt : 1u;
}
__device__ __forceinline__ void xcd_barrier(const XcdBarrier& b) {
    asm volatile("s_waitcnt vmcnt(0)" ::: "memory");
    __syncthreads();
    if (threadIdx.x == 0) {
        unsigned* bar = b.bar;
        __builtin_amdgcn_s_waitcnt(0);
        unsigned nloc = b.st[0], nx = b.st[1];
        if (nloc == 0u) { xcd_barrier_complete(bar, b.x, nloc, nx); b.st[0] = nloc; b.st[1] = nx; }
        const unsigned old = xb_add(&bar[XB_XSUB(b.x)], 1u);
        const unsigned gen = old / nloc;
        if (old + 1u == (gen + 1u) * nloc) {
            __builtin_amdgcn_fence(__ATOMIC_RELEASE, "agent");
            asm volatile("s_waitcnt vmcnt(0)" ::: "memory");
            const unsigned og = xb_add(&bar[XB_TOP], 1u);
            const unsigned tg = og / nx;
            if (og + 1u == (tg + 1u) * nx) xb_add(&bar[XB_TOPGEN], 1u);
            else XB_SPIN(xb_ld(&bar[XB_TOPGEN]) == tg, bar);
            __builtin_amdgcn_fence(__ATOMIC_ACQUIRE, "agent");
            xb_add(&bar[XB_XGEN(b.x)], 1u);
            asm volatile("s_waitcnt vmcnt(0)" ::: "memory");
        } else {
            XB_SPIN(xb_ld(&bar[XB_XGEN(b.x)]) == gen, bar);
            __builtin_amdgcn_fence(__ATOMIC_ACQUIRE, "agent");
            asm volatile("s_waitcnt vmcnt(0)" ::: "memory");
        }
    }
    __syncthreads();
}

namespace pg8 {
constexpr int BM = 256, BK = 64, HALF = 128, HTB = HALF * BK * 2, STAGE_BYTES = 8 * HTB, NXCD = 8, WGM = 8;
__host__ __device__ __forceinline__ int lds_byte(int r, int c) { const int st = (r >> 4) * 2 + (c >> 5), rr = r & 15, cc = c & 31, ob = rr * 64 + cc * 2; return st * 1024 + (ob ^ (((ob >> 9) & 1) << 5)); }
__host__ __device__ __forceinline__ void stage_rc(int b, int& R, int& C) { const int st = b / 1024, sb = b % 1024, swz = sb ^ (((sb >> 9) & 1) << 5); R = (st >> 1) * 16 + swz / 64; C = (st & 1) * 32 + (swz % 64) / 2; }
__host__ __device__ __forceinline__ int perm32(int rho) { const int n = rho >> 4, i = rho & 15; return 8 * (i >> 2) + 4 * n + (i & 3); }
__device__ __forceinline__ size_t img_off(int row, int kb, int RB) {
    return (size_t)(row >> 8) * ((size_t)256 * RB) + (size_t)(kb >> 7) * 32768 + (size_t)(((row >> 7) & 1) * 16384 + lds_byte(row & 127, (kb & 127) >> 1));
}
__device__ __forceinline__ int wslot(int n) { const int w = n & 31; return (n & ~31) + 16 * ((w >> 2) & 1) + 4 * (w >> 3) + (w & 3); }

__device__ __forceinline__ f32x4 tof(const f32x4 v) { return v; }
__device__ __forceinline__ f32x4 tof(const i32x4 v) { return __builtin_convertvector(v, f32x4); }
__device__ __forceinline__ unsigned cvt_pk_bf16(float lo, float hi) { unsigned r; asm volatile("v_cvt_pk_bf16_f32 %0, %1, %2" : "=v"(r) : "v"(lo), "v"(hi)); return r; }

struct GUnit { const char* A; const char* B; int pm, pn, aux; };
__device__ __forceinline__ void static_map(int L, int nM, int nN, int& pm, int& pn) {
    const int nwg = nM * nN; int wgid = L;
    { const int q = nwg / NXCD, r = nwg % NXCD, xcd = wgid % NXCD, off = wgid / NXCD; wgid = (xcd < r ? xcd * (q + 1) : r * (q + 1) + (xcd - r) * q) + off; }
    const int nig = WGM * nN, gid = wgid / nig, fm = gid * WGM, gsz = (nM - fm) < WGM ? (nM - fm) : WGM;
    pm = fm + ((wgid % nig) % gsz); pn = (wgid % nig) / gsz;
}

typedef int v8i __attribute__((ext_vector_type(8)));
__device__ __forceinline__ v8i cat8(const bf16x8 a, const bf16x8 b) { const v4u x = __builtin_bit_cast(v4u, a), y = __builtin_bit_cast(v4u, b); return (v8i){(int)x.x, (int)x.y, (int)x.z, (int)x.w, (int)y.x, (int)y.y, (int)y.z, (int)y.w}; }
template <int M_> struct AccSel { typedef f32x4 type; };
template <> struct AccSel<2> { typedef i32x4 type; };
template <int MODE, class Epi, class Sched>
__device__ __forceinline__ void gemm_phase(LAS unsigned char* lds, const int tid, const int RB, const Sched& S, const Epi& E) {
    constexpr bool FP8 = MODE == 1; typedef typename AccSel<MODE>::type AccT;
    const int wid = __builtin_amdgcn_readfirstlane(tid >> 6), lane = tid & 63, wr = wid >> 2, wc = wid & 3, fr = lane & 15, fq = lane >> 4;
    const int nt = RB / 128;
    unsigned voffA[2], voffB[2];
#pragma unroll
    for (int i = 0; i < 2; ++i) { voffA[i] = (unsigned)(tid * 16 + i * 8192); voffB[i] = voffA[i]; }
    const size_t kstep = (size_t)32768;
    const size_t hstep = (size_t)16384;
    const unsigned ldsw = (unsigned)wid * 1024u;
    const int aoff = lds_byte(wr * 64 + fr, fq * 8), boff = lds_byte(wc * 32 + fr, fq * 8);
#define PG8_SA(b, h) (((b) * 2 + (h)) * HTB)
#define PG8_SB(b, h) ((4 + (b) * 2 + (h)) * HTB)
#define PG8_STAGE(bufoff, gbase, voff) do { _Pragma("unroll") for (int _i = 0; _i < 2; ++_i) \
        __builtin_amdgcn_global_load_lds((const unsigned*)((const char*)(gbase) + (voff)[_i]), (LAS unsigned*)(lds + (bufoff) + ldsw + _i * 8192), 16, 0, 0); } while (0)
#define PG8_LD8(p) ({ const v4u lo_ = *(const LAS v4u*)(p), hi_ = *(const LAS v4u*)((p) + 1024); (v8i){(int)lo_.x, (int)lo_.y, (int)lo_.z, (int)lo_.w, (int)hi_.x, (int)hi_.y, (int)hi_.z, (int)hi_.w}; })
#define PG8_LDA(dst, b, h) do { _Pragma("unroll") for (int m = 0; m < 4; ++m) { if constexpr (FP8) dst##8[m] = PG8_LD8(lds + PG8_SA(b, h) + aoff + m * 2048); else { _Pragma("unroll") for (int k = 0; k < 2; ++k) dst[m][k] = *(const LAS bf16x8*)(lds + PG8_SA(b, h) + aoff + m * 2048 + k * 1024); } } } while (0)
#define PG8_LDB(dst, b, h) do { _Pragma("unroll") for (int n = 0; n < 2; ++n) { if constexpr (FP8) dst##8[n] = PG8_LD8(lds + PG8_SB(b, h) + boff + n * 2048); else { _Pragma("unroll") for (int k = 0; k < 2; ++k) dst[n][k] = *(const LAS bf16x8*)(lds + PG8_SB(b, h) + boff + n * 2048 + k * 1024); } } } while (0)
#define PG8_MMA(ai, bj, At, Bt) do { __builtin_amdgcn_s_setprio(1); _Pragma("unroll") for (int m = 0; m < 4; ++m) _Pragma("unroll") for (int n = 0; n < 2; ++n) { \
        if constexpr (FP8) asm volatile("v_mfma_scale_f32_16x16x128_f8f6f4 %0, %1, %2, %0, %3, %3 op_sel_hi:[0,0,0]" : "+v"(acc[ai][bj][m][n]) : "v"(Bt##8[n]), "v"(At##8[m]), "v"(scl1));   \
        else if constexpr (MODE == 2) { _Pragma("unroll") for (int k = 0; k < 2; ++k) acc[ai][bj][m][n] = __builtin_amdgcn_mfma_i32_16x16x64_i8(__builtin_bit_cast(i32x4, Bt[n][k]), __builtin_bit_cast(i32x4, At[m][k]), acc[ai][bj][m][n], 0, 0, 0); } \
        else { _Pragma("unroll") for (int k = 0; k < 2; ++k) acc[ai][bj][m][n] = __builtin_amdgcn_mfma_f32_16x16x32_bf16(Bt[n][k], At[m][k], acc[ai][bj][m][n], 0, 0, 0); } } __builtin_amdgcn_s_setprio(0); } while (0)
#define PG8_WAIT_V(n) asm volatile("s_waitcnt vmcnt(" #n ")" ::: "memory")
#define PG8_WAIT_L(n) asm volatile("s_waitcnt lgkmcnt(" #n ")" ::: "memory")
#define PG8_BAR __builtin_amdgcn_s_barrier()
#define PG8_SCHED __builtin_amdgcn_sched_barrier(0)
    GUnit cur, nxt; int ui = 0;
    if (!S.next(0, cur)) return;
    AccT acc[2][2][4][2];
#pragma unroll
    for (int a = 0; a < 2; ++a)
#pragma unroll
        for (int b = 0; b < 2; ++b)
#pragma unroll
            for (int m = 0; m < 4; ++m)
#pragma unroll
                for (int n = 0; n < 2; ++n) acc[a][b][m][n] = (AccT){0, 0, 0, 0};
    bf16x8 At[4][2], B0[2][2], B1[2][2]; v8i At8[4], B08[2], B18[2];
    const unsigned scl1 = 0x7f7f7f7fu;
    const char* cA = cur.A; const char* cB = cur.B;
    PG8_STAGE(PG8_SB(0, 0), cB, voffB); PG8_STAGE(PG8_SB(0, 1), cB + hstep, voffB); PG8_STAGE(PG8_SA(0, 0), cA, voffA); PG8_STAGE(PG8_SA(0, 1), cA + hstep, voffA);
    if (wr == 1) PG8_BAR;
    PG8_WAIT_V(2); PG8_BAR;
    PG8_STAGE(PG8_SB(1, 0), cB + kstep, voffB); PG8_STAGE(PG8_SA(1, 0), cA + kstep, voffA); PG8_STAGE(PG8_SB(1, 1), cB + hstep + kstep, voffB);
    PG8_WAIT_V(6); PG8_BAR;
    for (;;) {
        const bool has_next = S.next(ui + 1, nxt);
        const char* nA = has_next ? nxt.A : cA; const char* nB = has_next ? nxt.B : cB;
        for (int t = 0; t < nt; t += 2) {
            const bool last = (t == nt - 2);
            const char* a1 = cA + (size_t)(t + 1) * kstep;
            const char* a2 = last ? nA : cA + (size_t)(t + 2) * kstep; const char* b2 = last ? nB : cB + (size_t)(t + 2) * kstep;
            const char* a3 = a2 + kstep; const char* b3 = b2 + kstep;
            PG8_LDB(B0, 0, 0); PG8_LDB(B1, 0, 1); PG8_SCHED; PG8_LDA(At, 0, 0); PG8_STAGE(PG8_SA(1, 1), a1 + hstep, voffA);
            PG8_WAIT_V(8); PG8_WAIT_L(0); PG8_BAR; PG8_MMA(0, 0, At, B0); PG8_MMA(0, 1, At, B1); PG8_BAR; PG8_SCHED;
            PG8_LDA(At, 0, 1); PG8_STAGE(PG8_SB(0, 0), b2, voffB); PG8_STAGE(PG8_SB(0, 1), b2 + hstep, voffB); PG8_STAGE(PG8_SA(0, 0), a2, voffA);
            PG8_WAIT_V(8); PG8_WAIT_L(0); PG8_BAR; PG8_MMA(1, 0, At, B0); PG8_MMA(1, 1, At, B1); PG8_BAR; PG8_SCHED;
            PG8_LDB(B0, 1, 0); PG8_LDB(B1, 1, 1); PG8_SCHED; PG8_LDA(At, 1, 0); PG8_STAGE(PG8_SA(0, 1), a2 + hstep, voffA);
            PG8_WAIT_V(8); PG8_WAIT_L(0); PG8_BAR; PG8_MMA(0, 0, At, B0); PG8_MMA(0, 1, At, B1); PG8_BAR; PG8_SCHED;
            PG8_LDA(At, 1, 1); PG8_STAGE(PG8_SB(1, 0), b3, voffB); PG8_STAGE(PG8_SB(1, 1), b3 + hstep, voffB); PG8_STAGE(PG8_SA(1, 0), a3, voffA);
            PG8_WAIT_V(8); PG8_WAIT_L(0); PG8_BAR; PG8_MMA(1, 0, At, B0); PG8_MMA(1, 1, At, B1); PG8_BAR; PG8_SCHED;
        }
        if constexpr (FP8) asm volatile("s_nop 15\n\ts_nop 15" ::: "memory");
        if (wr == 0) PG8_BAR;
        E(acc, cur, wr, wc, fr, fq);
        if (!has_next) break;
#pragma unroll
        for (int a = 0; a < 2; ++a)
#pragma unroll
            for (int b = 0; b < 2; ++b)
#pragma unroll
                for (int m = 0; m < 4; ++m)
#pragma unroll
                    for (int n = 0; n < 2; ++n) acc[a][b][m][n] = (AccT){0, 0, 0, 0};
        cur = nxt; cA = nA; cB = nB; ++ui;
        if (wr == 1) PG8_BAR;
    }
    PG8_WAIT_V(0);
    PG8_BAR;
#undef PG8_SA
#undef PG8_SB
#undef PG8_STAGE
#undef PG8_LDA
#undef PG8_LDB
#undef PG8_MMA
#undef PG8_WAIT_V
#undef PG8_WAIT_L
#undef PG8_BAR
#undef PG8_SCHED
}

struct PlainSched {
    const char* A; const char* B; int nM, nN, G, c; size_t tstep;
    const char* A2; const char* B2; size_t a2stride, b2stride; int n2;
    __device__ __forceinline__ bool next(int i, GUnit& u) const {
        const int L = i * G + c, n1 = nM * nN;
        if (L < n1) { static_map(L, nM, nN, u.pm, u.pn); u.A = A + (size_t)u.pm * tstep; u.B = B + (size_t)u.pn * tstep; u.aux = 0; return true; }
        const int L2 = L - n1; if (L2 >= n2 * 32) return false;
        const int j = L2 >> 5, r = L2 & 31; u.pm = r & 7; u.pn = r >> 3; u.aux = 1 + j;
        u.A = A2 + (size_t)j * a2stride + (size_t)u.pm * tstep; u.B = B2 + (size_t)j * b2stride + (size_t)u.pn * tstep; return true;
    }
};
struct GroupSched {
    const char* A; const char* B; const int* tile_e; int nrt, nN, G, c; size_t tstep, estride;
    __device__ __forceinline__ bool next(int i, GUnit& u) const {
        const int L = i * G + c; if (L >= nrt * nN) return false;
        static_map(L, nrt, nN, u.pm, u.pn);
        const int e = tile_e ? tile_e[u.pm] : 0; u.aux = e;
        u.A = A + (size_t)u.pm * tstep; u.B = B + (size_t)e * estride + (size_t)u.pn * tstep; return true;
    }
};

struct EpiProj {
    bf16* proj; bf16* kvm0; size_t kvm_stride; const float* rowscale; float cscale;
    template <class AccT> __device__ __forceinline__ void operator()(const AccT (&acc)[2][2][4][2], const GUnit& u, int wr, int wc, int fr, int fq) const {
        bf16* base = u.aux == 0 ? proj : kvm0 + (size_t)(u.aux - 1) * kvm_stride; const int ldc = u.aux == 0 ? NPROJ : 1024;
        const int row0 = u.pm * BM + wr * 64 + fr, col0 = u.pn * BM + wc * 32 + 8 * fq;
        float rs[2][4];
#pragma unroll
        for (int ai = 0; ai < 2; ++ai)
#pragma unroll
            for (int m = 0; m < 4; ++m) rs[ai][m] = rowscale ? rowscale[row0 + ai * HALF + m * 16] * cscale : 1.0f;
        __builtin_amdgcn_sched_barrier(0);
#pragma unroll
        for (int ai = 0; ai < 2; ++ai)
#pragma unroll
            for (int m = 0; m < 4; ++m) { const int row = row0 + ai * HALF + m * 16; bf16* rowp = base + (size_t)row * ldc + col0;
#pragma unroll
                for (int bj = 0; bj < 2; ++bj) { const f32x4 v0 = tof(acc[ai][bj][m][0]) * rs[ai][m], v1 = tof(acc[ai][bj][m][1]) * rs[ai][m];
                    v4u w; w.x = cvt_pk_bf16(v0[0], v0[1]); w.y = cvt_pk_bf16(v0[2], v0[3]); w.z = cvt_pk_bf16(v1[0], v1[1]); w.w = cvt_pk_bf16(v1[2], v1[3]);
                    *(v4u*)(rowp + bj * HALF) = w; } }
    }
};
struct EpiRes {
    const void* res; int res_bf16; bf16* out; const float* rowscale; float cscale;
    template <class AccT> __device__ __forceinline__ void operator()(const AccT (&acc)[2][2][4][2], const GUnit& u, int wr, int wc, int fr, int fq) const {
        const int row0 = u.pm * BM + wr * 64 + fr, col0 = u.pn * BM + wc * 32 + 8 * fq;
#pragma unroll
        for (int ai = 0; ai < 2; ++ai) {
            f32x4 rr[4][2][2]; float rs[4];
#pragma unroll
            for (int m = 0; m < 4; ++m) { const size_t off = (size_t)(row0 + ai * HALF + m * 16) * D + col0; rs[m] = rowscale ? rowscale[row0 + ai * HALF + m * 16] * cscale : 1.0f;
#pragma unroll
                for (int bj = 0; bj < 2; ++bj) { if (res_bf16) { rr[m][bj][0] = __builtin_bit_cast(f32x4, *(const v4u*)((const bf16*)res + off + bj * HALF)); rr[m][bj][1] = rr[m][bj][0]; }
                    else { rr[m][bj][0] = *(const f32x4*)((const float*)res + off + bj * HALF); rr[m][bj][1] = *(const f32x4*)((const float*)res + off + bj * HALF + 4); } } }
            __builtin_amdgcn_sched_barrier(0);
#pragma unroll
            for (int m = 0; m < 4; ++m) { const size_t off = (size_t)(row0 + ai * HALF + m * 16) * D + col0;
#pragma unroll
                for (int bj = 0; bj < 2; ++bj) { f32x4 a0, a1;
                    if (res_bf16) { const v4u w = __builtin_bit_cast(v4u, rr[m][bj][0]); a0 = (f32x4){bflo(w.x), bfhi(w.x), bflo(w.y), bfhi(w.y)}; a1 = (f32x4){bflo(w.z), bfhi(w.z), bflo(w.w), bfhi(w.w)}; } else { a0 = rr[m][bj][0]; a1 = rr[m][bj][1]; }
                    const f32x4 v0 = a0 + tof(acc[ai][bj][m][0]) * rs[m], v1 = a1 + tof(acc[ai][bj][m][1]) * rs[m];
                    v4u w; w.x = cvt_pk_bf16(v0[0], v0[1]); w.y = cvt_pk_bf16(v0[2], v0[3]); w.z = cvt_pk_bf16(v1[0], v1[1]); w.w = cvt_pk_bf16(v1[2], v1[3]);
                    *(v4u*)(out + off + bj * HALF) = w; } }
            __builtin_amdgcn_sched_barrier(0);
        }
    }
};
struct EpiSwiglu {
    bf16* act; int ldc; float inscale; int fp8out; const float* rowscale;
    template <class AccT> __device__ __forceinline__ void operator()(const AccT (&acc)[2][2][4][2], const GUnit& u, int wr, int wc, int fr, int fq) const {
        const int row0 = u.pm * BM + wr * 64 + fr, col0 = u.pn * HALF + wc * 32 + 8 * fq;
        float rsv[2][4];
#pragma unroll
        for (int ai = 0; ai < 2; ++ai)
#pragma unroll
            for (int m = 0; m < 4; ++m) rsv[ai][m] = rowscale ? rowscale[row0 + ai * HALF + m * 16] * inscale : inscale;
        __builtin_amdgcn_sched_barrier(0);
#pragma unroll
        for (int ai = 0; ai < 2; ++ai)
#pragma unroll
            for (int m = 0; m < 4; ++m) { float o[8]; const float rs = rsv[ai][m];
                const float c1 = rs * -1.4426950408889634f, rs2 = rs * rs * (fp8out ? 8.0f : 1.0f);
#pragma unroll
                for (int n = 0; n < 2; ++n)
#pragma unroll
                    for (int j = 0; j < 4; ++j) { const float a = (float)acc[ai][0][m][n][j], b = (float)acc[ai][1][m][n][j];
                        o[4 * n + j] = (a * b) * (__builtin_amdgcn_rcpf(1.0f + __builtin_amdgcn_exp2f(a * c1)) * rs2); }
                if (fp8out) {
#pragma unroll
                    for (int j = 0; j < 8; ++j) o[j] = __builtin_amdgcn_fmed3f(o[j], -448.0f, 448.0f);
                    unsigned w0 = 0, w1 = 0; w0 = __builtin_amdgcn_cvt_pk_fp8_f32(o[0], o[1], w0, false); w0 = __builtin_amdgcn_cvt_pk_fp8_f32(o[2], o[3], w0, true);
                    w1 = __builtin_amdgcn_cvt_pk_fp8_f32(o[4], o[5], w1, false); w1 = __builtin_amdgcn_cvt_pk_fp8_f32(o[6], o[7], w1, true);
                    *(v2u*)((unsigned char*)act + img_off(row0 + ai * HALF + m * 16, col0, ldc)) = (v2u){w0, w1};
                } else {
                v4u w; w.x = cvt_pk_bf16(o[0], o[1]); w.y = cvt_pk_bf16(o[2], o[3]); w.z = cvt_pk_bf16(o[4], o[5]); w.w = cvt_pk_bf16(o[6], o[7]);
                *(v4u*)((unsigned char*)act + img_off(row0 + ai * HALF + m * 16, col0 * 2, ldc * 2)) = w; } }
    }
};
struct EpiDown {
    const bf16* res; bf16* out; bf16* Y; const float* rowgate; int moe;
    template <class AccT> __device__ __forceinline__ void operator()(const AccT (&acc)[2][2][4][2], const GUnit& u, int wr, int wc, int fr, int fq) const {
        const int row0 = u.pm * BM + wr * 64 + fr, col0 = u.pn * BM + wc * 32 + 8 * fq;
        if (!moe) {
#pragma unroll
            for (int ai = 0; ai < 2; ++ai) {
                v4u rw[4][2];
#pragma unroll
                for (int m = 0; m < 4; ++m)
#pragma unroll
                    for (int bj = 0; bj < 2; ++bj) rw[m][bj] = *(const v4u*)(res + (size_t)(row0 + ai * HALF + m * 16) * D + col0 + bj * HALF);
                __builtin_amdgcn_sched_barrier(0);
#pragma unroll
                for (int m = 0; m < 4; ++m) { const size_t off = (size_t)(row0 + ai * HALF + m * 16) * D + col0;
#pragma unroll
                    for (int bj = 0; bj < 2; ++bj) { const v4u w0 = rw[m][bj];
                        const f32x4 v0 = (f32x4){bflo(w0.x), bfhi(w0.x), bflo(w0.y), bfhi(w0.y)} + tof(acc[ai][bj][m][0]), v1 = (f32x4){bflo(w0.z), bfhi(w0.z), bflo(w0.w), bfhi(w0.w)} + tof(acc[ai][bj][m][1]);
                        v4u w; w.x = cvt_pk_bf16(v0[0], v0[1]); w.y = cvt_pk_bf16(v0[2], v0[3]); w.z = cvt_pk_bf16(v1[0], v1[1]); w.w = cvt_pk_bf16(v1[2], v1[3]);
                        *(v4u*)(out + off + bj * HALF) = w; } }
                __builtin_amdgcn_sched_barrier(0);
            }
        } else {
            float gv[2][4];
#pragma unroll
            for (int ai = 0; ai < 2; ++ai)
#pragma unroll
                for (int m = 0; m < 4; ++m) gv[ai][m] = rowgate[row0 + ai * HALF + m * 16] * (1.0f / 512.0f);
            __builtin_amdgcn_sched_barrier(0);
#pragma unroll
            for (int ai = 0; ai < 2; ++ai)
#pragma unroll
                for (int m = 0; m < 4; ++m) { const int row = row0 + ai * HALF + m * 16; const float g = gv[ai][m]; bf16* rowp = Y + (size_t)row * D + col0;
#pragma unroll
                    for (int bj = 0; bj < 2; ++bj) { const f32x4 v0 = tof(acc[ai][bj][m][0]) * g, v1 = tof(acc[ai][bj][m][1]) * g;
                        v4u w; w.x = cvt_pk_bf16(v0[0], v0[1]); w.y = cvt_pk_bf16(v0[2], v0[3]); w.z = cvt_pk_bf16(v1[0], v1[1]); w.w = cvt_pk_bf16(v1[2], v1[3]);
                        *(v4u*)(rowp + bj * HALF) = w; } }
        }
    }
};
}

using pg8::img_off; using pg8::wslot;
struct Args { const float* in[25]; float* out; unsigned char* ws; int step_lo, step_hi; int pad0, pad1; };
struct Frame {
    LAS unsigned char* lds; int tid, lane, wave, G, blk;
    const __attribute__((address_space(4))) Args* ap; GAS float* out; GAS unsigned char* ws;
};
#define KARGS() const __attribute__((address_space(4))) Args* ap_ = F.ap; asm volatile("" : "+s"(ap_))
#define IN(i) (ap_->in[i])
#define WSP ((unsigned char*)F.ws)
#define OUTP ((float*)F.out)
enum { I_X = 0, I_MEM, I_NMIXG, I_NMEMG, I_WIN, I_CONVW, I_ALOG, I_DTB, I_DNG, I_RNG, I_AQG, I_AKG, I_RELB, I_MQG, I_MKG, I_WMKV, I_WOUT, I_NFFG, I_FWG, I_FWU, I_FWD, I_RW, I_MWG, I_MWU, I_MWD };

__device__ __forceinline__ void p0_item(const float* W, int ldw, int K, int nblk, bf16* WT, int row_off, int mode, LAS float* scr, int item, int lane) {
    const int kb = item / nblk, nb = item % nblk, k0 = 64 * kb, n0 = 32 * nb;
    const int drow0 = mode == 0 ? row_off + n0 : ((n0 >> 7) * 256 + (mode - 1) * 128 + (n0 & 127));
    float tv[32];
#pragma unroll
    for (int i = 0; i < 32; ++i) { const int kk = 2 * i + (lane >> 5); tv[i] = __builtin_nontemporal_load(W + (size_t)(k0 + kk) * ldw + n0 + (lane & 31));   }
#pragma unroll
    for (int i = 0; i < 32; ++i) { const int kk = 2 * i + (lane >> 5); scr[kk * 33 + (lane & 31)] = tv[i]; }
    asm volatile("s_waitcnt lgkmcnt(0)" ::: "memory");
    const int c = lane & 7;
#pragma unroll
    for (int j = 0; j < 4; ++j) { const int n = (lane >> 3) + 8 * j; const LAS float* s = scr + (8 * c) * 33 + n;
        v4u o; o.x = pk2(s[0 * 33], s[1 * 33]); o.y = pk2(s[2 * 33], s[3 * 33]); o.z = pk2(s[4 * 33], s[5 * 33]); o.w = pk2(s[6 * 33], s[7 * 33]);
        *(v4u*)((unsigned char*)WT + img_off(wslot(drow0 + n), (k0 + 8 * c) * 2, K * 2)) = o; }
    asm volatile("s_waitcnt lgkmcnt(0)" ::: "memory");
}
__device__ __forceinline__ unsigned pk4_fp8(float a, float b, float c, float d) { unsigned w = 0; w = __builtin_amdgcn_cvt_pk_fp8_f32(a, b, w, false); w = __builtin_amdgcn_cvt_pk_fp8_f32(c, d, w, true); return w; }
__device__ __forceinline__ unsigned pk4_i8(float a, float b, float c, float d) {
    const int x = (int)rintf(fminf(fmaxf(a, -127.f), 127.f)), y = (int)rintf(fminf(fmaxf(b, -127.f), 127.f)), z = (int)rintf(fminf(fmaxf(c, -127.f), 127.f)), w = (int)rintf(fminf(fmaxf(d, -127.f), 127.f));
    return (unsigned)(x & 255) | ((unsigned)(y & 255) << 8) | ((unsigned)(z & 255) << 16) | ((unsigned)w << 24); }
__device__ __forceinline__ void p0_item8(const float* W, int ldw, int K, int nblk, unsigned char* WT, int row_off, int mode, int fmt, LAS float* scr, int item, int lane) {
    const int kb = item / nblk, nb = item % nblk, k0 = 64 * kb, n0 = 32 * nb;
    const int drow0 = mode == 0 ? row_off + n0 : ((n0 >> 7) * 256 + (mode - 1) * 128 + (n0 & 127));
    const float wsc = fmt == 1 ? 64.0f : SW_D;
    float tv[32];
#pragma unroll
    for (int i = 0; i < 32; ++i) { const int kk = 2 * i + (lane >> 5); tv[i] = __builtin_nontemporal_load(W + (size_t)(k0 + kk) * ldw + n0 + (lane & 31));   }
#pragma unroll
    for (int i = 0; i < 32; ++i) { const int kk = 2 * i + (lane >> 5); scr[kk * 33 + (lane & 31)] = tv[i] * wsc; }
    asm volatile("s_waitcnt lgkmcnt(0)" ::: "memory");
    const int c = lane & 7;
#pragma unroll
    for (int j = 0; j < 4; ++j) { const int n = (lane >> 3) + 8 * j; const LAS float* s = scr + (8 * c) * 33 + n;
        v2u o; if (fmt == 1) { o.x = pk4_fp8(s[0 * 33], s[1 * 33], s[2 * 33], s[3 * 33]); o.y = pk4_fp8(s[4 * 33], s[5 * 33], s[6 * 33], s[7 * 33]); }
        else { o.x = pk4_i8(s[0 * 33], s[1 * 33], s[2 * 33], s[3 * 33]); o.y = pk4_i8(s[4 * 33], s[5 * 33], s[6 * 33], s[7 * 33]); }
        *(v2u*)(WT + img_off(wslot(drow0 + n), k0 + 8 * c, K)) = o; }
    asm volatile("s_waitcnt lgkmcnt(0)" ::: "memory");
}
__device__ __forceinline__ void phase_p0(Frame& F) {
    KARGS();
    LAS float* scr = (LAS float*)(F.lds + F.wave * 16384);
    const int gw = F.blk * NWAVES + F.wave, NGW = F.G * NWAVES;
    constexpr int I_MOE1 = 32 * 224, I_MOE = 3 * I_MOE1;
    constexpr int N_MOE = NE * I_MOE;
    constexpr int I_L = 2048 + 4096 + 1024 + 2048;
    constexpr int I_FF = 32 * 176;
    constexpr int NITEMS = N_MOE + 2 * I_L + 3 * I_FF;
    for (int it = gw; it < NITEMS; it += NGW) {
        int r = it;
        if (r < N_MOE) { const int e = r / I_MOE, q = r % I_MOE, which = q / I_MOE1, idx = q % I_MOE1;
            if (which < 2) p0_item8((which == 0 ? IN(I_MWG) : IN(I_MWU)) + (size_t)e * D * DFFE, DFFE, D, DFFE / 32, WSP + WS_MGU + (size_t)e * 2 * DFFE * D, 0, 1 + which, 2, scr, idx, F.lane);
            else p0_item8(IN(I_MWD) + (size_t)e * DFFE * D, D, DFFE, D / 32, WSP + WS_MDN + (size_t)e * D * DFFE, 0, 0, 1, scr, idx, F.lane);
            continue; }
        r -= N_MOE;
        if (r < 2 * I_L) { const int l = r / I_L; int q = r % I_L;
            const float* win = IN(I_WIN) + (size_t)l * D * DIN; unsigned char* wint = WSP + WS_WIN + (size_t)l * NPROJ * D;
#if W_IN_I8
            if (q < 2048) { p0_item8(win, DIN, D, 64, wint, 0, 0, 2, scr, q, F.lane); continue; } q -= 2048;
            if (q < 4096) { p0_item8(win + 2056, DIN, D, 128, wint, 2048, 0, 2, scr, q, F.lane); continue; } q -= 4096;
#else
            if (q < 2048) { p0_item(win, DIN, D, 64, (bf16*)(WSP + WS_WIN) + (size_t)l * NPROJ * D, 0, 0, scr, q, F.lane); continue; } q -= 2048;
            if (q < 4096) { p0_item(win + 2056, DIN, D, 128, (bf16*)(WSP + WS_WIN) + (size_t)l * NPROJ * D, 2048, 0, scr, q, F.lane); continue; } q -= 4096;
#endif
            if (q < 1024) { p0_item(IN(I_WMKV) + (size_t)l * D * 1024, 1024, D, 32, (bf16*)(WSP + WS_WMKV) + (size_t)l * 1024 * D, 0, 0, scr, q, F.lane); continue; } q -= 1024;
            p0_item(IN(I_WOUT) + (size_t)l * D * D, D, D, 64, (bf16*)(WSP + WS_WOUT) + (size_t)l * D * D, 0, 0, scr, q, F.lane); continue; }
        r -= 2 * I_L;
        if (r < I_FF) { p0_item8(IN(I_FWG), DFF, D, DFF / 32, WSP + WS_WGU, 0, 1, 2, scr, r, F.lane); continue; } r -= I_FF;
        if (r < I_FF) { p0_item8(IN(I_FWU), DFF, D, DFF / 32, WSP + WS_WGU, 0, 2, 2, scr, r, F.lane); continue; } r -= I_FF;
        p0_item(IN(I_FWD), D, DFF, D / 32, (bf16*)(WSP + WS_WDN), 0, 0, scr, r, F.lane);
    }
    { float* rc = (float*)(WSP + MS_ROPE); float* rs = rc + SEQ * 64;
      for (int idx = F.blk * NTHREADS + F.tid; idx < SEQ * 64; idx += F.G * NTHREADS) { const int pos = idx >> 6, i = idx & 63;
          const double inv = exp(-(double)i * (9.210340371976184 / 64.0)); const double ang = (double)pos * inv; rc[idx] = (float)cos(ang); rs[idx] = (float)sin(ang); } }
    for (int m = gw; m < 2 * MROWS; m += NGW) { const int l = m / MROWS, row = m % MROWS;
        const f32x4* xr = (const f32x4*)(IN(I_MEM) + (size_t)row * D) + F.lane; const f32x4* gr = (const f32x4*)(IN(I_NMEMG) + (size_t)l * D) + F.lane;
        f32x4 v[8]; float ss = 0.f;
#pragma unroll
        for (int j = 0; j < 8; ++j) { v[j] = xr[64 * j]; ss += (v[j].x * v[j].x + v[j].y * v[j].y) + (v[j].z * v[j].z + v[j].w * v[j].w); }
        const float r = rsqrtf(wave_sum(ss) * (1.0f / D) + EPS);
        unsigned char* o = WSP + MS_MEMH + (size_t)l * MROWS * D * 2;
#pragma unroll
        for (int j = 0; j < 8; ++j) { const f32x4 g = gr[64 * j]; v2u w; w.x = pk2(v[j].x * r * g.x, v[j].y * r * g.y); w.y = pk2(v[j].z * r * g.z, v[j].w * r * g.w); *(v2u*)(o + img_off(row, 512 * j + 8 * F.lane, D * 2)) = w; }
    }
}

__device__ __forceinline__ void phase_rmsnorm(Frame& F, const void* x, int xbf, const float* gain, bf16* out, int mode, int l, int bi, int nb) {
    KARGS();
    LAS float* w8 = (LAS float*)F.lds;
    LAS int* lcnt = (LAS int*)(F.lds + 65536);
    if (mode != 0) {
        for (int idx = F.tid; idx < D * 8; idx += NTHREADS) { const int d = idx >> 3, e = idx & 7;
            w8[e * D + d] = mode == 1 ? IN(I_WIN)[(size_t)l * D * DIN + (size_t)d * DIN + 2048 + e] : IN(I_RW)[d * 8 + e]; }
        if (F.tid < 8) lcnt[F.tid] = 0;
        __syncthreads();
    }
    const int rpb = (T + nb - 1) / nb, row_lo = bi * rpb, nrows = row_lo + rpb <= T ? rpb : (T - row_lo > 0 ? T - row_lo : 0);
    f32x4 g[8];
#pragma unroll
    for (int j = 0; j < 8; ++j) g[j] = ((const f32x4*)gain)[64 * j + F.lane];
    f32x4 nv[8];
#define RMS_LOADROW(rr) do { if (xbf) { const v2u* xr_ = (const v2u*)((const bf16*)x + (size_t)(rr) * D) + F.lane; \
        _Pragma("unroll") for (int j = 0; j < 8; ++j) { const v2u w_ = xr_[64 * j]; nv[j] = (f32x4){bflo(w_.x), bfhi(w_.x), bflo(w_.y), bfhi(w_.y)}; } } \
      else { const f32x4* xr_ = (const f32x4*)((const float*)x + (size_t)(rr) * D) + F.lane; _Pragma("unroll") for (int j = 0; j < 8; ++j) nv[j] = xr_[64 * j]; } } while (0)
    if (F.wave < nrows) RMS_LOADROW(row_lo + F.wave);
    for (int rl = F.wave; rl < nrows; rl += NWAVES) {
        const int row = row_lo + rl;
        f32x4 v[8]; float ss = 0.f;
#pragma unroll
        for (int j = 0; j < 8; ++j) { v[j] = nv[j]; ss += (v[j].x * v[j].x + v[j].y * v[j].y) + (v[j].z * v[j].z + v[j].w * v[j].w); }
        { const int rn = rl + NWAVES < nrows ? row + NWAVES : row; RMS_LOADROW(rn); }
        const float r = rsqrtf(wave_sum(ss) * (1.0f / D) + EPS);
        float amax = 0.f;
#pragma unroll
        for (int j = 0; j < 8; ++j) { v[j] = v[j] * r * g[j]; amax = fmaxf(amax, fmaxf(fmaxf(fabsf(v[j].x), fabsf(v[j].y)), fmaxf(fabsf(v[j].z), fabsf(v[j].w)))); }
        if (!W_IN_I8 && mode == 1) {
#pragma unroll
            for (int j = 0; j < 8; ++j) { v2u w; w.x = pk2(v[j].x, v[j].y); w.y = pk2(v[j].z, v[j].w); *(v2u*)((unsigned char*)out + img_off(row, 512 * j + 8 * F.lane, D * 2)) = w; }
        } else {
        amax = wave_max(amax); const float qs = amax > 0.f ? 127.0f / amax : 0.f;
        if (F.lane == 0) ((float*)(WSP + MS_SA))[row] = amax * (1.0f / 127.0f);
#pragma unroll
        for (int j = 0; j < 8; ++j) *(unsigned*)((unsigned char*)out + img_off(row, 256 * j + 4 * F.lane, D)) = pk4_i8(v[j].x * qs, v[j].y * qs, v[j].z * qs, v[j].w * qs);
        }
        if (mode != 0) {
            float myval = 0.f;
#pragma unroll 1
            for (int e = 0; e < 8; ++e) { float s = 0.f;
#pragma unroll
                for (int j = 0; j < 8; ++j) { const f32x4 w = *(const LAS f32x4*)(w8 + e * D + 256 * j + 4 * F.lane); s += (v[j].x * w.x + v[j].y * w.y) + (v[j].z * w.z + v[j].w * w.w); }
                s = wave_sum(s); if (F.lane == e) myval = s; }
            if (mode == 1) {
                if (F.lane < 8) { float res;
                    if (F.lane < 4) { const float a = IN(I_ALOG)[l * NH + F.lane], db = IN(I_DTB)[l * NH + F.lane]; const float z = myval + db; const float sp = z > 20.f ? z : log1pf(expf(z)); res = -expf(a) * sp; }
                    else res = 1.0f / (1.0f + expf(-myval));
                    ((float*)(WSP + MS_GATES))[(size_t)row * 8 + F.lane] = res; }
            } else {
                float dt[8];
#pragma unroll
                for (int e = 0; e < 8; ++e) dt[e] = __shfl(myval, e);
                int e0 = 0; float l0 = dt[0];
#pragma unroll
                for (int e = 1; e < 8; ++e) if (dt[e] > l0) { l0 = dt[e]; e0 = e; }
                int e1 = -1; float l1 = -3.0e38f;
#pragma unroll
                for (int e = 0; e < 8; ++e) if (e != e0 && dt[e] > l1) { l1 = dt[e]; e1 = e; }
                if (F.lane == 0) { const float ex = expf(l1 - l0); const float g0 = 1.0f / (1.0f + ex), g1 = ex / (1.0f + ex);
                    ((int*)(WSP + MS_TOPE))[row * 2] = e0; ((int*)(WSP + MS_TOPE))[row * 2 + 1] = e1;
                    ((float*)(WSP + MS_TOPG))[row * 2] = g0; ((float*)(WSP + MS_TOPG))[row * 2 + 1] = g1;
                    __hip_atomic_fetch_add(&lcnt[e0], 1, __ATOMIC_RELAXED, __HIP_MEMORY_SCOPE_WORKGROUP); __hip_atomic_fetch_add(&lcnt[e1], 1, __ATOMIC_RELAXED, __HIP_MEMORY_SCOPE_WORKGROUP); }
            }
        }
    }
    if (mode == 2) { __syncthreads(); if (F.tid < 8) ((int*)(WSP + MS_CNT))[F.blk * 8 + F.tid] = lcnt[F.tid]; }
    __syncthreads();
}

__device__ __forceinline__ void phase_prep(Frame& F, int l) {
    KARGS();
    bf16* proj = (bf16*)(WSP + SC_PROJ); bf16* conva = (bf16*)(WSP + SC_CONVA); bf16* kvm = (bf16*)(WSP + MS_KVM) + (size_t)l * MROWS * 1024;
    const float* convw = IN(I_CONVW) + (size_t)l * 4 * 1536;
    const float* rc = (const float*)(WSP + MS_ROPE); const float* rs = rc + SEQ * 64;
    const int gw = F.blk * NWAVES + F.wave, NGW = F.G * NWAVES;
    const int lane = F.lane, li = lane & 15, d0 = li * 8;
    const float qscale = 0.08838834764831845f;
    LAS bf16* vt = (LAS bf16*)(F.lds + F.wave * 16896);
    for (int it = T * 8 + gw; it < T * 8 + MROWS + 1152; it += NGW) {
        if (it >= T * 8 + MROWS) {
            const int vi = it - (T * 8 + MROWS); const bf16* src; bf16* dst; int lds_;
            if (vi < 1024) { const int b = vi >> 7, h = (vi >> 5) & 3, c = vi & 31; src = proj + (size_t)(b * SEQ + c * CH) * NPROJ + C_VC + h * HD; lds_ = NPROJ; dst = (bf16*)(WSP + SC_VCT) + (size_t)vi * 8192; }
            else { const int mi = vi - 1024, b = mi >> 4, h = (mi >> 2) & 3, c = mi & 3; src = kvm + (size_t)(b * NMEM + c * CH) * 1024 + 512 + h * HD; lds_ = 1024; dst = (bf16*)(WSP + MS_VMT) + (size_t)mi * 8192; }
#pragma unroll 4
            for (int i = 0; i < 16; ++i) { const int row = 4 * i + (lane >> 4); const v4u w = *(const v4u*)(src + (size_t)row * lds_ + li * 8);
                LAS v2u* d = (LAS v2u*)(vt + row * 132 + li * 8); d[0] = (v2u){w.x, w.y}; d[1] = (v2u){w.z, w.w}; }
            asm volatile("s_waitcnt lgkmcnt(0)" ::: "memory");
            const int q4 = lane >> 4;
#pragma unroll 2
            for (int f = 0; f < 16; ++f) { const int mt8 = f >> 1, kt = f & 1; const LAS bf16* p = vt + (32 * kt + 4 * q4) * 132 + 16 * mt8 + li;
                v4u w; w.x = (unsigned)p[0] | ((unsigned)p[132] << 16); w.y = (unsigned)p[2 * 132] | ((unsigned)p[3 * 132] << 16);
                w.z = (unsigned)p[16 * 132] | ((unsigned)p[17 * 132] << 16); w.w = (unsigned)p[18 * 132] | ((unsigned)p[19 * 132] << 16);
                *(v4u*)(dst + (size_t)(f * 64 + lane) * 8) = w; }
            asm volatile("s_waitcnt lgkmcnt(0)" ::: "memory");
            continue; }
        if (it >= T * 8) {
            const int row = it - T * 8; bf16* p = kvm + (size_t)row * 1024 + lane * 8; float f[8]; unpack8(*(const v4u*)p, f);
            float ss = 0.f;
#pragma unroll
            for (int j = 0; j < 8; ++j) ss += f[j] * f[j];
            const float r = rsqrtf(grp16_sum(ss) * (1.0f / HD) + EPS); const float* gn = IN(I_MKG) + l * HD + d0;
#pragma unroll
            for (int j = 0; j < 8; ++j) f[j] = f[j] * r * gn[j];
            *(v4u*)p = pack8(f); continue; }
    }
    const int grp = gw & 7, tstart = gw >> 3, tstride = NGW >> 3;
    if (grp < 3) {
        const int c0 = grp * 512 + lane * 8; float w[4][8];
#pragma unroll
        for (int tap = 0; tap < 4; ++tap) { const f32x4 w0 = *(const f32x4*)(convw + tap * 1536 + c0), w1 = *(const f32x4*)(convw + tap * 1536 + c0 + 4);
            w[tap][0] = w0.x; w[tap][1] = w0.y; w[tap][2] = w0.z; w[tap][3] = w0.w; w[tap][4] = w1.x; w[tap][5] = w1.y; w[tap][6] = w1.z; w[tap][7] = w1.w; }
        for (int tb = tstart; tb < T; tb += 4 * tstride) {
            v4u xin[4][4];
#pragma unroll
            for (int u = 0; u < 4; ++u) { const int t = tb + u * tstride, pos = t & (SEQ - 1);
#pragma unroll
                for (int tap = 0; tap < 4; ++tap) { const int dp = pos - 3 + tap; const int tt = dp >= 0 ? t - 3 + tap : t;
                    xin[u][tap] = *(const v4u*)(proj + (size_t)tt * NPROJ + c0); } }
#pragma unroll
            for (int u = 0; u < 4; ++u) { const int t = tb + u * tstride, pos = t & (SEQ - 1); float a[8];
#pragma unroll
                for (int j = 0; j < 8; ++j) a[j] = 0.f;
#pragma unroll
                for (int tap = 0; tap < 4; ++tap) { float f[8]; unpack8(xin[u][tap], f); const float en = (pos - 3 + tap >= 0) ? 1.f : 0.f;
#pragma unroll
                    for (int j = 0; j < 8; ++j) a[j] += f[j] * (w[tap][j] * en); }
#pragma unroll
                for (int j = 0; j < 8; ++j) a[j] = silu_f(a[j]);
                if (grp < 2) { float ss = 0.f;
#pragma unroll
                    for (int j = 0; j < 8; ++j) ss += a[j] * a[j];
                    float r = rsqrtf(grp16_sum(ss) + EPS); if (grp == 0) r *= qscale;
#pragma unroll
                    for (int j = 0; j < 8; ++j) a[j] *= r; }
                *(v4u*)(conva + (size_t)t * 1536 + c0) = pack8(a); }
        }
    } else if (grp < 5) {
        const int i0 = (li & 7) * 8; const int col = (grp == 3 ? C_QB : C_KB) + lane * 8;
        for (int tb = tstart; tb < T; tb += 4 * tstride) {
            v4u xin[4]; f32x4 cs[4][4];
#pragma unroll
            for (int u = 0; u < 4; ++u) { const int t = tb + u * tstride, pos = t & (SEQ - 1); xin[u] = *(const v4u*)(proj + (size_t)t * NPROJ + col);
                cs[u][0] = *(const f32x4*)(rc + pos * 64 + i0); cs[u][1] = *(const f32x4*)(rc + pos * 64 + i0 + 4); cs[u][2] = *(const f32x4*)(rs + pos * 64 + i0); cs[u][3] = *(const f32x4*)(rs + pos * 64 + i0 + 4); }
#pragma unroll
            for (int u = 0; u < 4; ++u) { const int t = tb + u * tstride; float f[8], o[8]; unpack8(xin[u], f);
                const float c[8] = {cs[u][0].x, cs[u][0].y, cs[u][0].z, cs[u][0].w, cs[u][1].x, cs[u][1].y, cs[u][1].z, cs[u][1].w}, sn[8] = {cs[u][2].x, cs[u][2].y, cs[u][2].z, cs[u][2].w, cs[u][3].x, cs[u][3].y, cs[u][3].z, cs[u][3].w};
#pragma unroll
                for (int j = 0; j < 8; ++j) { const float other = __shfl_xor(f[j], 8); o[j] = li < 8 ? f[j] * c[j] - other * sn[j] : f[j] * c[j] + other * sn[j]; }
                if (grp == 4) {
#pragma unroll
                    for (int j = 0; j < 8; ++j) o[j] *= qscale; }
                *(v4u*)(proj + (size_t)t * NPROJ + col) = pack8(o); }
        }
    } else {
        const int col = (grp == 5 ? C_QC : (grp == 6 ? C_KC : C_QM)) + lane * 8; const float* gn = (grp == 5 ? IN(I_AQG) : (grp == 6 ? IN(I_AKG) : IN(I_MQG))) + l * HD + d0;
        float gv[8];
#pragma unroll
        for (int j = 0; j < 8; ++j) gv[j] = gn[j] * (grp != 6 ? qscale : 1.0f);
        for (int tb = tstart; tb < T; tb += 4 * tstride) {
            v4u xin[4];
#pragma unroll
            for (int u = 0; u < 4; ++u) xin[u] = *(const v4u*)(proj + (size_t)(tb + u * tstride) * NPROJ + col);
#pragma unroll
            for (int u = 0; u < 4; ++u) { float f[8]; unpack8(xin[u], f); float ss = 0.f;
#pragma unroll
                for (int j = 0; j < 8; ++j) ss += f[j] * f[j];
                const float r = rsqrtf(grp16_sum(ss) * (1.0f / HD) + EPS);
#pragma unroll
                for (int j = 0; j < 8; ++j) f[j] = f[j] * r * gv[j];
                *(v4u*)(proj + (size_t)(tb + u * tstride) * NPROJ + col) = pack8(f); }
        }
    }
}

__device__ __forceinline__ void phase_attn_naive(Frame& F, int l) {
    KARGS();
    const bf16* proj = (const bf16*)(WSP + SC_PROJ); const bf16* kvm = (const bf16*)(WSP + MS_KVM) + (size_t)l * MROWS * 1024; bf16* mix = (bf16*)(WSP + WS_HB);
    LAS float* sq = (LAS float*)F.lds + F.wave * 128;
    LAS float* sp = (LAS float*)(F.lds + 4096) + F.wave * 640;
    const float* relb = IN(I_RELB) + (size_t)l * NH * RELW;
    for (int u = F.blk; u < 2 * NB * NH * NCHUNK; u += F.G) {
        const int kind = u / (NB * NH * NCHUNK), r = u % (NB * NH * NCHUNK), b = r / (NH * NCHUNK), h = (r / NCHUNK) % NH, n = r % NCHUNK;
        const int c0 = kind == 0 ? (n - NPREV < 0 ? 0 : n - NPREV) : 0; const int nk = kind == 0 ? CH * (n - c0 + 1) : NMEM;
        const bf16* kb = kind == 0 ? proj + (size_t)(b * SEQ + c0 * CH) * NPROJ + C_KC + h * HD : kvm + (size_t)(b * NMEM) * 1024 + h * HD;
        const bf16* vb = kind == 0 ? proj + (size_t)(b * SEQ + c0 * CH) * NPROJ + C_VC + h * HD : kvm + (size_t)(b * NMEM) * 1024 + 512 + h * HD;
        const int ld = kind == 0 ? NPROJ : 1024;
        for (int qi = 0; qi < 8; ++qi) {
            const int ql = F.wave * 8 + qi, t = b * SEQ + n * CH + ql;
            const bf16* qp = proj + (size_t)t * NPROJ + (kind == 0 ? C_QC : C_QM) + h * HD;
            { const unsigned w = ((const unsigned*)qp)[F.lane]; sq[2 * F.lane] = bflo(w); sq[2 * F.lane + 1] = bfhi(w); }
            asm volatile("s_waitcnt lgkmcnt(0)" ::: "memory");
            float mx = -3.0e38f;
            for (int kk = F.lane; kk < nk; kk += 64) { const v4u* kr = (const v4u*)(kb + (size_t)kk * ld); float s = 0.f;
#pragma unroll
                for (int c = 0; c < 16; ++c) { float f[8]; unpack8(kr[c], f);
#pragma unroll
                    for (int j = 0; j < 8; ++j) s += f[j] * sq[c * 8 + j]; }
                if (kind == 0) { int rel = (n * CH + ql) - (c0 * CH + kk); rel = rel < -128 ? -128 : (rel > 128 ? 128 : rel); s += relb[h * RELW + rel + 128]; }
                sp[kk] = s; mx = fmaxf(mx, s); }
            mx = wave_max(mx); float sum = 0.f;
            for (int kk = F.lane; kk < nk; kk += 64) { const float p = __expf(sp[kk] - mx); sp[kk] = p; sum += p; }
            sum = wave_sum(sum); const float inv = 1.0f / sum;
            asm volatile("s_waitcnt lgkmcnt(0)" ::: "memory");
            float o0 = 0.f, o1 = 0.f;
            for (int kk = 0; kk < nk; ++kk) { const float p = sp[kk]; const unsigned w = *(const unsigned*)(vb + (size_t)kk * ld + 2 * F.lane); o0 += p * bflo(w); o1 += p * bfhi(w); }
            *(unsigned*)(mix + (size_t)t * D + (kind == 0 ? 1024 : 1536) + h * HD + 2 * F.lane) = pk2(o0 * inv, o1 * inv);
            asm volatile("s_waitcnt lgkmcnt(0)" ::: "memory");
        }
    }
}

__device__ __forceinline__ void phase_recur_naive(Frame& F, int l) {
    if (F.blk >= 2 * NB * NH) return;
    const int kind = F.blk / (NB * NH), b = (F.blk / NH) % NB, h = F.blk % NH;
    const bf16* proj = (const bf16*)(WSP + SC_PROJ); const bf16* conva = (const bf16*)(WSP + SC_CONVA); const float* gates = (const float*)(WSP + MS_GATES);
    float* obuf = (float*)(WSP + SC_OBUF);
    LAS float* sk = (LAS float*)F.lds; LAS float* sqv = sk + 128; LAS float* sv = sk + 256; LAS float* red = sk + 384; LAS float* red2 = sk + 896; LAS float* sab = sk + 1408;
    const int v = F.tid & 127, kg = F.tid >> 7;
    float s[32];
#pragma unroll
    for (int i = 0; i < 32; ++i) s[i] = 0.f;
    const float gam = 1.0f - exp2f(-5.0f - (float)h);
    const bf16* qb = kind == 0 ? conva + C_QA + h * HD : proj + C_QB + h * HD; const bf16* kb = kind == 0 ? conva + 512 + h * HD : proj + C_KB + h * HD; const bf16* vb = kind == 0 ? conva + 1024 + h * HD : proj + C_VB + h * HD;
    const int ld = kind == 0 ? 1536 : NPROJ;
    bf16 pk_ = 0, pq_ = 0, pv_ = 0; float pg_ = 0.f, pb_ = 0.f;
    { const int t = b * SEQ; if (F.tid < 128) { pk_ = kb[(size_t)t * ld + F.tid]; pq_ = qb[(size_t)t * ld + F.tid]; pv_ = vb[(size_t)t * ld + F.tid]; } if (kind == 0) { pg_ = gates[(size_t)t * 8 + h]; pb_ = gates[(size_t)t * 8 + 4 + h]; } }
    for (int tt = 0; tt < SEQ; ++tt) {
        const int t = b * SEQ + tt;
        if (F.tid < 128) { sk[F.tid] = bf2f(pk_); sqv[F.tid] = bf2f(pq_); sv[F.tid] = bf2f(pv_); }
        if (F.tid == 0) { if (kind == 0) { sab[0] = expf(pg_); sab[1] = pb_; } else { sab[0] = gam; sab[1] = 0.f; } }
        if (tt + 1 < SEQ) { const int t1 = t + 1; if (F.tid < 128) { pk_ = kb[(size_t)t1 * ld + F.tid]; pq_ = qb[(size_t)t1 * ld + F.tid]; pv_ = vb[(size_t)t1 * ld + F.tid]; } if (kind == 0) { pg_ = gates[(size_t)t1 * 8 + h]; pb_ = gates[(size_t)t1 * 8 + 4 + h]; } }
        __syncthreads();
        const float a = sab[0], bb = sab[1], bp = kind == 0 ? bb : 1.0f;
        float part = 0.f;
#pragma unroll
        for (int i = 0; i < 32; ++i) part += sk[kg * 32 + i] * s[i];
        red[kg * 128 + v] = part;
        __syncthreads();
        const float ks = (red[v] + red[128 + v]) + (red[256 + v] + red[384 + v]);
        const float dl = bp * sv[v] - a * bb * ks;
        float p2 = 0.f;
#pragma unroll
        for (int i = 0; i < 32; ++i) { s[i] = a * s[i] + sk[kg * 32 + i] * dl; p2 += sqv[kg * 32 + i] * s[i]; }
        red2[kg * 128 + v] = p2;
        __syncthreads();
        if (kg == 0) obuf[(size_t)t * 1024 + kind * 512 + h * HD + v] = (red2[v] + red2[128 + v]) + (red2[256 + v] + red2[384 + v]);
    }
}


template <int MT, int KS, int NTHR>
__device__ __forceinline__ void write_frags(const LAS bf16* X, int ldx, bf16* dst, int t0) {
    v2u lo[MT * KS * 64 / NTHR], hi[MT * KS * 64 / NTHR];
#pragma unroll
    for (int it = 0; it < MT * KS * 64 / NTHR; ++it) { const int idx = t0 + it * NTHR, ln = idx & 63, ks = (idx >> 6) % KS, mt = (idx >> 6) / KS, c16 = ln & 15, q4 = ln >> 4;
        const LAS bf16* p = X + (16 * mt + c16) * ldx + 32 * ks + 4 * q4; lo[it] = *(const LAS v2u*)p; hi[it] = *(const LAS v2u*)(p + 16); }
#pragma unroll
    for (int it = 0; it < MT * KS * 64 / NTHR; ++it) { const int idx = t0 + it * NTHR; *(v4u*)(dst + (size_t)idx * 8) = (v4u){lo[it].x, lo[it].y, hi[it].x, hi[it].y}; }
}
template <int I, int H> __device__ __forceinline__ void c1_load(f32x4 (&dst)[8], const LAS float* Lm) {
#pragma unroll
    for (int jj = 0; jj < 8; ++jj) { constexpr int dummy = 0; const int j4 = 8 * H + jj; if (j4 < (I + 3) / 4) dst[jj] = *(const LAS f32x4*)(Lm + I * 64 + 4 * j4); (void)dummy; }
}
template <int I, int H> __device__ __forceinline__ void c1_comp(const f32x4 (&src)[8], const float (&x)[64], float& a0, float& a1, float& a2, float& a3) {
#pragma unroll
    for (int jj = 0; jj < 8; ++jj) { const int j4 = 8 * H + jj; if (j4 < (I + 3) / 4) { const f32x4 lv = src[jj];
        if (4 * j4 + 0 < I) a0 += lv.x * x[4 * j4 + 0]; if (4 * j4 + 1 < I) a1 += lv.y * x[4 * j4 + 1]; if (4 * j4 + 2 < I) a2 += lv.z * x[4 * j4 + 2]; if (4 * j4 + 3 < I) a3 += lv.w * x[4 * j4 + 3]; } }
}
template <int I> struct C1Rows {
    static __device__ __forceinline__ void run(float (&x)[64], f32x4 (&la)[8], f32x4 (&lb)[8], const LAS float* Lm) {
        float a0 = 0.f, a1 = 0.f, a2 = 0.f, a3 = 0.f;
        c1_load<I, 1>(lb, Lm);
        __builtin_amdgcn_sched_barrier(0);
        c1_comp<I, 0>(la, x, a0, a1, a2, a3);
        __builtin_amdgcn_sched_barrier(0);
        if (I + 1 < 64) c1_load<(I + 1 < 64 ? I + 1 : 63), 0>(la, Lm);
        __builtin_amdgcn_sched_barrier(0);
        c1_comp<I, 1>(lb, x, a0, a1, a2, a3);
        x[I] = x[I] - ((a0 + a1) + (a2 + a3));
        __builtin_amdgcn_sched_barrier(0);
        C1Rows<I + 1>::run(x, la, lb, Lm);
    }
};
template <> struct C1Rows<64> { static __device__ __forceinline__ void run(float (&)[64], f32x4 (&)[8], f32x4 (&)[8], const LAS float*) {} };
constexpr int C1_HSZ = 77824;
__device__ __forceinline__ void phase_c1(Frame& F, int l) {
    const bf16* proj = (const bf16*)(WSP + SC_PROJ); const bf16* conva = (const bf16*)(WSP + SC_CONVA); const float* gates = (const float*)(WSP + MS_GATES);
    const int lane = F.lane, wave = F.wave, c16 = lane & 15, q4 = lane >> 4;
    const int hb = wave >> 2, lw = wave & 3, lt = F.tid & 255;
    LAS unsigned char* hl = F.lds + hb * C1_HSZ;
    LAS float* Lm = (LAS float*)hl; LAS float* Lm_u = Lm;
    LAS bf16* Xa = (LAS bf16*)(hl + 16384);
    LAS bf16* Xk = (LAS bf16*)(hl + 25088);
    LAS float* sgc = (LAS float*)(hl + 42496); LAS float* sbeta = sgc + 64; LAS float* seg = sgc + 128; LAS float* sbeta_u = sbeta; LAS float* seg_u = seg;
    LAS bf16* Xkr = (LAS bf16*)(hl + 43264);
    LAS bf16* Xw = Xkr;
    LAS bf16* Xv = (LAS bf16*)(hl + 60160);
    for (int u0 = F.blk; u0 < 2048; u0 += 2 * F.G) {
        const int uu = u0 + hb * F.G; const bool act = uu < 2048; const int u = act ? uu : 0;
        const int kind = u >> 10, r = u & 1023, b = r >> 7, h = (r >> 5) & 3, n = r & 31, t0 = b * SEQ + n * CH;
        const bf16* qb = kind == 0 ? conva + h * HD : proj + C_QB + h * HD; const bf16* kb = kind == 0 ? conva + 512 + h * HD : proj + C_KB + h * HD; const bf16* vb = kind == 0 ? conva + 1024 + h * HD : proj + C_VB + h * HD;
        const int ld = kind == 0 ? 1536 : NPROJ;
        unsigned char* rec = WSP + SC_PRE + (size_t)(kind * 1024 + (b * NH + h) * 32 + n) * REC_BYTES;
        bf16x8 qa[4];
        { const bf16* xq = qb + (size_t)(t0 + 16 * lw + c16) * ld + 8 * q4;
#pragma unroll
          for (int ks = 0; ks < 4; ++ks) qa[ks] = *(const bf16x8*)(xq + 32 * ks); }
        v4u qv[4], kv[4], vv[4];
        { const int row = lt >> 2, cb = (lt & 3) * 32; const size_t o = (size_t)(t0 + row) * ld + cb;
#pragma unroll
          for (int i = 0; i < 4; ++i) { qv[i] = *(const v4u*)(qb + o + 8 * i); kv[i] = *(const v4u*)(kb + o + 8 * i); vv[i] = *(const v4u*)(vb + o + 8 * i); } }
        if (lw == 0) { float g, be;
            if (kind == 0) { g = gates[(size_t)(t0 + lane) * 8 + h]; be = gates[(size_t)(t0 + lane) * 8 + 4 + h]; } else { g = log1pf(-exp2f(-5.0f - (float)h)); be = 1.0f; }
#pragma unroll
            for (int o = 1; o < 64; o <<= 1) { const float y = __shfl_up(g, o); if (lane >= o) g += y; }
            sgc[lane] = g; sbeta[lane] = be; seg[lane] = __expf(g);
            if (lane == 63 && act) ((float*)(WSP + MS_GTOT))[kind * 1024 + (b * NH + h) * 32 + n] = __expf(g); }
        __syncthreads();
        { const int row = lt >> 2, ksq = lt & 3, cb = ksq * 32; const float eq = seg[row], ek = __expf(sgc[63] - sgc[row]);
          float f[32];
#pragma unroll
          for (int i = 0; i < 4; ++i) { float t8[8]; unpack8(qv[i], t8);
#pragma unroll
              for (int j = 0; j < 8; ++j) f[8 * i + j] = t8[j] * eq; }
          if (act) { bf16* dq = (bf16*)(rec + REC_QF) + (size_t)((((row >> 4) * 4 + ksq) * 64) + (row & 15)) * 8;
#pragma unroll
              for (int qq = 0; qq < 4; ++qq) *(v4u*)(dq + (size_t)qq * 16 * 8) = (v4u){pk2(f[4 * qq], f[4 * qq + 1]), pk2(f[4 * qq + 2], f[4 * qq + 3]), pk2(f[16 + 4 * qq], f[16 + 4 * qq + 1]), pk2(f[16 + 4 * qq + 2], f[16 + 4 * qq + 3])}; }
          { LAS v2u* d = (LAS v2u*)(Xkr + row * 132 + cb);
#pragma unroll
            for (int i = 0; i < 4; ++i) { d[2 * i] = (v2u){kv[i].x, kv[i].y}; d[2 * i + 1] = (v2u){kv[i].z, kv[i].w}; } }
          { LAS v2u* d = (LAS v2u*)(Xv + row * 132 + cb);
#pragma unroll
            for (int i = 0; i < 4; ++i) { d[2 * i] = (v2u){vv[i].x, vv[i].y}; d[2 * i + 1] = (v2u){vv[i].z, vv[i].w}; } }
#pragma unroll
          for (int i = 0; i < 4; ++i) { float t8[8]; unpack8(kv[i], t8);
#pragma unroll
              for (int j = 0; j < 8; ++j) Xk[(cb + 8 * i + j) * 68 + row] = (bf16)f2bf(t8[j] * ek); } }
        __syncthreads();
        { const int mt = lw;
            bf16x8 bfr[16];
#pragma unroll
            for (int nt = 0; nt < 4; ++nt)
#pragma unroll
                for (int ks = 0; ks < 4; ++ks) { const LAS bf16* pb = Xkr + (16 * nt + c16) * 132 + 32 * ks + 8 * q4; const v2u lo = *(const LAS v2u*)pb, hi = *(const LAS v2u*)(pb + 4); bfr[nt * 4 + ks] = __builtin_bit_cast(bf16x8, (v4u){lo.x, lo.y, hi.x, hi.y}); }
#pragma unroll 1
            for (int mat = 0; mat < (kind == 0 ? 2 : 1); ++mat) {
                bf16x8 af[4];
                if (mat == 0) {
#pragma unroll
                    for (int ks = 0; ks < 4; ++ks) af[ks] = qa[ks];
                } else {
#pragma unroll
                    for (int ks = 0; ks < 4; ++ks) { const LAS bf16* pa = Xkr + (16 * mt + c16) * 132 + 32 * ks + 8 * q4; const v2u lo = *(const LAS v2u*)pa, hi = *(const LAS v2u*)(pa + 4); af[ks] = __builtin_bit_cast(bf16x8, (v4u){lo.x, lo.y, hi.x, hi.y}); } }
#pragma unroll
                for (int nt = 0; nt < 4; ++nt) { f32x4 acc = {0.f, 0.f, 0.f, 0.f};
#pragma unroll
                    for (int ks = 0; ks < 4; ++ks) acc = __builtin_amdgcn_mfma_f32_16x16x32_bf16(af[ks], bfr[nt * 4 + ks], acc, 0, 0, 0);
                    const int j = 16 * nt + c16; const float gj = sgc[j];
#pragma unroll
                    for (int rr = 0; rr < 4; ++rr) { const int i = 16 * mt + 4 * q4 + rr; const float dec = j <= i ? __expf(sgc[i] - gj) : 0.f;
                        if (mat == 0) Xa[i * 68 + j] = (bf16)f2bf(acc[rr] * dec); else Lm[i * 64 + j] = j < i ? acc[rr] * dec * sbeta[i] : 0.f; } } } }
        __syncthreads();
        if (act) { write_frags<4, 2, 256>(Xa, 68, (bf16*)(rec + REC_AF), lt); write_frags<8, 2, 256>(Xk, 68, (bf16*)(rec + REC_KF), lt); }
        { const int c = lt;
            int vz = 0; asm volatile("" : "+v"(vz));
            const LAS float* sbeta = sbeta_u + vz; const LAS float* seg = seg_u + vz; const LAS float* Lm = Lm_u + vz;
            if (kind == 0) { float x[64]; const LAS bf16* src = c < 128 ? Xv + c : Xkr + (c - 128);
#pragma unroll
                for (int i = 0; i < 64; ++i) { float rhs = bf2f(src[i * 132]) * sbeta[i]; if (c >= 128) rhs *= seg[i]; x[i] = rhs; }
                { f32x4 la[8], lb[8]; c1_load<1, 0>(la, Lm); C1Rows<1>::run(x, la, lb, Lm); }
                if (c < 128) { const int nt = c >> 4, cc = c & 15;
                    if (act) {
#pragma unroll
                    for (int mt = 0; mt < 4; ++mt)
#pragma unroll
                        for (int qq = 0; qq < 4; ++qq) *(f32x4*)(rec + REC_U + (size_t)(((nt * 4 + mt) * 64) + 16 * qq + cc) * 16) = (f32x4){x[16 * mt + 4 * qq], x[16 * mt + 4 * qq + 1], x[16 * mt + 4 * qq + 2], x[16 * mt + 4 * qq + 3]}; }
                } else {
#pragma unroll
                    for (int i = 0; i < 64; ++i) Xw[i * 132 + (c - 128)] = (bf16)f2bf(x[i]); }
            } else if (c < 128 && act) { const int nt = c >> 4, cc = c & 15;
#pragma unroll 1
                for (int i4 = 0; i4 < 16; ++i4) { const int mt = i4 >> 2, qq = i4 & 3; const LAS bf16* p = Xv + (4 * i4) * 132 + c;
                    *(f32x4*)(rec + REC_U + (size_t)(((nt * 4 + mt) * 64) + 16 * qq + cc) * 16) = (f32x4){bf2f(p[0]), bf2f(p[132]), bf2f(p[264]), bf2f(p[396])}; } }
        }
        __syncthreads();
        if (kind == 0 && act) write_frags<4, 4, 256>(Xw, 132, (bf16*)(rec + REC_WF), lt);
        __syncthreads();
    }
}
__device__ __forceinline__ bf16x8 pack_b(const f32x4 a, const f32x4 b) {
    v4u w; w.x = pg8::cvt_pk_bf16(a[0], a[1]); w.y = pg8::cvt_pk_bf16(a[2], a[3]); w.z = pg8::cvt_pk_bf16(b[0], b[1]); w.w = pg8::cvt_pk_bf16(b[2], b[3]); return __builtin_bit_cast(bf16x8, w); }
__device__ __forceinline__ void scan_dma(const unsigned char* rec, int pair, LAS unsigned char* buf, int wave, int lane) {
#pragma unroll
    for (int k = 0; k < 8; ++k) { const int i = wave * 8 + k;
        const unsigned char* src = i < 56 ? rec + i * 1024 : rec + REC_U + pair * 8192 + (i - 56) * 1024;
        __builtin_amdgcn_global_load_lds((const unsigned*)(src + lane * 16), (LAS unsigned*)(buf + i * 1024), 16, 0, 0); }
}
template <int BUF>
__device__ __forceinline__ void scan_step(LAS unsigned char* lds, f32x4 (&S)[8], const int kind, const float gt, float* op, const int wave, const int lane) {
    const LAS unsigned char* buf = lds + BUF * 65536;
    const LAS bf16x8* Qf = (const LAS bf16x8*)(buf + REC_QF) + lane; const LAS bf16x8* Kf = (const LAS bf16x8*)(buf + REC_KF) + lane;
    const LAS bf16x8* Af = (const LAS bf16x8*)(buf + REC_AF) + lane; const LAS bf16x8* Wf = (const LAS bf16x8*)(buf + REC_WF) + lane;
    const LAS f32x4* Uf = (const LAS f32x4*)(buf + 57344 + wave * 4096) + lane;
    bf16x8 Sb[4];
#pragma unroll
    for (int ks = 0; ks < 4; ++ks) Sb[ks] = pack_b(S[2 * ks], S[2 * ks + 1]);
    f32x4 vn[4]; bf16x8 fa[16], fb[8];
#pragma unroll
    for (int mt = 0; mt < 4; ++mt) vn[mt] = Uf[mt * 64];
    if (kind == 0) {
#pragma unroll
        for (int i = 0; i < 16; ++i) fa[i] = Wf[i * 64];
        __builtin_amdgcn_sched_barrier(0);
#pragma unroll
        for (int mt = 0; mt < 4; ++mt) { f32x4 acc = {0.f, 0.f, 0.f, 0.f};
#pragma unroll
            for (int ks = 0; ks < 4; ++ks) acc = __builtin_amdgcn_mfma_f32_16x16x32_bf16(fa[mt * 4 + ks], Sb[ks], acc, 0, 0, 0);
            vn[mt] = vn[mt] - acc; } }
#pragma unroll
    for (int i = 0; i < 16; ++i) fa[i] = Qf[i * 64];
#pragma unroll
    for (int i = 0; i < 8; ++i) fb[i] = Af[i * 64];
    __builtin_amdgcn_sched_barrier(0);
    bf16x8 Vb[2]; Vb[0] = pack_b(vn[0], vn[1]); Vb[1] = pack_b(vn[2], vn[3]);
    f32x4 o[4];
#pragma unroll
    for (int mt = 0; mt < 4; ++mt) { o[mt] = (f32x4){0.f, 0.f, 0.f, 0.f};
#pragma unroll
        for (int ks = 0; ks < 4; ++ks) o[mt] = __builtin_amdgcn_mfma_f32_16x16x32_bf16(fa[mt * 4 + ks], Sb[ks], o[mt], 0, 0, 0);
#pragma unroll
        for (int kt = 0; kt < 2; ++kt) o[mt] = __builtin_amdgcn_mfma_f32_16x16x32_bf16(fb[mt * 2 + kt], Vb[kt], o[mt], 0, 0, 0); }
    __builtin_amdgcn_sched_barrier(0);
#pragma unroll
    for (int i = 0; i < 16; ++i) fa[i] = Kf[i * 64];
#pragma unroll
    for (int mt = 0; mt < 4; ++mt) { float* p = op + (size_t)mt * 16 * 1024; p[0] = o[mt][0]; p[1024] = o[mt][1]; p[2048] = o[mt][2]; p[3072] = o[mt][3]; }
    __builtin_amdgcn_sched_barrier(0);
#pragma unroll
    for (int m8 = 0; m8 < 8; ++m8) { f32x4 a = S[m8] * gt;
#pragma unroll
        for (int kt = 0; kt < 2; ++kt) a = __builtin_amdgcn_mfma_f32_16x16x32_bf16(fa[m8 * 2 + kt], Vb[kt], a, 0, 0, 0);
        S[m8] = a; }
}
__device__ __forceinline__ void phase_scan(Frame& F, int l) {
    float* obuf = (float*)(WSP + SC_OBUF); const float* gtot = (const float*)(WSP + MS_GTOT);
    const int lane = F.lane, c16 = lane & 15, q4 = lane >> 4, wave = F.wave;
    for (int cb = F.blk; cb < 256; cb += F.G) {
        const int grp = (cb & 7) * 8 + (cb >> 5), pair = (cb >> 3) & 3, kind = grp >> 5, bh = grp & 31, b = bh >> 2, h = bh & 3, s8 = pair * 2 + wave;
        const unsigned char* rec0 = WSP + SC_PRE + (size_t)(kind * 1024 + bh * 32) * REC_BYTES;
        const float gtv = gtot[kind * 1024 + bh * 32 + (lane & 31)];
        float* op0 = obuf + (size_t)(b * SEQ + 4 * q4) * 1024 + kind * 512 + h * HD + 16 * s8 + c16;
        f32x4 S[8];
#pragma unroll
        for (int i = 0; i < 8; ++i) S[i] = (f32x4){0.f, 0.f, 0.f, 0.f};
        scan_dma(rec0, pair, F.lds, wave, lane);
#pragma unroll 1
        for (int n = 0; n < NCHUNK; n += 2) {
            asm volatile("s_waitcnt vmcnt(0)" ::: "memory"); __builtin_amdgcn_s_barrier(); asm volatile("" ::: "memory");
            scan_dma(rec0 + (size_t)(n + 1) * REC_BYTES, pair, F.lds + 65536, wave, lane);
            if (wave < 2) scan_step<0>(F.lds, S, kind, __shfl(gtv, n), op0 + (size_t)n * CH * 1024, wave, lane);
            asm volatile("s_waitcnt vmcnt(0)" ::: "memory"); __builtin_amdgcn_s_barrier(); asm volatile("" ::: "memory");
            if (n + 2 < NCHUNK) scan_dma(rec0 + (size_t)(n + 2) * REC_BYTES, pair, F.lds, wave, lane);
            if (wave < 2) scan_step<1>(F.lds, S, kind, __shfl(gtv, n + 1), op0 + (size_t)(n + 1) * CH * 1024, wave, lane);
        }
        asm volatile("s_waitcnt vmcnt(0) lgkmcnt(0)" ::: "memory"); __builtin_amdgcn_s_barrier(); asm volatile("" ::: "memory");
    }
}

__device__ __forceinline__ void scan_dma8(const unsigned char* rec, LAS unsigned char* buf, int wave, int lane) {
#pragma unroll
    for (int k = 0; k < 7; ++k) { const int i = wave * 7 + k;
        __builtin_amdgcn_global_load_lds((const unsigned*)(rec + i * 1024 + lane * 16), (LAS unsigned*)(buf + i * 1024), 16, 0, 0); }
}
template <int BUF>
__device__ __forceinline__ void scan_step8(LAS unsigned char* lds, f32x4 (&S)[8], f32x4 (&un)[4], const unsigned char* unext, const int kind, const float gt, float* op, const int lane) {
    const LAS unsigned char* buf = lds + BUF * 65536;
    const LAS bf16x8* Qf = (const LAS bf16x8*)(buf + REC_QF) + lane; const LAS bf16x8* Kf = (const LAS bf16x8*)(buf + REC_KF) + lane;
    const LAS bf16x8* Af = (const LAS bf16x8*)(buf + REC_AF) + lane; const LAS bf16x8* Wf = (const LAS bf16x8*)(buf + REC_WF) + lane;
    bf16x8 Sb[4];
#pragma unroll
    for (int ks = 0; ks < 4; ++ks) Sb[ks] = pack_b(S[2 * ks], S[2 * ks + 1]);
    f32x4 vn[4]; bf16x8 fa[16], fb[8];
#pragma unroll
    for (int mt = 0; mt < 4; ++mt) vn[mt] = un[mt];
    if (unext) {
#pragma unroll
        for (int mt = 0; mt < 4; ++mt) un[mt] = *(const f32x4*)(unext + mt * 1024); }
    if (kind == 0) {
#pragma unroll
        for (int i = 0; i < 16; ++i) fa[i] = Wf[i * 64];
        __builtin_amdgcn_sched_barrier(0);
#pragma unroll
        for (int mt = 0; mt < 4; ++mt) { f32x4 acc = {0.f, 0.f, 0.f, 0.f};
#pragma unroll
            for (int ks = 0; ks < 4; ++ks) acc = __builtin_amdgcn_mfma_f32_16x16x32_bf16(fa[mt * 4 + ks], Sb[ks], acc, 0, 0, 0);
            vn[mt] = vn[mt] - acc; } }
#pragma unroll
    for (int i = 0; i < 16; ++i) fa[i] = Qf[i * 64];
#pragma unroll
    for (int i = 0; i < 8; ++i) fb[i] = Af[i * 64];
    __builtin_amdgcn_sched_barrier(0);
    bf16x8 Vb[2]; Vb[0] = pack_b(vn[0], vn[1]); Vb[1] = pack_b(vn[2], vn[3]);
    f32x4 o[4];
#pragma unroll
    for (int mt = 0; mt < 4; ++mt) { o[mt] = (f32x4){0.f, 0.f, 0.f, 0.f};
#pragma unroll
        for (int ks = 0; ks < 4; ++ks) o[mt] = __builtin_amdgcn_mfma_f32_16x16x32_bf16(fa[mt * 4 + ks], Sb[ks], o[mt], 0, 0, 0);
#pragma unroll
        for (int kt = 0; kt < 2; ++kt) o[mt] = __builtin_amdgcn_mfma_f32_16x16x32_bf16(fb[mt * 2 + kt], Vb[kt], o[mt], 0, 0, 0); }
    __builtin_amdgcn_sched_barrier(0);
#pragma unroll
    for (int i = 0; i < 16; ++i) fa[i] = Kf[i * 64];
#pragma unroll
    for (int mt = 0; mt < 4; ++mt) { float* p = op + (size_t)mt * 16 * 1024; p[0] = o[mt][0]; p[1024] = o[mt][1]; p[2048] = o[mt][2]; p[3072] = o[mt][3]; }
    __builtin_amdgcn_sched_barrier(0);
#pragma unroll
    for (int m8 = 0; m8 < 8; ++m8) { f32x4 a = S[m8] * gt;
#pragma unroll
        for (int kt = 0; kt < 2; ++kt) a = __builtin_amdgcn_mfma_f32_16x16x32_bf16(fa[m8 * 2 + kt], Vb[kt], a, 0, 0, 0);
        S[m8] = a; }
}
__device__ __forceinline__ void phase_scan8(Frame& F, int l) {
    float* obuf = (float*)(WSP + SC_OBUF); const float* gtot = (const float*)(WSP + MS_GTOT);
    const int lane = F.lane, c16 = lane & 15, q4 = lane >> 4, wave = F.wave;
    const int grp = (F.blk & 7) * 8 + (F.blk >> 3), kind = grp >> 5, bh = grp & 31, b = bh >> 2, h = bh & 3;
    const unsigned char* rec0 = WSP + SC_PRE + (size_t)(kind * 1024 + bh * 32) * REC_BYTES;
    const float gtv = gtot[kind * 1024 + bh * 32 + (lane & 31)];
    float* op0 = obuf + (size_t)(b * SEQ + 4 * q4) * 1024 + kind * 512 + h * HD + 16 * wave + c16;
    const unsigned char* up = rec0 + REC_U + wave * 4096 + lane * 16;
    f32x4 S[8], ua[4];
#pragma unroll
    for (int i = 0; i < 8; ++i) S[i] = (f32x4){0.f, 0.f, 0.f, 0.f};
#pragma unroll
    for (int mt = 0; mt < 4; ++mt) ua[mt] = *(const f32x4*)(up + mt * 1024);
    scan_dma8(rec0, F.lds, wave, lane);
#pragma unroll 1
    for (int n = 0; n < NCHUNK; n += 2) {
        asm volatile("s_waitcnt vmcnt(0)" ::: "memory"); __builtin_amdgcn_s_barrier(); asm volatile("" ::: "memory");
        scan_dma8(rec0 + (size_t)(n + 1) * REC_BYTES, F.lds + 65536, wave, lane);
        scan_step8<0>(F.lds, S, ua, up + (size_t)(n + 1) * REC_BYTES, kind, __shfl(gtv, n), op0 + (size_t)n * CH * 1024, lane);
        asm volatile("s_waitcnt vmcnt(0)" ::: "memory"); __builtin_amdgcn_s_barrier(); asm volatile("" ::: "memory");
        if (n + 2 < NCHUNK) scan_dma8(rec0 + (size_t)(n + 2) * REC_BYTES, F.lds, wave, lane);
        scan_step8<1>(F.lds, S, ua, n + 2 < NCHUNK ? up + (size_t)(n + 2) * REC_BYTES : nullptr, kind, __shfl(gtv, n + 1), op0 + (size_t)(n + 1) * CH * 1024, lane);
    }
    asm volatile("s_waitcnt vmcnt(0) lgkmcnt(0)" ::: "memory"); __builtin_amdgcn_s_barrier(); asm volatile("" ::: "memory");
}

constexpr int AT_STAGE = 32768, AT_TB = 4 * AT_STAGE;
__device__ __forceinline__ void attn_dma(const bf16* ktile, const bf16* vtile, const unsigned (&koff)[2], const unsigned voff, LAS unsigned char* st, int wave) {
#pragma unroll
    for (int k = 0; k < 2; ++k) __builtin_amdgcn_global_load_lds((const unsigned*)((const char*)ktile + koff[k]), (LAS unsigned*)(st + (2 * wave + k) * 1024), 16, 0, 0);
#pragma unroll
    for (int k = 0; k < 2; ++k) __builtin_amdgcn_global_load_lds((const unsigned*)((const char*)vtile + voff + k * 1024), (LAS unsigned*)(st + 16384 + (2 * wave + k) * 1024), 16, 0, 0);
}
template <int STG>
__device__ __forceinline__ void attn_tile(LAS unsigned char* lds, const int (&kx)[4], const bf16x8 (&Qb)[4], f32x4 (&oacc)[8], float& m, float& lsum, const bool band, const int dn, const int rb0, const LAS float* tb, const int lane) {
    const LAS unsigned char* st = lds + STG * AT_STAGE;
    bf16x8 fr[16];
#pragma unroll
    for (int mt = 0; mt < 4; ++mt)
#pragma unroll
        for (int ks = 0; ks < 4; ++ks) fr[mt * 4 + ks] = *(const LAS bf16x8*)(st + mt * 4096 + kx[ks]);
    __builtin_amdgcn_sched_barrier(0);
    f32x4 sc[4];
#pragma unroll
    for (int mt = 0; mt < 4; ++mt) { sc[mt] = (f32x4){0.f, 0.f, 0.f, 0.f};
#pragma unroll
        for (int ks = 0; ks < 4; ++ks) sc[mt] = __builtin_amdgcn_mfma_f32_16x16x32_bf16(fr[mt * 4 + ks], Qb[ks], sc[mt], 0, 0, 0); }
    __builtin_amdgcn_sched_barrier(0);
#pragma unroll
    for (int i = 0; i < 16; ++i) fr[i] = *(const LAS bf16x8*)(st + 16384 + (i * 64 + lane) * 16);
    __builtin_amdgcn_sched_barrier(0);
    if (band) {
        if (dn >= 3) { const float bc = tb[256];
#pragma unroll
            for (int mt = 0; mt < 4; ++mt) sc[mt] = sc[mt] + bc; }
        else { const int rb = 64 * dn + rb0;
#pragma unroll
            for (int mt = 0; mt < 4; ++mt)
#pragma unroll
                for (int rr = 0; rr < 4; ++rr) { int idx = rb - 16 * mt - rr; idx = idx < 0 ? 0 : (idx > 256 ? 256 : idx); sc[mt][rr] += tb[idx]; } } }
    float mx = fmaxf(fmaxf(fmaxf(sc[0][0], sc[0][1]), fmaxf(sc[0][2], sc[0][3])), fmaxf(fmaxf(sc[1][0], sc[1][1]), fmaxf(sc[1][2], sc[1][3])));
    mx = fmaxf(mx, fmaxf(fmaxf(fmaxf(sc[2][0], sc[2][1]), fmaxf(sc[2][2], sc[2][3])), fmaxf(fmaxf(sc[3][0], sc[3][1]), fmaxf(sc[3][2], sc[3][3]))));
    mx = fmaxf(mx, __shfl_xor(mx, 16)); mx = fmaxf(mx, __shfl_xor(mx, 32));
    const float mn = fmaxf(m, mx), alpha = __expf(m - mn); m = mn;
    float ps = 0.f;
#pragma unroll
    for (int mt = 0; mt < 4; ++mt)
#pragma unroll
        for (int rr = 0; rr < 4; ++rr) { const float e = __expf(sc[mt][rr] - mn); sc[mt][rr] = e; ps += e; }
    lsum = lsum * alpha + ps;
#pragma unroll
    for (int i = 0; i < 8; ++i) oacc[i] = oacc[i] * alpha;
    bf16x8 Pb[2]; Pb[0] = pack_b(sc[0], sc[1]); Pb[1] = pack_b(sc[2], sc[3]);
#pragma unroll
    for (int m8 = 0; m8 < 8; ++m8)
#pragma unroll
        for (int kt = 0; kt < 2; ++kt) oacc[m8] = __builtin_amdgcn_mfma_f32_16x16x32_bf16(fr[m8 * 2 + kt], Pb[kt], oacc[m8], 0, 0, 0);
}
__device__ __forceinline__ void phase_attn(Frame& F, int l, const bool shared_step) {
    KARGS();
    const bf16* proj = (const bf16*)(WSP + SC_PROJ); const bf16* kvm = (const bf16*)(WSP + MS_KVM) + (size_t)l * MROWS * 1024; bf16* mix = (bf16*)(WSP + WS_HB);
    const bf16* vct = (const bf16*)(WSP + SC_VCT); const bf16* vmt = (const bf16*)(WSP + MS_VMT);
    const float* relb = IN(I_RELB) + (size_t)l * NH * RELW;
    const int lane = F.lane, c16 = lane & 15, q4 = lane >> 4, w4 = F.wave & 3, g = F.wave >> 2, wave = F.wave;
    LAS float* tb = (LAS float*)(F.lds + AT_TB);
    int kx[4];
#pragma unroll
    for (int ks = 0; ks < 4; ++ks) kx[ks] = c16 * 256 + (((4 * ks + q4) ^ c16) << 4);
    const int vcu = (F.G & 7) == 0 ? (F.blk & 7) * (F.G >> 3) + (F.blk >> 3) : F.blk;
    const int lb = (F.blk >> 3) - 8;
    for (int it = 0; ; ++it) {
        int p;
        if (shared_step) {
            int j;
            if (it < 5) j = it * 24 + lb; else { if (it > 5 || lb < 8 || lb >= 16) break; j = 112 + lb; }
            int kd, bhl, pn;
            if (j < 48) { kd = 0; bhl = j / 12; pn = 4 + (j - bhl * 12); }
            else if (j < 60) { kd = 0; bhl = (j - 48) & 3; pn = 3 - ((j - 48) >> 2); }
            else if (j < 124) { kd = 1; bhl = (j - 60) >> 4; pn = (j - 60) & 15; }
            else { kd = 0; bhl = j - 124; pn = 0; }
            p = kd * 512 + ((F.blk & 7) * 4 + bhl) * 16 + pn;
        } else { p = vcu + it * F.G; if (p >= 1024) break; }
        const int u0 = 2 * p, kind = u0 >> 10, r = u0 & 1023, b = r >> 7, h = (r >> 5) & 3, n0 = r & 31, n = n0 + g;
        const int cs = kind == 0 ? (n0 - NPREV < 0 ? 0 : n0 - NPREV) : 0, nts = kind == 0 ? n0 + 2 - cs : 4;
        const int c0 = kind == 0 ? (n - NPREV < 0 ? 0 : n - NPREV) : 0, lo = c0 - cs, hi = kind == 0 ? n + 1 - cs : 4;
        const int tq = b * SEQ + n * CH + 16 * w4;
        const bf16* qrow = proj + (size_t)(tq + c16) * NPROJ + (kind == 0 ? C_QC : C_QM) + h * HD + 8 * q4;
        const bf16* kbase = kind == 0 ? proj + (size_t)(b * SEQ + cs * CH) * NPROJ + C_KC + h * HD : kvm + (size_t)(b * NMEM) * 1024 + h * HD;
        const int ldk = kind == 0 ? NPROJ : 1024;
        const bf16* vtb = kind == 0 ? vct + (size_t)((b * NH + h) * NCHUNK + cs) * 8192 : vmt + (size_t)((b * NH + h) * 4) * 8192;
        bf16x8 Qb[4];
#pragma unroll
        for (int ks = 0; ks < 4; ++ks) Qb[ks] = *(const bf16x8*)(qrow + 32 * ks);
        float tbv = 0.f;
        if (kind == 0 && wave < 5) { const int idx = lane + 64 * wave; tbv = relb[h * RELW + (idx < RELW ? idx : RELW - 1)]; }
        asm volatile("s_waitcnt vmcnt(0)" ::: "memory");
        if (kind == 0 && wave < 5) { const int idx = lane + 64 * wave; if (idx < RELW) tb[idx] = tbv; }
        f32x4 oacc[8];
#pragma unroll
        for (int i = 0; i < 8; ++i) oacc[i] = (f32x4){0.f, 0.f, 0.f, 0.f};
        float m = -1.0e30f, lsum = 0.f;
        const int rb0 = 16 * w4 + c16 - 4 * q4 + 128;
        unsigned koff[2];
#pragma unroll
        for (int k = 0; k < 2; ++k) { const int row = 8 * wave + 4 * k + q4; koff[k] = (unsigned)(row * ldk + ((c16 ^ (row & 15)) << 3)) * 2u; }
        const unsigned voff = (unsigned)((2 * wave) * 64 + lane) * 16u;
#define AT_ISSUE(tile, stg) do { const int tc_ = (tile) < nts ? (tile) : nts - 1; attn_dma(kbase + (size_t)tc_ * CH * ldk, vtb + (size_t)tc_ * 8192, koff, voff, F.lds + (stg) * AT_STAGE, wave); } while (0)
#define AT_STEP(k) do { asm volatile("s_waitcnt vmcnt(8) lgkmcnt(0)" ::: "memory"); __builtin_amdgcn_s_barrier(); asm volatile("" ::: "memory"); \
            AT_ISSUE(ti + (k) + 3, ((k) + 3) & 3); \
            if (ti + (k) >= lo && ti + (k) < hi) attn_tile<(k)>(F.lds, kx, Qb, oacc, m, lsum, kind == 0, n - (cs + ti + (k)), rb0, tb, lane); } while (0)
        AT_ISSUE(0, 0); AT_ISSUE(1, 1); AT_ISSUE(2, 2);
#pragma unroll 1
        for (int ti = 0; ti < nts; ti += 4) {
            AT_STEP(0);
            if (ti + 1 < nts) AT_STEP(1);
            if (ti + 2 < nts) AT_STEP(2);
            if (ti + 3 < nts) AT_STEP(3);
        }
#undef AT_STEP
#undef AT_ISSUE
        lsum += __shfl_xor(lsum, 16); lsum += __shfl_xor(lsum, 32);
        const float inv = 1.0f / lsum;
        const int ocol = (kind == 0 ? 1024 : 1536) + h * HD + 4 * q4;
#pragma unroll
        for (int m8 = 0; m8 < 8; ++m8) { const f32x4 o = oacc[m8] * inv; *(v2u*)((unsigned char*)mix + img_off(tq + c16, (ocol + 16 * m8) * 2, D * 2)) = (v2u){pg8::cvt_pk_bf16(o[0], o[1]), pg8::cvt_pk_bf16(o[2], o[3])}; }
        asm volatile("s_waitcnt vmcnt(0) lgkmcnt(0)" ::: "memory"); __builtin_amdgcn_s_barrier(); asm volatile("" ::: "memory");
    }
}

__device__ __forceinline__ void phase_post(Frame& F, int l) {
    KARGS();
    const bf16* proj = (const bf16*)(WSP + SC_PROJ); const float* obuf = (const float*)(WSP + SC_OBUF); bf16* mix = (bf16*)(WSP + WS_HB);
    const int gw = F.blk * NWAVES + F.wave, NGW = F.G * NWAVES, lane = F.lane, li = lane & 15, d0 = li * 8, h = lane >> 4;
    const int kind = gw & 1, tstart = gw >> 1, tstride = NGW >> 1;
    float gv[8]; { const float* gn = kind == 0 ? IN(I_DNG) + l * HD + d0 : IN(I_RNG) + l * GW + h * HD + d0;
#pragma unroll
        for (int j = 0; j < 8; ++j) gv[j] = gn[j]; }
    for (int tb = tstart; tb < T; tb += 4 * tstride) {
        f32x4 a0[4], a1[4]; v4u zz[4];
#pragma unroll
        for (int u = 0; u < 4; ++u) { const int t = tb + u * tstride; a0[u] = *(const f32x4*)(obuf + (size_t)t * 1024 + kind * 512 + lane * 8); a1[u] = *(const f32x4*)(obuf + (size_t)t * 1024 + kind * 512 + lane * 8 + 4);
            zz[u] = *(const v4u*)(proj + (size_t)t * NPROJ + (kind == 0 ? C_ZA : C_GB) + lane * 8); }
#pragma unroll
        for (int u = 0; u < 4; ++u) { const int t = tb + u * tstride;
            float o[8] = {a0[u].x, a0[u].y, a0[u].z, a0[u].w, a1[u].x, a1[u].y, a1[u].z, a1[u].w}; float z[8]; unpack8(zz[u], z);
            if (kind == 0) { float ss = 0.f;
#pragma unroll
                for (int j = 0; j < 8; ++j) ss += o[j] * o[j];
                const float r = rsqrtf(grp16_sum(ss) * (1.0f / HD) + EPS);
#pragma unroll
                for (int j = 0; j < 8; ++j) o[j] = o[j] * r * gv[j] * silu_f(z[j]);
            } else { float sm = 0.f;
#pragma unroll
                for (int j = 0; j < 8; ++j) sm += o[j];
                const float mu = grp16_sum(sm) * (1.0f / HD); float sv = 0.f;
#pragma unroll
                for (int j = 0; j < 8; ++j) { o[j] -= mu; sv += o[j] * o[j]; }
                const float r = rsqrtf(grp16_sum(sv) * (1.0f / HD) + EPS);
#pragma unroll
                for (int j = 0; j < 8; ++j) o[j] = o[j] * r * gv[j] * silu_f(z[j]); }
            *(v4u*)((unsigned char*)mix + img_off(t, (kind * 512 + lane * 8) * 2, D * 2)) = pack8(o); }
    }
}

__device__ __forceinline__ void phase_route(Frame& F) {
    LAS int* lc = (LAS int*)F.lds;
    LAS int* base = lc + 2048;
    LAS int* tot = base + 8; LAS int* tst = tot + 8; LAS int* spos = tst + 16;
    const int* cnt = (const int*)(WSP + MS_CNT); const int* tope = (const int*)(WSP + MS_TOPE); const float* topg = (const float*)(WSP + MS_TOPG);
    int* pos = (int*)(WSP + MS_POS); float* rowg = (float*)(WSP + MS_ROWG); int* tile = (int*)(WSP + MS_TILE);
    const bf16* h2 = (const bf16*)(WSP + WS_HB); bf16* xs = (bf16*)(WSP + SC_XS);
    const int rpb = T / F.G;
    for (int i = F.tid; i < F.G * 8; i += NTHREADS) lc[i] = cnt[i];
    __syncthreads();
    if (F.tid < 8) { int before = 0, total = 0; for (int bI = 0; bI < F.G; ++bI) { const int c = lc[bI * 8 + F.tid]; if (bI < F.blk) before += c; total += c; } base[F.tid] = before; tot[F.tid] = total; }
    __syncthreads();
    if (F.tid == 0) { int ts = 0; for (int e = 0; e < 8; ++e) { tst[e] = ts; ts += (tot[e] + 255) >> 8; } tst[8] = ts;
        if (F.blk == 0) tile[0] = ts; }
    __syncthreads();
    if (F.blk == 0 && F.tid < tst[8]) { int e = 0;
#pragma unroll 1
        for (int q = 1; q < 8; ++q) e += (F.tid >= tst[q]) ? 1 : 0;
        tile[16 + F.tid] = e; }
    if (F.tid < 8) { int cursor = tst[F.tid] * 256 + base[F.tid];
        for (int i = 0; i < 2 * rpb; ++i) { const int tok = F.blk * rpb + (i >> 1); if (tope[tok * 2 + (i & 1)] == F.tid) { spos[i] = cursor; pos[tok * 2 + (i & 1)] = cursor; rowg[cursor] = topg[tok * 2 + (i & 1)]; ++cursor; } } }
    __syncthreads();
    unsigned char* xs8 = (unsigned char*)xs; const float* sa = (const float*)(WSP + MS_SA); float* sxs = (float*)(WSP + MS_SXS);
    for (int i = F.wave; i < 2 * rpb; i += NWAVES) { const int tok = F.blk * rpb + (i >> 1), prow = spos[i];
        v4u w[2];
#pragma unroll
        for (int j = 0; j < 2; ++j) w[j] = *(const v4u*)((const unsigned char*)h2 + img_off(tok, 1024 * j + 16 * F.lane, D));
#pragma unroll
        for (int j = 0; j < 2; ++j) *(v4u*)(xs8 + img_off(prow, 1024 * j + 16 * F.lane, D)) = w[j];
        if (F.lane == 0) sxs[prow] = sa[tok]; }
    const unsigned z0 = (unsigned)F.tid >> 31;
    if (F.blk < 8) { const int e = F.blk, lo = tst[e] * 256 + tot[e], hi = tst[e + 1] * 256;
        for (int r = lo + F.wave; r < hi; r += NWAVES) { rowg[r] = 0.f; if (F.lane == 0) sxs[r] = 0.f;
#pragma unroll
            for (int j = 0; j < 2; ++j) *(v4u*)(xs8 + img_off(r, 1024 * j + 16 * F.lane, D)) = (v4u){z0, z0, z0, z0}; } }
    __syncthreads();
}
__device__ __forceinline__ void phase_combine(Frame& F) {
    const int* pos = (const int*)(WSP + MS_POS); const bf16* Y = (const bf16*)(WSP + SC_Y); const bf16* x3 = (const bf16*)(WSP + WS_XB) + (size_t)T * D;
    const int gw = F.blk * NWAVES + F.wave, NGW = F.G * NWAVES;
    for (int t = gw; t < T; t += NGW) { const int p0 = pos[t * 2], p1 = pos[t * 2 + 1];
        f32x4* o = (f32x4*)(OUTP + (size_t)t * D) + F.lane; const v2u* xr = (const v2u*)(x3 + (size_t)t * D) + F.lane; const v2u* y0 = (const v2u*)(Y + (size_t)p0 * D) + F.lane; const v2u* y1 = (const v2u*)(Y + (size_t)p1 * D) + F.lane;
#pragma unroll
        for (int j = 0; j < 8; ++j) { const v2u xx = xr[64 * j], a = y0[64 * j], c = y1[64 * j]; f32x4 x;
            x.x = bflo(xx.x) + bflo(a.x) + bflo(c.x); x.y = bfhi(xx.x) + bfhi(a.x) + bfhi(c.x); x.z = bflo(xx.y) + bflo(a.y) + bflo(c.y); x.w = bfhi(xx.y) + bfhi(a.y) + bfhi(c.y); o[64 * j] = x; } }
}

constexpr int STEPS_PER_LAYER = 12, N_STEPS = 1 + 2 * STEPS_PER_LAYER;
__global__ void __launch_bounds__(NTHREADS, 2) fwd(Args args) {
    extern __shared__ __attribute__((aligned(16))) unsigned char lds_raw[];
    Frame F; F.lds = (LAS unsigned char*)lds_raw; F.tid = threadIdx.x; F.lane = F.tid & 63; F.wave = __builtin_amdgcn_readfirstlane(F.tid >> 6); F.G = gridDim.x; F.blk = blockIdx.x;
    F.ap = (const __attribute__((address_space(4))) Args*)__builtin_amdgcn_kernarg_segment_ptr();
    F.out = (GAS float*)args.out; F.ws = (GAS unsigned char*)args.ws;
    volatile LAS unsigned* MISC = (volatile LAS unsigned*)(F.lds + LDS_CTL_OFF);
    if (F.tid < 64) MISC[F.tid] = 0u;
    __syncthreads();
    XcdBarrier bar = xcd_barrier_post((unsigned*)(WSP + WS_CTL) + CW_BAR, MISC + 8);
    const int lo = args.step_lo, hi = args.step_hi;
    bool first = true;
#ifndef ONLY
#define ONLY -1
#endif
#define EN(j) (ONLY < 0 || ONLY == (j))
#define FRESH() Frame P = F; asm volatile("" : "+s"(P.ws), "+s"(P.out), "+s"(P.ap), "+s"(P.blk), "+s"(P.G), "+s"(P.wave), "+v"(P.tid), "+v"(P.lane))
#define STEP(k) if (lo <= (k) && (k) < hi && (first ? (first = false, true) : (xcd_barrier(bar), true)))
    STEP(0) { FRESH(); if (EN(0)) phase_p0(P); }
#pragma unroll 1
    for (int l = 0; l < 2; ++l) {
        const int sb = 1 + l * STEPS_PER_LAYER;
        STEP(sb + 0) { FRESH(); { Frame& F = P; KARGS(); const void* xin = l == 0 ? (const void*)IN(I_X) : (const void*)(WSP + WS_XB); if (EN(1)) {
                if (l == 0) {
                    pg8::PlainSched S; S.A = nullptr; S.B = nullptr; S.nM = 0; S.nN = 0; S.G = F.G; S.c = F.blk; S.tstep = (size_t)256 * D * 2;
                    S.A2 = (const char*)(WSP + MS_MEMH); S.B2 = (const char*)(WSP + WS_WMKV); S.a2stride = (size_t)MROWS * D * 2; S.b2stride = (size_t)1024 * D * 2; S.n2 = 2;
                    pg8::EpiProj E{(bf16*)(WSP + SC_PROJ), (bf16*)(WSP + MS_KVM), (size_t)MROWS * 1024, nullptr, 1.0f};
                    pg8::gemm_phase<0>(F.lds, F.tid, D * 2, S, E);
                    if (F.blk >= 64) phase_rmsnorm(F, xin, l, IN(I_NMIXG) + (size_t)l * D, (bf16*)(WSP + WS_HB), 1, l, F.blk - 64, F.G - 64);
                } else phase_rmsnorm(F, xin, l, IN(I_NMIXG) + (size_t)l * D, (bf16*)(WSP + WS_HB), 1, l, F.blk, F.G); } } }
        STEP(sb + 1) { FRESH(); Frame& F = P;
#if W_IN_I8
            pg8::PlainSched S; S.A = (const char*)(WSP + WS_HB); S.B = (const char*)(WSP + WS_WIN) + (size_t)l * NPROJ * D; S.nM = T / 256; S.nN = NPROJ / 256; S.G = F.G; S.c = F.blk; S.tstep = (size_t)256 * D;
            S.A2 = nullptr; S.B2 = nullptr; S.a2stride = 0; S.b2stride = 0; S.n2 = 0;
            pg8::EpiProj E{(bf16*)(WSP + SC_PROJ), (bf16*)(WSP + MS_KVM), (size_t)MROWS * 1024, (const float*)(WSP + MS_SA), INV_SW_D};
            if (EN(2)) pg8::gemm_phase<2>(F.lds, F.tid, D, S, E);
#else
            pg8::PlainSched S; S.A = (const char*)(WSP + WS_HB); S.B = (const char*)(WSP + WS_WIN) + (size_t)l * NPROJ * D * 2; S.nM = T / 256; S.nN = NPROJ / 256; S.G = F.G; S.c = F.blk; S.tstep = (size_t)256 * D * 2;
            S.A2 = nullptr; S.B2 = nullptr; S.a2stride = 0; S.b2stride = 0; S.n2 = 0;
            pg8::EpiProj E{(bf16*)(WSP + SC_PROJ), (bf16*)(WSP + MS_KVM), (size_t)MROWS * 1024, nullptr, 1.0f};
            if (EN(2)) pg8::gemm_phase<0>(F.lds, F.tid, D * 2, S, E);
#endif
        }
        STEP(sb + 2) { FRESH(); if (EN(3)) phase_prep(P, l); }
        STEP(sb + 3) { FRESH(); if (EN(4)) phase_c1(P, l); }
        STEP(sb + 4) { FRESH(); if (EN(5)) {
            const bool sh = P.G == 256, sc = (P.blk >> 3) < 8;
            if (!sh || !sc) phase_attn(P, l, sh);
            if (!sh) phase_scan(P, l); else if (sc) phase_scan8(P, l);
        } }
        STEP(sb + 5) { FRESH(); if (EN(6)) phase_post(P, l); }
        STEP(sb + 6) { FRESH(); Frame& F = P; KARGS(); const void* xin = l == 0 ? (const void*)IN(I_X) : (const void*)(WSP + WS_XB);
            bf16* xmid = l == 0 ? (bf16*)OUTP : (bf16*)(WSP + WS_XB) + (size_t)T * D;
            pg8::PlainSched S; S.A = (const char*)(WSP + WS_HB); S.B = (const char*)(WSP + WS_WOUT) + (size_t)l * D * D * 2; S.nM = T / 256; S.nN = D / 256; S.G = F.G; S.c = F.blk; S.tstep = (size_t)256 * D * 2;
            S.A2 = nullptr; S.B2 = nullptr; S.a2stride = 0; S.b2stride = 0; S.n2 = 0;
            pg8::EpiRes E{xin, l, xmid};
            if (EN(7)) pg8::gemm_phase<0>(F.lds, F.tid, D * 2, S, E);
        }
        STEP(sb + 7) { FRESH(); { Frame& F = P; KARGS(); if (EN(8)) phase_rmsnorm(F, l == 0 ? (const void*)OUTP : (const void*)((bf16*)(WSP + WS_XB) + (size_t)T * D), 1, IN(I_NFFG) + (size_t)l * D, (bf16*)(WSP + WS_HB), l == 0 ? 0 : 2, l, F.blk, F.G); } }
        if (l == 1) { STEP(sb + 8) { FRESH(); if (EN(9)) phase_route(P); } }
        STEP(sb + 9) { FRESH(); Frame& F = P;
            pg8::GroupSched S; S.G = F.G; S.c = F.blk; S.tstep = (size_t)256 * D;
            if (l == 0) { S.A = (const char*)(WSP + WS_HB); S.B = (const char*)(WSP + WS_WGU); S.tile_e = nullptr; S.nrt = T / 256; S.nN = 2 * DFF / 256; S.estride = 0; }
            else { S.A = (const char*)(WSP + SC_XS); S.B = (const char*)(WSP + WS_MGU); S.tile_e = (const int*)(WSP + MS_TILE) + 16; S.nrt = ((const int*)(WSP + MS_TILE))[0]; S.nN = 2 * DFFE / 256; S.estride = (size_t)2 * DFFE * D; }
            pg8::EpiSwiglu E{l == 0 ? (bf16*)(WSP + SC_ACT) : (bf16*)(WSP + SC_MACT), l == 0 ? DFF : DFFE, INV_SW_D, l, l == 0 ? (const float*)(WSP + MS_SA) : (const float*)(WSP + MS_SXS)};
            if (EN(10)) pg8::gemm_phase<2>(F.lds, F.tid, D, S, E);
        }
        STEP(sb + 10) { FRESH(); Frame& F = P;
            pg8::GroupSched S; S.G = F.G; S.c = F.blk; S.nN = D / 256;
            pg8::EpiDown E{(const bf16*)OUTP, (bf16*)(WSP + WS_XB), (bf16*)(WSP + SC_Y), (const float*)(WSP + MS_ROWG), l};
            if (l == 0) { S.A = (const char*)(WSP + SC_ACT); S.B = (const char*)(WSP + WS_WDN); S.tile_e = nullptr; S.nrt = T / 256; S.estride = 0; S.tstep = (size_t)256 * DFF * 2;
                if (EN(11)) pg8::gemm_phase<0>(F.lds, F.tid, DFF * 2, S, E); }
            else { S.A = (const char*)(WSP + SC_MACT); S.B = (const char*)(WSP + WS_MDN); S.tile_e = (const int*)(WSP + MS_TILE) + 16; S.nrt = ((const int*)(WSP + MS_TILE))[0]; S.estride = (size_t)D * DFFE; S.tstep = (size_t)256 * DFFE;
                if (EN(11)) pg8::gemm_phase<1>(F.lds, F.tid, DFFE, S, E); }
        }
        if (l == 1) { STEP(sb + 11) { FRESH(); if (EN(12)) phase_combine(P); } }
    }
#undef STEP
}

extern "C" void kernel_launch(void* const* d_in, const int* in_sizes, int n_in, void* d_out, int out_size, void* d_ws, size_t ws_size, hipStream_t stream) {
    static int grid = 0;
    if (grid == 0) {
        if (n_in != 25 || out_size != T * D || ws_size < WS_END) { fprintf(stderr, "kernel_launch: unexpected shapes (n_in %d, out %d, ws %zu < %zu)\n", n_in, out_size, ws_size, (size_t)WS_END); grid = -1; return; }
        int dev = 0, cus = 0, per_cu = 0;
        if (hipGetDevice(&dev) != hipSuccess || hipDeviceGetAttribute(&cus, hipDeviceAttributeMultiprocessorCount, dev) != hipSuccess) { grid = -1; return; }
        if (hipFuncSetAttribute((const void*)fwd, hipFuncAttributeMaxDynamicSharedMemorySize, LDS_BYTES) != hipSuccess) { fprintf(stderr, "kernel_launch: hipFuncSetAttribute failed\n"); grid = -1; return; }
        if (hipOccupancyMaxActiveBlocksPerMultiprocessor(&per_cu, (const void*)fwd, NTHREADS, LDS_BYTES) != hipSuccess || per_cu < 1) { fprintf(stderr, "kernel_launch: occupancy query says %d\n", per_cu); }
        (void)hipGetLastError();
        grid = cus;
        if (T % grid != 0) { fprintf(stderr, "kernel_launch: grid %d does not divide T\n", grid); grid = -1; return; }
    }
    if (grid < 0) return;
    (void)in_sizes;
    if (hipMemsetAsync((char*)d_ws + WS_CTL, 0, CTL_ZERO_BYTES, stream) != hipSuccess) return;
    Args a{};
    for (int i = 0; i < 25; ++i) a.in[i] = (const float*)d_in[i];
    a.out = (float*)d_out; a.ws = (unsigned char*)d_ws; a.pad0 = 3;
#if ONE_LAUNCH
    a.step_lo = 0; a.step_hi = N_STEPS;
    hipLaunchKernelGGL(fwd, dim3(grid), dim3(NTHREADS), LDS_BYTES, stream, a);
#ifdef PROBE_STEPS
    { const int ps[] = PROBE_STEPS; for (int s : ps) { a.step_lo = s; a.step_hi = s + 1; a.pad0 = PROBE_MASK; hipLaunchKernelGGL(fwd, dim3(grid), dim3(NTHREADS), LDS_BYTES, stream, a); } }
#endif
#else
    for (int s = 0; s < N_STEPS; ++s) {
        if (s >= 1 && s < 1 + STEPS_PER_LAYER && ((s - 1) == 8 || (s - 1) == 11)) continue;
        a.step_lo = s; a.step_hi = s + 1;
        hipLaunchKernelGGL(fwd, dim3(grid), dim3(NTHREADS), LDS_BYTES, stream, a);
    }
#endif
}
```

```cpp
#include <hip/hip_runtime.h>
#include <cstdio>
#include <cstdint>

#ifndef W_IN_I8
#define W_IN_I8 1
#endif
#ifndef PROBE_MASK
#define PROBE_MASK 3
#endif
#ifndef NAIVE_ATTN
#define NAIVE_ATTN 0
#endif
#ifndef NAIVE_RECUR
#define NAIVE_RECUR 0
#endif
#ifndef ONE_LAUNCH
#define ONE_LAUNCH 1
#endif

#define GAS __attribute__((address_space(1)))
#define LAS __attribute__((address_space(3)))
typedef unsigned short bf16;
typedef unsigned v4u __attribute__((ext_vector_type(4)));
typedef unsigned v2u __attribute__((ext_vector_type(2)));
typedef float f32x4 __attribute__((ext_vector_type(4)));
typedef short bf16x8 __attribute__((ext_vector_type(8)));
typedef int i32x4 __attribute__((ext_vector_type(4)));

constexpr int D = 2048, NB = 8, SEQ = 2048, T = NB * SEQ, NH = 4, HD = 128, GW = 512, DIN = 6152, NPROJ = 6144;
constexpr int CH = 64, NCHUNK = SEQ / CH, NMEM = 256, MROWS = NB * NMEM, NPREV = 8;
constexpr int DFF = 5632, NE = 8, DFFE = 7168, RELW = 257;
constexpr int XS_ROWS = 2 * T + NE * 256;
constexpr float EPS = 1e-6f;
constexpr int C_QA = 0, C_KA = 512, C_VA = 1024, C_ZA = 1536, C_QB = 2048, C_KB = 2560, C_VB = 3072, C_GB = 3584, C_QC = 4096, C_KC = 4608, C_VC = 5120, C_QM = 5632;

constexpr size_t MiB = 1u << 20;
constexpr size_t WS_CTL = 0, CTL_ZERO_BYTES = 64 * 1024;
constexpr size_t WS_WIN = 1 * MiB;
constexpr size_t WS_WMKV = WS_WIN + 48 * MiB;
constexpr size_t WS_WOUT = WS_WMKV + 8 * MiB;
constexpr size_t WS_WGU = WS_WOUT + 16 * MiB;
constexpr size_t WS_WDN = WS_WGU + 44 * MiB;
constexpr size_t WS_MGU = WS_WDN + 22 * MiB;
constexpr size_t WS_MDN = WS_MGU + 448 * MiB;
constexpr size_t WS_HB = WS_MDN + 224 * MiB;
constexpr size_t WS_XB = WS_HB + 64 * MiB;
constexpr size_t WS_MISC = WS_XB + 128 * MiB;
constexpr size_t WS_SCR = WS_MISC + 40 * MiB;
constexpr size_t WS_END = WS_SCR + 748 * MiB;
static_assert(WS_HB == 811 * MiB && WS_END == 1791 * MiB, "ws map");
constexpr size_t MS_MEMH = WS_MISC;
constexpr size_t MS_KVM = WS_MISC + 16 * MiB;
constexpr size_t MS_VMT = WS_MISC + 24 * MiB;
constexpr size_t MS_GATES = WS_MISC + 28 * MiB;
constexpr size_t MS_ROPE = WS_MISC + 29 * MiB;
constexpr size_t MS_TOPE = WS_MISC + 30 * MiB;
constexpr size_t MS_TOPG = MS_TOPE + 128 * 1024;
constexpr size_t MS_POS = MS_TOPG + 128 * 1024;
constexpr size_t MS_ROWG = MS_POS + 128 * 1024;
constexpr size_t MS_CNT = MS_ROWG + 256 * 1024;
constexpr size_t MS_TILE = MS_CNT + 64 * 1024;
constexpr size_t SC_PROJ = WS_SCR;
constexpr size_t SC_CONVA = WS_SCR + 192 * MiB;
constexpr size_t SC_VCT = WS_SCR + 240 * MiB;
constexpr size_t SC_OBUF = WS_SCR + 256 * MiB;
constexpr size_t SC_PRE = WS_SCR + 320 * MiB;
constexpr int REC_BYTES = 90112, REC_QF = 0, REC_KF = 16384, REC_AF = 32768, REC_WF = 40960, REC_U = 57344;
constexpr size_t MS_GTOT = WS_MISC + 32 * MiB;
constexpr size_t MS_SA = WS_MISC + 33 * MiB;
constexpr size_t MS_SXS = WS_MISC + 34 * MiB;
constexpr float SW_D = 127.0f * 45.254833995939045f / 6.0f, INV_SW_D = 1.0f / SW_D;
constexpr size_t SC_ACT = WS_SCR;
constexpr size_t SC_XS = WS_SCR;
constexpr size_t SC_MACT = WS_SCR + 136 * MiB;
constexpr size_t SC_Y = WS_SCR + 612 * MiB;
constexpr int CW_BAR = 4096;

constexpr int LDS_BYTES = 163840;
constexpr int LDS_CTL_OFF = 162816;
constexpr int NWAVES = 8, NTHREADS = 512;

__device__ __forceinline__ unsigned f2bf(float f) { unsigned u = __builtin_bit_cast(unsigned, f); return (u + 0x7fffu + ((u >> 16) & 1u)) >> 16; }
__device__ __forceinline__ unsigned pk2(float lo, float hi) { return f2bf(lo) | (f2bf(hi) << 16); }
__device__ __forceinline__ float bflo(unsigned w) { return __builtin_bit_cast(float, w << 16); }
__device__ __forceinline__ float bfhi(unsigned w) { return __builtin_bit_cast(float, w & 0xffff0000u); }
__device__ __forceinline__ float bf2f(bf16 b) { return __builtin_bit_cast(float, ((unsigned)b) << 16); }
__device__ __forceinline__ float wave_sum(float v) {
#pragma unroll
    for (int o = 1; o < 64; o <<= 1) v += __shfl_xor(v, o);
    return v;
}
__device__ __forceinline__ float wave_max(float v) {
#pragma unroll
    for (int o = 1; o < 64; o <<= 1) v = fmaxf(v, __shfl_xor(v, o));
    return v;
}
__device__ __forceinline__ float grp16_sum(float v) {
#pragma unroll
    for (int o = 1; o < 16; o <<= 1) v += __shfl_xor(v, o);
    return v;
}
__device__ __forceinline__ float silu_f(float x) { return x / (1.0f + __expf(-x)); }
__device__ __forceinline__ void unpack8(const v4u w, float (&f)[8]) {
    f[0] = bflo(w.x); f[1] = bfhi(w.x); f[2] = bflo(w.y); f[3] = bfhi(w.y); f[4] = bflo(w.z); f[5] = bfhi(w.z); f[6] = bflo(w.w); f[7] = bfhi(w.w);
}
__device__ __forceinline__ v4u pack8(const float (&f)[8]) { v4u w; w.x = pk2(f[0], f[1]); w.y = pk2(f[2], f[3]); w.z = pk2(f[4], f[5]); w.w = pk2(f[6], f[7]); return w; }

#define XB_TMO      128
#define XB_XCNT(j)  (256  + 64 * (j))
#define XB_XSUB(j)  (1280 + 64 * (j))
#define XB_XGEN(j)  (2304 + 64 * (j))
#define XB_TOP      3328
#define XB_TOPGEN   3392
#define XCD_BAR_WORDS 3456
#define XB_SPIN_CAP (1u << 18)
__device__ __forceinline__ unsigned xb_ld(unsigned* p)              { return __hip_atomic_load(p, __ATOMIC_RELAXED, __HIP_MEMORY_SCOPE_AGENT); }
__device__ __forceinline__ unsigned xb_add(unsigned* p, unsigned v) { return __hip_atomic_fetch_add(p, v, __ATOMIC_RELAXED, __HIP_MEMORY_SCOPE_AGENT); }
__device__ __forceinline__ unsigned xb_xcc_id() { return (unsigned)__builtin_amdgcn_s_getreg((3 << 11) | 20) & 0xFu; }
#define XB_SPIN(cond, bar) do { unsigned _sp = 0; while (cond) { __builtin_amdgcn_s_sleep(1); \
    if ((++_sp & 255u) == 0u) { if (xb_ld(&(bar)[XB_TMO])) break; if (_sp > XB_SPIN_CAP) { atomicAdd(&(bar)[XB_TMO], 1u); break; } } } } while (0)
struct XcdBarrier { unsigned* bar; unsigned x; volatile LAS unsigned* st; };
__device__ __forceinline__ XcdBarrier xcd_barrier_post(unsigned* bar, volatile LAS unsigned* st) {
    XcdBarrier b; b.bar = bar; b.x = xb_xcc_id(); b.st = st;
    if (threadIdx.x == 0) (void)xb_add(&bar[XB_XCNT(b.x)], 1u);
    return b;
}
__device__ __forceinline__ void xcd_barrier_complete(unsigned* bar, unsigned x, unsigned& nloc, unsigned& nx) {
    const unsigned G = gridDim.x * gridDim.y * gridDim.z;
    unsigned sum, cnt, mine, sp = 0u;
    for (;;) {
        sum = 0u; cnt = 0u; mine = 0u;
#pragma unroll
        for (unsigned j = 0; j < 16; ++j) { const unsigned c = xb_ld(&bar[XB_XCNT(j)]); sum += c; cnt += (c > 0u) ? 1u : 0u; mine = (j == x) ? c : mine; }
        if (sum == G) break;
        __builtin_amdgcn_s_sleep(1);
        if ((++sp & 255u) == 0u) { if (xb_ld(&bar[XB_TMO])) break; if (sp > XB_SPIN_CAP) { atomicAdd(&bar[XB_TMO], 1u); break; } }
    }
    nloc = mine > 0u ? mine : 1u; nx = cnt > 0u ? cnt : 1u;
}
__device__ __forceinline__ void xcd_barrier(const XcdBarrier& b) {
    asm volatile("s_waitcnt vmcnt(0)" ::: "memory");
    __syncthreads();
    if (threadIdx.x == 0) {
        unsigned* bar = b.bar;
        __builtin_amdgcn_s_waitcnt(0);
        unsigned nloc = b.st[0], nx = b.st[1];
        if (nloc == 0u) { xcd_barrier_complete(bar, b.x, nloc, nx); b.st[0] = nloc; b.st[1] = nx; }
        const unsigned old = xb_add(&bar[XB_XSUB(b.x)], 1u);
        const unsigned gen = old / nloc;
        if (old + 1u == (gen + 1u) * nloc) {
            __builtin_amdgcn_fence(__ATOMIC_RELEASE, "agent");
            asm volatile("s_waitcnt vmcnt(0)" ::: "memory");
            const unsigned og = xb_add(&bar[XB_TOP], 1u);
            const unsigned tg = og / nx;
            if (og + 1u == (tg + 1u) * nx) xb_add(&bar[XB_TOPGEN], 1u);
            else XB_SPIN(xb_ld(&bar[XB_TOPGEN]) == tg, bar);
            __builtin_amdgcn_fence(__ATOMIC_ACQUIRE, "agent");
            xb_add(&bar[XB_XGEN(b.x)], 1u);
            asm volatile("s_waitcnt vmcnt(0)" ::: "memory");
        } else {
            XB_SPIN(xb_ld(&bar[XB_XGEN(b.x)]) == gen, bar);
            __builtin_amdgcn_fence(__ATOMIC_ACQUIRE, "agent");
            asm volatile("s_waitcnt vmcnt(0)" ::: "memory");
        }
    }
    __syncthreads();
}

namespace pg8 {
constexpr int BM = 256, BK = 64, HALF = 128, HTB = HALF * BK * 2, STAGE_BYTES = 8 * HTB, NXCD = 8, WGM = 8;
__host__ __device__ __forceinline__ int lds_byte(int r, int c) { const int st = (r >> 4) * 2 + (c >> 5), rr = r & 15, cc = c & 31, ob = rr * 64 + cc * 2; return st * 1024 + (ob ^ (((ob >> 9) & 1) << 5)); }
__host__ __device__ __forceinline__ void stage_rc(int b, int& R, int& C) { const int st = b / 1024, sb = b % 1024, swz = sb ^ (((sb >> 9) & 1) << 5); R = (st >> 1) * 16 + swz / 64; C = (st & 1) * 32 + (swz % 64) / 2; }
__host__ __device__ __forceinline__ int perm32(int rho) { const int n = rho >> 4, i = rho & 15; return 8 * (i >> 2) + 4 * n + (i & 3); }
__device__ __forceinline__ size_t img_off(int row, int kb, int RB) {
    return (size_t)(row >> 8) * ((size_t)256 * RB) + (size_t)(kb >> 7) * 32768 + (size_t)(((row >> 7) & 1) * 16384 + lds_byte(row & 127, (kb & 127) >> 1));
}
__device__ __forceinline__ int wslot(int n) { const int w = n & 31; return (n & ~31) + 16 * ((w >> 2) & 1) + 4 * (w >> 3) + (w & 3); }

__device__ __forceinline__ f32x4 tof(const f32x4 v) { return v; }
__device__ __forceinline__ f32x4 tof(const i32x4 v) { return __builtin_convertvector(v, f32x4); }
__device__ __forceinline__ unsigned cvt_pk_bf16(float lo, float hi) { unsigned r; asm volatile("v_cvt_pk_bf16_f32 %0, %1, %2" : "=v"(r) : "v"(lo), "v"(hi)); return r; }

struct GUnit { const char* A; const char* B; int pm, pn, aux; };
__device__ __forceinline__ void static_map(int L, int nM, int nN, int& pm, int& pn) {
    const int nwg = nM * nN; int wgid = L;
    { const int q = nwg / NXCD, r = nwg % NXCD, xcd = wgid % NXCD, off = wgid / NXCD; wgid = (xcd < r ? xcd * (q + 1) : r * (q + 1) + (xcd - r) * q) + off; }
    const int nig = WGM * nN, gid = wgid / nig, fm = gid * WGM, gsz = (nM - fm) < WGM ? (nM - fm) : WGM;
    pm = fm + ((wgid % nig) % gsz); pn = (wgid % nig) / gsz;
}

typedef int v8i __attribute__((ext_vector_type(8)));
__device__ __forceinline__ v8i cat8(const bf16x8 a, const bf16x8 b) { const v4u x = __builtin_bit_cast(v4u, a), y = __builtin_bit_cast(v4u, b); return (v8i){(int)x.x, (int)x.y, (int)x.z, (int)x.w, (int)y.x, (int)y.y, (int)y.z, (int)y.w}; }
template <int M_> struct AccSel { typedef f32x4 type; };
template <> struct AccSel<2> { typedef i32x4 type; };
template <int MODE, class Epi, class Sched>
__device__ __forceinline__ void gemm_phase(LAS unsigned char* lds, const int tid, const int RB, const Sched& S, const Epi& E) {
    constexpr bool FP8 = MODE == 1; typedef typename AccSel<MODE>::type AccT;
    const int wid = __builtin_amdgcn_readfirstlane(tid >> 6), lane = tid & 63, wr = wid >> 2, wc = wid & 3, fr = lane & 15, fq = lane >> 4;
    const int nt = RB / 128;
    unsigned voffA[2], voffB[2];
#pragma unroll
    for (int i = 0; i < 2; ++i) { voffA[i] = (unsigned)(tid * 16 + i * 8192); voffB[i] = voffA[i]; }
    const size_t kstep = (size_t)32768;
    const size_t hstep = (size_t)16384;
    const unsigned ldsw = (unsigned)wid * 1024u;
    const int aoff = lds_byte(wr * 64 + fr, fq * 8), boff = lds_byte(wc * 32 + fr, fq * 8);
#define PG8_SA(b, h) (((b) * 2 + (h)) * HTB)
#define PG8_SB(b, h) ((4 + (b) * 2 + (h)) * HTB)
#define PG8_STAGE(bufoff, gbase, voff) do { _Pragma("unroll") for (int _i = 0; _i < 2; ++_i) \
        __builtin_amdgcn_global_load_lds((const unsigned*)((const char*)(gbase) + (voff)[_i]), (LAS unsigned*)(lds + (bufoff) + ldsw + _i * 8192), 16, 0, 0); } while (0)
#define PG8_LD8(p) ({ const v4u lo_ = *(const LAS v4u*)(p), hi_ = *(const LAS v4u*)((p) + 1024); (v8i){(int)lo_.x, (int)lo_.y, (int)lo_.z, (int)lo_.w, (int)hi_.x, (int)hi_.y, (int)hi_.z, (int)hi_.w}; })
#define PG8_LDA(dst, b, h) do { _Pragma("unroll") for (int m = 0; m < 4; ++m) { if constexpr (FP8) dst##8[m] = PG8_LD8(lds + PG8_SA(b, h) + aoff + m * 2048); else { _Pragma("unroll") for (int k = 0; k < 2; ++k) dst[m][k] = *(const LAS bf16x8*)(lds + PG8_SA(b, h) + aoff + m * 2048 + k * 1024); } } } while (0)
#define PG8_LDB(dst, b, h) do { _Pragma("unroll") for (int n = 0; n < 2; ++n) { if constexpr (FP8) dst##8[n] = PG8_LD8(lds + PG8_SB(b, h) + boff + n * 2048); else { _Pragma("unroll") for (int k = 0; k < 2; ++k) dst[n][k] = *(const LAS bf16x8*)(lds + PG8_SB(b, h) + boff + n * 2048 + k * 1024); } } } while (0)
#define PG8_MMA(ai, bj, At, Bt) do { __builtin_amdgcn_s_setprio(1); _Pragma("unroll") for (int m = 0; m < 4; ++m) _Pragma("unroll") for (int n = 0; n < 2; ++n) { \
        if constexpr (FP8) asm volatile("v_mfma_scale_f32_16x16x128_f8f6f4 %0, %1, %2, %0, %3, %3 op_sel_hi:[0,0,0]" : "+v"(acc[ai][bj][m][n]) : "v"(Bt##8[n]), "v"(At##8[m]), "v"(scl1));   \
        else if constexpr (MODE == 2) { _Pragma("unroll") for (int k = 0; k < 2; ++k) acc[ai][bj][m][n] = __builtin_amdgcn_mfma_i32_16x16x64_i8(__builtin_bit_cast(i32x4, Bt[n][k]), __builtin_bit_cast(i32x4, At[m][k]), acc[ai][bj][m][n], 0, 0, 0); } \
        else { _Pragma("unroll") for (int k = 0; k < 2; ++k) acc[ai][bj][m][n] = __builtin_amdgcn_mfma_f32_16x16x32_bf16(Bt[n][k], At[m][k], acc[ai][bj][m][n], 0, 0, 0); } } __builtin_amdgcn_s_setprio(0); } while (0)
#define PG8_WAIT_V(n) asm volatile("s_waitcnt vmcnt(" #n ")" ::: "memory")
#define PG8_WAIT_L(n) asm volatile("s_waitcnt lgkmcnt(" #n ")" ::: "memory")
#define PG8_BAR __builtin_amdgcn_s_barrier()
#define PG8_SCHED __builtin_amdgcn_sched_barrier(0)
    GUnit cur, nxt; int ui = 0;
    if (!S.next(0, cur)) return;
    AccT acc[2][2][4][2];
#pragma unroll
    for (int a = 0; a < 2; ++a)
#pragma unroll
        for (int b = 0; b < 2; ++b)
#pragma unroll
            for (int m = 0; m < 4; ++m)
#pragma unroll
                for (int n = 0; n < 2; ++n) acc[a][b][m][n] = (AccT){0, 0, 0, 0};
    bf16x8 At[4][2], B0[2][2], B1[2][2]; v8i At8[4], B08[2], B18[2];
    const unsigned scl1 = 0x7f7f7f7fu;
    const char* cA = cur.A; const char* cB = cur.B;
    PG8_STAGE(PG8_SB(0, 0), cB, voffB); PG8_STAGE(PG8_SB(0, 1), cB + hstep, voffB); PG8_STAGE(PG8_SA(0, 0), cA, voffA); PG8_STAGE(PG8_SA(0, 1), cA + hstep, voffA);
    if (wr == 1) PG8_BAR;
    PG8_WAIT_V(2); PG8_BAR;
    PG8_STAGE(PG8_SB(1, 0), cB + kstep, voffB); PG8_STAGE(PG8_SA(1, 0), cA + kstep, voffA); PG8_STAGE(PG8_SB(1, 1), cB + hstep + kstep, voffB);
    PG8_WAIT_V(6); PG8_BAR;
    for (;;) {
        const bool has_next = S.next(ui + 1, nxt);
        const char* nA = has_next ? nxt.A : cA; const char* nB = has_next ? nxt.B : cB;
        for (int t = 0; t < nt; t += 2) {
            const bool last = (t == nt - 2);
            const char* a1 = cA + (size_t)(t + 1) * kstep;
            const char* a2 = last ? nA : cA + (size_t)(t + 2) * kstep; const char* b2 = last ? nB : cB + (size_t)(t + 2) * kstep;
            const char* a3 = a2 + kstep; const char* b3 = b2 + kstep;
            PG8_LDB(B0, 0, 0); PG8_LDB(B1, 0, 1); PG8_SCHED; PG8_LDA(At, 0, 0); PG8_STAGE(PG8_SA(1, 1), a1 + hstep, voffA);
            PG8_WAIT_V(8); PG8_WAIT_L(0); PG8_BAR; PG8_MMA(0, 0, At, B0); PG8_MMA(0, 1, At, B1); PG8_BAR; PG8_SCHED;
            PG8_LDA(At, 0, 1); PG8_STAGE(PG8_SB(0, 0), b2, voffB); PG8_STAGE(PG8_SB(0, 1), b2 + hstep, voffB); PG8_STAGE(PG8_SA(0, 0), a2, voffA);
            PG8_WAIT_V(8); PG8_WAIT_L(0); PG8_BAR; PG8_MMA(1, 0, At, B0); PG8_MMA(1, 1, At, B1); PG8_BAR; PG8_SCHED;
            PG8_LDB(B0, 1, 0); PG8_LDB(B1, 1, 1); PG8_SCHED; PG8_LDA(At, 1, 0); PG8_STAGE(PG8_SA(0, 1), a2 + hstep, voffA);
            PG8_WAIT_V(8); PG8_WAIT_L(0); PG8_BAR; PG8_MMA(0, 0, At, B0); PG8_MMA(0, 1, At, B1); PG8_BAR; PG8_SCHED;
            PG8_LDA(At, 1, 1); PG8_STAGE(PG8_SB(1, 0), b3, voffB); PG8_STAGE(PG8_SB(1, 1), b3 + hstep, voffB); PG8_STAGE(PG8_SA(1, 0), a3, voffA);
            PG8_WAIT_V(8); PG8_WAIT_L(0); PG8_BAR; PG8_MMA(1, 0, At, B0); PG8_MMA(1, 1, At, B1); PG8_BAR; PG8_SCHED;
        }
        if constexpr (FP8) asm volatile("s_nop 15\n\ts_nop 15" ::: "memory");
        if (wr == 0) PG8_BAR;
        E(acc, cur, wr, wc, fr, fq);
        if (!has_next) break;
#pragma unroll
        for (int a = 0; a < 2; ++a)
#pragma unroll
            for (int b = 0; b < 2; ++b)
#pragma unroll
                for (int m = 0; m < 4; ++m)
#pragma unroll
                    for (int n = 0; n < 2; ++n) acc[a][b][m][n] = (AccT){0, 0, 0, 0};
        cur = nxt; cA = nA; cB = nB; ++ui;
        if (wr == 1) PG8_BAR;
    }
    PG8_WAIT_V(0);
    PG8_BAR;
#undef PG8_SA
#undef PG8_SB
#undef PG8_STAGE
#undef PG8_LDA
#undef PG8_LDB
#undef PG8_MMA
#undef PG8_WAIT_V
#undef PG8_WAIT_L
#undef PG8_BAR
#undef PG8_SCHED
}

struct PlainSched {
    const char* A; const char* B; int nM, nN, G, c; size_t tstep;
    const char* A2; const char* B2; size_t a2stride, b2stride; int n2;
    __device__ __forceinline__ bool next(int i, GUnit& u) const {
        const int L = i * G + c, n1 = nM * nN;
        if (L < n1) { static_map(L, nM, nN, u.pm, u.pn); u.A = A + (size_t)u.pm * tstep; u.B = B + (size_t)u.pn * tstep; u.aux = 0; return true; }
        const int L2 = L - n1; if (L2 >= n2 * 32) return false;
        const int j = L2 >> 5, r = L2 & 31; u.pm = r & 7; u.pn = r >> 3; u.aux = 1 + j;
        u.A = A2 + (size_t)j * a2stride + (size_t)u.pm * tstep; u.B = B2 + (size_t)j * b2stride + (size_t)u.pn * tstep; return true;
    }
};
struct GroupSched {
    const char* A; const char* B; const int* tile_e; int nrt, nN, G, c; size_t tstep, estride;
    __device__ __forceinline__ bool next(int i, GUnit& u) const {
        const int L = i * G + c; if (L >= nrt * nN) return false;
        static_map(L, nrt, nN, u.pm, u.pn);
        const int e = tile_e ? tile_e[u.pm] : 0; u.aux = e;
        u.A = A + (size_t)u.pm * tstep; u.B = B + (size_t)e * estride + (size_t)u.pn * tstep; return true;
    }
};

struct EpiProj {
    bf16* proj; bf16* kvm0; size_t kvm_stride; const float* rowscale; float cscale;
    template <class AccT> __device__ __forceinline__ void operator()(const AccT (&acc)[2][2][4][2], const GUnit& u, int wr, int wc, int fr, int fq) const {
        bf16* base = u.aux == 0 ? proj : kvm0 + (size_t)(u.aux - 1) * kvm_stride; const int ldc = u.aux == 0 ? NPROJ : 1024;
        const int row0 = u.pm * BM + wr * 64 + fr, col0 = u.pn * BM + wc * 32 + 8 * fq;
        float rs[2][4];
#pragma unroll
        for (int ai = 0; ai < 2; ++ai)
#pragma unroll
            for (int m = 0; m < 4; ++m) rs[ai][m] = rowscale ? rowscale[row0 + ai * HALF + m * 16] * cscale : 1.0f;
        __builtin_amdgcn_sched_barrier(0);
#pragma unroll
        for (int ai = 0; ai < 2; ++ai)
#pragma unroll
            for (int m = 0; m < 4; ++m) { const int row = row0 + ai * HALF + m * 16; bf16* rowp = base + (size_t)row * ldc + col0;
#pragma unroll
                for (int bj = 0; bj < 2; ++bj) { const f32x4 v0 = tof(acc[ai][bj][m][0]) * rs[ai][m], v1 = tof(acc[ai][bj][m][1]) * rs[ai][m];
                    v4u w; w.x = cvt_pk_bf16(v0[0], v0[1]); w.y = cvt_pk_bf16(v0[2], v0[3]); w.z = cvt_pk_bf16(v1[0], v1[1]); w.w = cvt_pk_bf16(v1[2], v1[3]);
                    *(v4u*)(rowp + bj * HALF) = w; } }
    }
};
struct EpiRes {
    const void* res; int res_bf16; bf16* out; const float* rowscale; float cscale;
    template <class AccT> __device__ __forceinline__ void operator()(const AccT (&acc)[2][2][4][2], const GUnit& u, int wr, int wc, int fr, int fq) const {
        const int row0 = u.pm * BM + wr * 64 + fr, col0 = u.pn * BM + wc * 32 + 8 * fq;
#pragma unroll
        for (int ai = 0; ai < 2; ++ai) {
            f32x4 rr[4][2][2]; float rs[4];
#pragma unroll
            for (int m = 0; m < 4; ++m) { const size_t off = (size_t)(row0 + ai * HALF + m * 16) * D + col0; rs[m] = rowscale ? rowscale[row0 + ai * HALF + m * 16] * cscale : 1.0f;
#pragma unroll
                for (int bj = 0; bj < 2; ++bj) { if (res_bf16) { rr[m][bj][0] = __builtin_bit_cast(f32x4, *(const v4u*)((const bf16*)res + off + bj * HALF)); rr[m][bj][1] = rr[m][bj][0]; }
                    else { rr[m][bj][0] = *(const f32x4*)((const float*)res + off + bj * HALF); rr[m][bj][1] = *(const f32x4*)((const float*)res + off + bj * HALF + 4); } } }
            __builtin_amdgcn_sched_barrier(0);
#pragma unroll
            for (int m = 0; m < 4; ++m) { const size_t off = (size_t)(row0 + ai * HALF + m * 16) * D + col0;
#pragma unroll
                for (int bj = 0; bj < 2; ++bj) { f32x4 a0, a1;
                    if (res_bf16) { const v4u w = __builtin_bit_cast(v4u, rr[m][bj][0]); a0 = (f32x4){bflo(w.x), bfhi(w.x), bflo(w.y), bfhi(w.y)}; a1 = (f32x4){bflo(w.z), bfhi(w.z), bflo(w.w), bfhi(w.w)}; } else { a0 = rr[m][bj][0]; a1 = rr[m][bj][1]; }
                    const f32x4 v0 = a0 + tof(acc[ai][bj][m][0]) * rs[m], v1 = a1 + tof(acc[ai][bj][m][1]) * rs[m];
                    v4u w; w.x = cvt_pk_bf16(v0[0], v0[1]); w.y = cvt_pk_bf16(v0[2], v0[3]); w.z = cvt_pk_bf16(v1[0], v1[1]); w.w = cvt_pk_bf16(v1[2], v1[3]);
                    *(v4u*)(out + off + bj * HALF) = w; } }
            __builtin_amdgcn_sched_barrier(0);
        }
    }
};
struct EpiSwiglu {
    bf16* act; int ldc; float inscale; int fp8out; const float* rowscale;
    template <class AccT> __device__ __forceinline__ void operator()(const AccT (&acc)[2][2][4][2], const GUnit& u, int wr, int wc, int fr, int fq) const {
        const int row0 = u.pm * BM + wr * 64 + fr, col0 = u.pn * HALF + wc * 32 + 8 * fq;
        float rsv[2][4];
#pragma unroll
        for (int ai = 0; ai < 2; ++ai)
#pragma unroll
            for (int m = 0; m < 4; ++m) rsv[ai][m] = rowscale ? rowscale[row0 + ai * HALF + m * 16] * inscale : inscale;
        __builtin_amdgcn_sched_barrier(0);
#pragma unroll
        for (int ai = 0; ai < 2; ++ai)
#pragma unroll
            for (int m = 0; m < 4; ++m) { float o[8]; const float rs = rsv[ai][m];
                const float c1 = rs * -1.4426950408889634f, rs2 = rs * rs * (fp8out ? 8.0f : 1.0f);
#pragma unroll
                for (int n = 0; n < 2; ++n)
#pragma unroll
                    for (int j = 0; j < 4; ++j) { const float a = (float)acc[ai][0][m][n][j], b = (float)acc[ai][1][m][n][j];
                        o[4 * n + j] = (a * b) * (__builtin_amdgcn_rcpf(1.0f + __builtin_amdgcn_exp2f(a * c1)) * rs2); }
                if (fp8out) {
#pragma unroll
                    for (int j = 0; j < 8; ++j) o[j] = __builtin_amdgcn_fmed3f(o[j], -448.0f, 448.0f);
                    unsigned w0 = 0, w1 = 0; w0 = __builtin_amdgcn_cvt_pk_fp8_f32(o[0], o[1], w0, false); w0 = __builtin_amdgcn_cvt_pk_fp8_f32(o[2], o[3], w0, true);
                    w1 = __builtin_amdgcn_cvt_pk_fp8_f32(o[4], o[5], w1, false); w1 = __builtin_amdgcn_cvt_pk_fp8_f32(o[6], o[7], w1, true);
                    *(v2u*)((unsigned char*)act + img_off(row0 + ai * HALF + m * 16, col0, ldc)) = (v2u){w0, w1};
                } else {
                v4u w; w.x = cvt_pk_bf16(o[0], o[1]); w.y = cvt_pk_bf16(o[2], o[3]); w.z = cvt_pk_bf16(o[4], o[5]); w.w = cvt_pk_bf16(o[6], o[7]);
                *(v4u*)((unsigned char*)act + img_off(row0 + ai * HALF + m * 16, col0 * 2, ldc * 2)) = w; } }
    }
};
struct EpiDown {
    const bf16* res; bf16* out; bf16* Y; const float* rowgate; int moe;
    template <class AccT> __device__ __forceinline__ void operator()(const AccT (&acc)[2][2][4][2], const GUnit& u, int wr, int wc, int fr, int fq) const {
        const int row0 = u.pm * BM + wr * 64 + fr, col0 = u.pn * BM + wc * 32 + 8 * fq;
        if (!moe) {
#pragma unroll
            for (int ai = 0; ai < 2; ++ai) {
                v4u rw[4][2];
#pragma unroll
                for (int m = 0; m < 4; ++m)
#pragma unroll
                    for (int bj = 0; bj < 2; ++bj) rw[m][bj] = *(const v4u*)(res + (size_t)(row0 + ai * HALF + m * 16) * D + col0 + bj * HALF);
                __builtin_amdgcn_sched_barrier(0);
#pragma unroll
                for (int m = 0; m < 4; ++m) { const size_t off = (size_t)(row0 + ai * HALF + m * 16) * D + col0;
#pragma unroll
                    for (int bj = 0; bj < 2; ++bj) { const v4u w0 = rw[m][bj];
                        const f32x4 v0 = (f32x4){bflo(w0.x), bfhi(w0.x), bflo(w0.y), bfhi(w0.y)} + tof(acc[ai][bj][m][0]), v1 = (f32x4){bflo(w0.z), bfhi(w0.z), bflo(w0.w), bfhi(w0.w)} + tof(acc[ai][bj][m][1]);
                        v4u w; w.x = cvt_pk_bf16(v0[0], v0[1]); w.y = cvt_pk_bf16(v0[2], v0[3]); w.z = cvt_pk_bf16(v1[0], v1[1]); w.w = cvt_pk_bf16(v1[2], v1[3]);
                        *(v4u*)(out + off + bj * HALF) = w; } }
                __builtin_amdgcn_sched_barrier(0);
            }
        } else {
            float gv[2][4];
#pragma unroll
            for (int ai = 0; ai < 2; ++ai)
#pragma unroll
                for (int m = 0; m < 4; ++m) gv[ai][m] = rowgate[row0 + ai * HALF + m * 16] * (1.0f / 512.0f);
            __builtin_amdgcn_sched_barrier(0);
#pragma unroll
            for (int ai = 0; ai < 2; ++ai)
#pragma unroll
                for (int m = 0; m < 4; ++m) { const int row = row0 + ai * HALF + m * 16; const float g = gv[ai][m]; bf16* rowp = Y + (size_t)row * D + col0;
#pragma unroll
                    for (int bj = 0; bj < 2; ++bj) { const f32x4 v0 = tof(acc[ai][bj][m][0]) * g, v1 = tof(acc[ai][bj][m][1]) * g;
                        v4u w; w.x = cvt_pk_bf16(v0[0], v0[1]); w.y = cvt_pk_bf16(v0[2], v0[3]); w.z = cvt_pk_bf16(v1[0], v1[1]); w.w = cvt_pk_bf16(v1[2], v1[3]);
                        *(v4u*)(rowp + bj * HALF) = w; } }
        }
    }
};
}

using pg8::img_off; using pg8::wslot;
struct Args { const float* in[25]; float* out; unsigned char* ws; int step_lo, step_hi; int pad0, pad1; };
struct Frame {
    LAS unsigned char* lds; int tid, lane, wave, G, blk;
    const __attribute__((address_space(4))) Args* ap; GAS float* out; GAS unsigned char* ws;
};
#define KARGS() const __attribute__((address_space(4))) Args* ap_ = F.ap; asm volatile("" : "+s"(ap_))
#define IN(i) (ap_->in[i])
#define WSP ((unsigned char*)F.ws)
#define OUTP ((float*)F.out)
enum { I_X = 0, I_MEM, I_NMIXG, I_NMEMG, I_WIN, I_CONVW, I_ALOG, I_DTB, I_DNG, I_RNG, I_AQG, I_AKG, I_RELB, I_MQG, I_MKG, I_WMKV, I_WOUT, I_NFFG, I_FWG, I_FWU, I_FWD, I_RW, I_MWG, I_MWU, I_MWD };

__device__ __forceinline__ void p0_item(const float* W, int ldw, int K, int nblk, bf16* WT, int row_off, int mode, LAS float* scr, int item, int lane) {
    const int kb = item / nblk, nb = item % nblk, k0 = 64 * kb, n0 = 32 * nb;
    const int drow0 = mode == 0 ? row_off + n0 : ((n0 >> 7) * 256 + (mode - 1) * 128 + (n0 & 127));
    float tv[32];
#pragma unroll
    for (int i = 0; i < 32; ++i) { const int kk = 2 * i + (lane >> 5); tv[i] = __builtin_nontemporal_load(W + (size_t)(k0 + kk) * ldw + n0 + (lane & 31));   }
#pragma unroll
    for (int i = 0; i < 32; ++i) { const int kk = 2 * i + (lane >> 5); scr[kk * 33 + (lane & 31)] = tv[i]; }
    asm volatile("s_waitcnt lgkmcnt(0)" ::: "memory");
    const int c = lane & 7;
#pragma unroll
    for (int j = 0; j < 4; ++j) { const int n = (lane >> 3) + 8 * j; const LAS float* s = scr + (8 * c) * 33 + n;
        v4u o; o.x = pk2(s[0 * 33], s[1 * 33]); o.y = pk2(s[2 * 33], s[3 * 33]); o.z = pk2(s[4 * 33], s[5 * 33]); o.w = pk2(s[6 * 33], s[7 * 33]);
        *(v4u*)((unsigned char*)WT + img_off(wslot(drow0 + n), (k0 + 8 * c) * 2, K * 2)) = o; }
    asm volatile("s_waitcnt lgkmcnt(0)" ::: "memory");
}
__device__ __forceinline__ unsigned pk4_fp8(float a, float b, float c, float d) { unsigned w = 0; w = __builtin_amdgcn_cvt_pk_fp8_f32(a, b, w, false); w = __builtin_amdgcn_cvt_pk_fp8_f32(c, d, w, true); return w; }
__device__ __forceinline__ unsigned pk4_i8(float a, float b, float c, float d) {
    const int x = (int)rintf(fminf(fmaxf(a, -127.f), 127.f)), y = (int)rintf(fminf(fmaxf(b, -127.f), 127.f)), z = (int)rintf(fminf(fmaxf(c, -127.f), 127.f)), w = (int)rintf(fminf(fmaxf(d, -127.f), 127.f));
    return (unsigned)(x & 255) | ((unsigned)(y & 255) << 8) | ((unsigned)(z & 255) << 16) | ((unsigned)w << 24); }
__device__ __forceinline__ void p0_item8(const float* W, int ldw, int K, int nblk, unsigned char* WT, int row_off, int mode, int fmt, LAS float* scr, int item, int lane) {
    const int kb = item / nblk, nb = item % nblk, k0 = 64 * kb, n0 = 32 * nb;
    const int drow0 = mode == 0 ? row_off + n0 : ((n0 >> 7) * 256 + (mode - 1) * 128 + (n0 & 127));
    const float wsc = fmt == 1 ? 64.0f : SW_D;
    float tv[32];
#pragma unroll
    for (int i = 0; i < 32; ++i) { const int kk = 2 * i + (lane >> 5); tv[i] = __builtin_nontemporal_load(W + (size_t)(k0 + kk) * ldw + n0 + (lane & 31));   }
#pragma unroll
    for (int i = 0; i < 32; ++i) { const int kk = 2 * i + (lane >> 5); scr[kk * 33 + (lane & 31)] = tv[i] * wsc; }
    asm volatile("s_waitcnt lgkmcnt(0)" ::: "memory");
    const int c = lane & 7;
#pragma unroll
    for (int j = 0; j < 4; ++j) { const int n = (lane >> 3) + 8 * j; const LAS float* s = scr + (8 * c) * 33 + n;
        v2u o; if (fmt == 1) { o.x = pk4_fp8(s[0 * 33], s[1 * 33], s[2 * 33], s[3 * 33]); o.y = pk4_fp8(s[4 * 33], s[5 * 33], s[6 * 33], s[7 * 33]); }
        else { o.x = pk4_i8(s[0 * 33], s[1 * 33], s[2 * 33], s[3 * 33]); o.y = pk4_i8(s[4 * 33], s[5 * 33], s[6 * 33], s[7 * 33]); }
        *(v2u*)(WT + img_off(wslot(drow0 + n), k0 + 8 * c, K)) = o; }
    asm volatile("s_waitcnt lgkmcnt(0)" ::: "memory");
}
__device__ __forceinline__ void phase_p0(Frame& F) {
    KARGS();
    LAS float* scr = (LAS float*)(F.lds + F.wave * 16384);
    const int gw = F.blk * NWAVES + F.wave, NGW = F.G * NWAVES;
    constexpr int I_MOE1 = 32 * 224, I_MOE = 3 * I_MOE1;
    constexpr int N_MOE = NE * I_MOE;
    constexpr int I_L = 2048 + 4096 + 1024 + 2048;
    constexpr int I_FF = 32 * 176;
    constexpr int NITEMS = N_MOE + 2 * I_L + 3 * I_FF;
    for (int it = gw; it < NITEMS; it += NGW) {
        int r = it;
        if (r < N_MOE) { const int e = r / I_MOE, q = r % I_MOE, which = q / I_MOE1, idx = q % I_MOE1;
            if (which < 2) p0_item8((which == 0 ? IN(I_MWG) : IN(I_MWU)) + (size_t)e * D * DFFE, DFFE, D, DFFE / 32, WSP + WS_MGU + (size_t)e * 2 * DFFE * D, 0, 1 + which, 2, scr, idx, F.lane);
            else p0_item8(IN(I_MWD) + (size_t)e * DFFE * D, D, DFFE, D / 32, WSP + WS_MDN + (size_t)e * D * DFFE, 0, 0, 1, scr, idx, F.lane);
            continue; }
        r -= N_MOE;
        if (r < 2 * I_L) { const int l = r / I_L; int q = r % I_L;
            const float* win = IN(I_WIN) + (size_t)l * D * DIN; unsigned char* wint = WSP + WS_WIN + (size_t)l * NPROJ * D;
#if W_IN_I8
            if (q < 2048) { p0_item8(win, DIN, D, 64, wint, 0, 0, 2, scr, q, F.lane); continue; } q -= 2048;
            if (q < 4096) { p0_item8(win + 2056, DIN, D, 128, wint, 2048, 0, 2, scr, q, F.lane); continue; } q -= 4096;
#else
            if (q < 2048) { p0_item(win, DIN, D, 64, (bf16*)(WSP + WS_WIN) + (size_t)l * NPROJ * D, 0, 0, scr, q, F.lane); continue; } q -= 2048;
            if (q < 4096) { p0_item(win + 2056, DIN, D, 128, (bf16*)(WSP + WS_WIN) + (size_t)l * NPROJ * D, 2048, 0, scr, q, F.lane); continue; } q -= 4096;
#endif
            if (q < 1024) { p0_item(IN(I_WMKV) + (size_t)l * D * 1024, 1024, D, 32, (bf16*)(WSP + WS_WMKV) + (size_t)l * 1024 * D, 0, 0, scr, q, F.lane); continue; } q -= 1024;
            p0_item(IN(I_WOUT) + (size_t)l * D * D, D, D, 64, (bf16*)(WSP + WS_WOUT) + (size_t)l * D * D, 0, 0, scr, q, F.lane); continue; }
        r -= 2 * I_L;
        if (r < I_FF) { p0_item8(IN(I_FWG), DFF, D, DFF / 32, WSP + WS_WGU, 0, 1, 2, scr, r, F.lane); continue; } r -= I_FF;
        if (r < I_FF) { p0_item8(IN(I_FWU), DFF, D, DFF / 32, WSP + WS_WGU, 0, 2, 2, scr, r, F.lane); continue; } r -= I_FF;
        p0_item(IN(I_FWD), D, DFF, D / 32, (bf16*)(WSP + WS_WDN), 0, 0, scr, r, F.lane);
    }
    { float* rc = (float*)(WSP + MS_ROPE); float* rs = rc + SEQ * 64;
      for (int idx = F.blk * NTHREADS + F.tid; idx < SEQ * 64; idx += F.G * NTHREADS) { const int pos = idx >> 6, i = idx & 63;
          const double inv = exp(-(double)i * (9.210340371976184 / 64.0)); const double ang = (double)pos * inv; rc[idx] = (float)cos(ang); rs[idx] = (float)sin(ang); } }
    for (int m = gw; m < 2 * MROWS; m += NGW) { const int l = m / MROWS, row = m % MROWS;
        const f32x4* xr = (const f32x4*)(IN(I_MEM) + (size_t)row * D) + F.lane; const f32x4* gr = (const f32x4*)(IN(I_NMEMG) + (size_t)l * D) + F.lane;
        f32x4 v[8]; float ss = 0.f;
#pragma unroll
        for (int j = 0; j < 8; ++j) { v[j] = xr[64 * j]; ss += (v[j].x * v[j].x + v[j].y * v[j].y) + (v[j].z * v[j].z + v[j].w * v[j].w); }
        const float r = rsqrtf(wave_sum(ss) * (1.0f / D) + EPS);
        unsigned char* o = WSP + MS_MEMH + (size_t)l * MROWS * D * 2;
#pragma unroll
        for (int j = 0; j < 8; ++j) { const f32x4 g = gr[64 * j]; v2u w; w.x = pk2(v[j].x * r * g.x, v[j].y * r * g.y); w.y = pk2(v[j].z * r * g.z, v[j].w * r * g.w); *(v2u*)(o + img_off(row, 512 * j + 8 * F.lane, D * 2)) = w; }
    }
}

__device__ __forceinline__ void phase_rmsnorm(Frame& F, const void* x, int xbf, const float* gain, bf16* out, int mode, int l, int bi, int nb) {
    KARGS();
    LAS float* w8 = (LAS float*)F.lds;
    LAS int* lcnt = (LAS int*)(F.lds + 65536);
    if (mode != 0) {
        for (int idx = F.tid; idx < D * 8; idx += NTHREADS) { const int d = idx >> 3, e = idx & 7;
            w8[e * D + d] = mode == 1 ? IN(I_WIN)[(size_t)l * D * DIN + (size_t)d * DIN + 2048 + e] : IN(I_RW)[d * 8 + e]; }
        if (F.tid < 8) lcnt[F.tid] = 0;
        __syncthreads();
    }
    const int rpb = (T + nb - 1) / nb, row_lo = bi * rpb, nrows = row_lo + rpb <= T ? rpb : (T - row_lo > 0 ? T - row_lo : 0);
    f32x4 g[8];
#pragma unroll
    for (int j = 0; j < 8; ++j) g[j] = ((const f32x4*)gain)[64 * j + F.lane];
    f32x4 nv[8];
#define RMS_LOADROW(rr) do { if (xbf) { const v2u* xr_ = (const v2u*)((const bf16*)x + (size_t)(rr) * D) + F.lane; \
        _Pragma("unroll") for (int j = 0; j < 8; ++j) { const v2u w_ = xr_[64 * j]; nv[j] = (f32x4){bflo(w_.x), bfhi(w_.x), bflo(w_.y), bfhi(w_.y)}; } } \
      else { const f32x4* xr_ = (const f32x4*)((const float*)x + (size_t)(rr) * D) + F.lane; _Pragma("unroll") for (int j = 0; j < 8; ++j) nv[j] = xr_[64 * j]; } } while (0)
    if (F.wave < nrows) RMS_LOADROW(row_lo + F.wave);
    for (int rl = F.wave; rl < nrows; rl += NWAVES) {
        const int row = row_lo + rl;
        f32x4 v[8]; float ss = 0.f;
#pragma unroll
        for (int j = 0; j < 8; ++j) { v[j] = nv[j]; ss += (v[j].x * v[j].x + v[j].y * v[j].y) + (v[j].z * v[j].z + v[j].w * v[j].w); }
        { const int rn = rl + NWAVES < nrows ? row + NWAVES : row; RMS_LOADROW(rn); }
        const float r = rsqrtf(wave_sum(ss) * (1.0f / D) + EPS);
        float amax = 0.f;
#pragma unroll
        for (int j = 0; j < 8; ++j) { v[j] = v[j] * r * g[j]; amax = fmaxf(amax, fmaxf(fmaxf(fabsf(v[j].x), fabsf(v[j].y)), fmaxf(fabsf(v[j].z), fabsf(v[j].w)))); }
        if (!W_IN_I8 && mode == 1) {
#pragma unroll
            for (int j = 0; j < 8; ++j) { v2u w; w.x = pk2(v[j].x, v[j].y); w.y = pk2(v[j].z, v[j].w); *(v2u*)((unsigned char*)out + img_off(row, 512 * j + 8 * F.lane, D * 2)) = w; }
        } else {
        amax = wave_max(amax); const float qs = amax > 0.f ? 127.0f / amax : 0.f;
        if (F.lane == 0) ((float*)(WSP + MS_SA))[row] = amax * (1.0f / 127.0f);
#pragma unroll
        for (int j = 0; j < 8; ++j) *(unsigned*)((unsigned char*)out + img_off(row, 256 * j + 4 * F.lane, D)) = pk4_i8(v[j].x * qs, v[j].y * qs, v[j].z * qs, v[j].w * qs);
        }
        if (mode != 0) {
            float myval = 0.f;
#pragma unroll 1
            for (int e = 0; e < 8; ++e) { float s = 0.f;
#pragma unroll
                for (int j = 0; j < 8; ++j) { const f32x4 w = *(const LAS f32x4*)(w8 + e * D + 256 * j + 4 * F.lane); s += (v[j].x * w.x + v[j].y * w.y) + (v[j].z * w.z + v[j].w * w.w); }
                s = wave_sum(s); if (F.lane == e) myval = s; }
            if (mode == 1) {
                if (F.lane < 8) { float res;
                    if (F.lane < 4) { const float a = IN(I_ALOG)[l * NH + F.lane], db = IN(I_DTB)[l * NH + F.lane]; const float z = myval + db; const float sp = z > 20.f ? z : log1pf(expf(z)); res = -expf(a) * sp; }
                    else res = 1.0f / (1.0f + expf(-myval));
                    ((float*)(WSP + MS_GATES))[(size_t)row * 8 + F.lane] = res; }
            } else {
                float dt[8];
#pragma unroll
                for (int e = 0; e < 8; ++e) dt[e] = __shfl(myval, e);
                int e0 = 0; float l0 = dt[0];
#pragma unroll
                for (int e = 1; e < 8; ++e) if (dt[e] > l0) { l0 = dt[e]; e0 = e; }
                int e1 = -1; float l1 = -3.0e38f;
#pragma unroll
                for (int e = 0; e < 8; ++e) if (e != e0 && dt[e] > l1) { l1 = dt[e]; e1 = e; }
                if (F.lane == 0) { const float ex = expf(l1 - l0); const float g0 = 1.0f / (1.0f + ex), g1 = ex / (1.0f + ex);
                    ((int*)(WSP + MS_TOPE))[row * 2] = e0; ((int*)(WSP + MS_TOPE))[row * 2 + 1] = e1;
                    ((float*)(WSP + MS_TOPG))[row * 2] = g0; ((float*)(WSP + MS_TOPG))[row * 2 + 1] = g1;
                    __hip_atomic_fetch_add(&lcnt[e0], 1, __ATOMIC_RELAXED, __HIP_MEMORY_SCOPE_WORKGROUP); __hip_atomic_fetch_add(&lcnt[e1], 1, __ATOMIC_RELAXED, __HIP_MEMORY_SCOPE_WORKGROUP); }
            }
        }
    }
    if (mode == 2) { __syncthreads(); if (F.tid < 8) ((int*)(WSP + MS_CNT))[F.blk * 8 + F.tid] = lcnt[F.tid]; }
    __syncthreads();
}

__device__ __forceinline__ void phase_prep(Frame& F, int l) {
    KARGS();
    bf16* proj = (bf16*)(WSP + SC_PROJ); bf16* conva = (bf16*)(WSP + SC_CONVA); bf16* kvm = (bf16*)(WSP + MS_KVM) + (size_t)l * MROWS * 1024;
    const float* convw = IN(I_CONVW) + (size_t)l * 4 * 1536;
    const float* rc = (const float*)(WSP + MS_ROPE); const float* rs = rc + SEQ * 64;
    const int gw = F.blk * NWAVES + F.wave, NGW = F.G * NWAVES;
    const int lane = F.lane, li = lane & 15, d0 = li * 8;
    const float qscale = 0.08838834764831845f;
    LAS bf16* vt = (LAS bf16*)(F.lds + F.wave * 16896);
    for (int it = T * 8 + gw; it < T * 8 + MROWS + 1152; it += NGW) {
        if (it >= T * 8 + MROWS) {
            const int vi = it - (T * 8 + MROWS); const bf16* src; bf16* dst; int lds_;
            if (vi < 1024) { const int b = vi >> 7, h = (vi >> 5) & 3, c = vi & 31; src = proj + (size_t)(b * SEQ + c * CH) * NPROJ + C_VC + h * HD; lds_ = NPROJ; dst = (bf16*)(WSP + SC_VCT) + (size_t)vi * 8192; }
            else { const int mi = vi - 1024, b = mi >> 4, h = (mi >> 2) & 3, c = mi & 3; src = kvm + (size_t)(b * NMEM + c * CH) * 1024 + 512 + h * HD; lds_ = 1024; dst = (bf16*)(WSP + MS_VMT) + (size_t)mi * 8192; }
#pragma unroll 4
            for (int i = 0; i < 16; ++i) { const int row = 4 * i + (lane >> 4); const v4u w = *(const v4u*)(src + (size_t)row * lds_ + li * 8);
                LAS v2u* d = (LAS v2u*)(vt + row * 132 + li * 8); d[0] = (v2u){w.x, w.y}; d[1] = (v2u){w.z, w.w}; }
            asm volatile("s_waitcnt lgkmcnt(0)" ::: "memory");
            const int q4 = lane >> 4;
#pragma unroll 2
            for (int f = 0; f < 16; ++f) { const int mt8 = f >> 1, kt = f & 1; const LAS bf16* p = vt + (32 * kt + 4 * q4) * 132 + 16 * mt8 + li;
                v4u w; w.x = (unsigned)p[0] | ((unsigned)p[132] << 16); w.y = (unsigned)p[2 * 132] | ((unsigned)p[3 * 132] << 16);
                w.z = (unsigned)p[16 * 132] | ((unsigned)p[17 * 132] << 16); w.w = (unsigned)p[18 * 132] | ((unsigned)p[19 * 132] << 16);
                *(v4u*)(dst + (size_t)(f * 64 + lane) * 8) = w; }
            asm volatile("s_waitcnt lgkmcnt(0)" ::: "memory");
            continue; }
        if (it >= T * 8) {
            const int row = it - T * 8; bf16* p = kvm + (size_t)row * 1024 + lane * 8; float f[8]; unpack8(*(const v4u*)p, f);
            float ss = 0.f;
#pragma unroll
            for (int j = 0; j < 8; ++j) ss += f[j] * f[j];
            const float r = rsqrtf(grp16_sum(ss) * (1.0f / HD) + EPS); const float* gn = IN(I_MKG) + l * HD + d0;
#pragma unroll
            for (int j = 0; j < 8; ++j) f[j] = f[j] * r * gn[j];
            *(v4u*)p = pack8(f); continue; }
    }
    const int grp = gw & 7, tstart = gw >> 3, tstride = NGW >> 3;
    if (grp < 3) {
        const int c0 = grp * 512 + lane * 8; float w[4][8];
#pragma unroll
        for (int tap = 0; tap < 4; ++tap) { const f32x4 w0 = *(const f32x4*)(convw + tap * 1536 + c0), w1 = *(const f32x4*)(convw + tap * 1536 + c0 + 4);
            w[tap][0] = w0.x; w[tap][1] = w0.y; w[tap][2] = w0.z; w[tap][3] = w0.w; w[tap][4] = w1.x; w[tap][5] = w1.y; w[tap][6] = w1.z; w[tap][7] = w1.w; }
        for (int tb = tstart; tb < T; tb += 4 * tstride) {
            v4u xin[4][4];
#pragma unroll
            for (int u = 0; u < 4; ++u) { const int t = tb + u * tstride, pos = t & (SEQ - 1);
#pragma unroll
                for (int tap = 0; tap < 4; ++tap) { const int dp = pos - 3 + tap; const int tt = dp >= 0 ? t - 3 + tap : t;
                    xin[u][tap] = *(const v4u*)(proj + (size_t)tt * NPROJ + c0); } }
#pragma unroll
            for (int u = 0; u < 4; ++u) { const int t = tb + u * tstride, pos = t & (SEQ - 1); float a[8];
#pragma unroll
                for (int j = 0; j < 8; ++j) a[j] = 0.f;
#pragma unroll
                for (int tap = 0; tap < 4; ++tap) { float f[8]; unpack8(xin[u][tap], f); const float en = (pos - 3 + tap >= 0) ? 1.f : 0.f;
#pragma unroll
                    for (int j = 0; j < 8; ++j) a[j] += f[j] * (w[tap][j] * en); }
#pragma unroll
                for (int j = 0; j < 8; ++j) a[j] = silu_f(a[j]);
                if (grp < 2) { float ss = 0.f;
#pragma unroll
                    for (int j = 0; j < 8; ++j) ss += a[j] * a[j];
                    float r = rsqrtf(grp16_sum(ss) + EPS); if (grp == 0) r *= qscale;
#pragma unroll
                    for (int j = 0; j < 8; ++j) a[j] *= r; }
                *(v4u*)(conva + (size_t)t * 1536 + c0) = pack8(a); }
        }
    } else if (grp < 5) {
        const int i0 = (li & 7) * 8; const int col = (grp == 3 ? C_QB : C_KB) + lane * 8;
        for (int tb = tstart; tb < T; tb += 4 * tstride) {
            v4u xin[4]; f32x4 cs[4][4];
#pragma unroll
            for (int u = 0; u < 4; ++u) { const int t = tb + u * tstride, pos = t & (SEQ - 1); xin[u] = *(const v4u*)(proj + (size_t)t * NPROJ + col);
                cs[u][0] = *(const f32x4*)(rc + pos * 64 + i0); cs[u][1] = *(const f32x4*)(rc + pos * 64 + i0 + 4); cs[u][2] = *(const f32x4*)(rs + pos * 64 + i0); cs[u][3] = *(const f32x4*)(rs + pos * 64 + i0 + 4); }
#pragma unroll
            for (int u = 0; u < 4; ++u) { const int t = tb + u * tstride; float f[8], o[8]; unpack8(xin[u], f);
                const float c[8] = {cs[u][0].x, cs[u][0].y, cs[u][0].z, cs[u][0].w, cs[u][1].x, cs[u][1].y, cs[u][1].z, cs[u][1].w}, sn[8] = {cs[u][2].x, cs[u][2].y, cs[u][2].z, cs[u][2].w, cs[u][3].x, cs[u][3].y, cs[u][3].z, cs[u][3].w};
#pragma unroll
                for (int j = 0; j < 8; ++j) { const float other = __shfl_xor(f[j], 8); o[j] = li < 8 ? f[j] * c[j] - other * sn[j] : f[j] * c[j] + other * sn[j]; }
                if (grp == 4) {
#pragma unroll
                    for (int j = 0; j < 8; ++j) o[j] *= qscale; }
                *(v4u*)(proj + (size_t)t * NPROJ + col) = pack8(o); }
        }
    } else {
        const int col = (grp == 5 ? C_QC : (grp == 6 ? C_KC : C_QM)) + lane * 8; const float* gn = (grp == 5 ? IN(I_AQG) : (grp == 6 ? IN(I_AKG) : IN(I_MQG))) + l * HD + d0;
        float gv[8];
#pragma unroll
        for (int j = 0; j < 8; ++j) gv[j] = gn[j] * (grp != 6 ? qscale : 1.0f);
        for (int tb = tstart; tb < T; tb += 4 * tstride) {
            v4u xin[4];
#pragma unroll
            for (int u = 0; u < 4; ++u) xin[u] = *(const v4u*)(proj + (size_t)(tb + u * tstride) * NPROJ + col);
#pragma unroll
            for (int u = 0; u < 4; ++u) { float f[8]; unpack8(xin[u], f); float ss = 0.f;
#pragma unroll
                for (int j = 0; j < 8; ++j) ss += f[j] * f[j];
                const float r = rsqrtf(grp16_sum(ss) * (1.0f / HD) + EPS);
#pragma unroll
                for (int j = 0; j < 8; ++j) f[j] = f[j] * r * gv[j];
                *(v4u*)(proj + (size_t)(tb + u * tstride) * NPROJ + col) = pack8(f); }
        }
    }
}

__device__ __forceinline__ void phase_attn_naive(Frame& F, int l) {
    KARGS();
    const bf16* proj = (const bf16*)(WSP + SC_PROJ); const bf16* kvm = (const bf16*)(WSP + MS_KVM) + (size_t)l * MROWS * 1024; bf16* mix = (bf16*)(WSP + WS_HB);
    LAS float* sq = (LAS float*)F.lds + F.wave * 128;
    LAS float* sp = (LAS float*)(F.lds + 4096) + F.wave * 640;
    const float* relb = IN(I_RELB) + (size_t)l * NH * RELW;
    for (int u = F.blk; u < 2 * NB * NH * NCHUNK; u += F.G) {
        const int kind = u / (NB * NH * NCHUNK), r = u % (NB * NH * NCHUNK), b = r / (NH * NCHUNK), h = (r / NCHUNK) % NH, n = r % NCHUNK;
        const int c0 = kind == 0 ? (n - NPREV < 0 ? 0 : n - NPREV) : 0; const int nk = kind == 0 ? CH * (n - c0 + 1) : NMEM;
        const bf16* kb = kind == 0 ? proj + (size_t)(b * SEQ + c0 * CH) * NPROJ + C_KC + h * HD : kvm + (size_t)(b * NMEM) * 1024 + h * HD;
        const bf16* vb = kind == 0 ? proj + (size_t)(b * SEQ + c0 * CH) * NPROJ + C_VC + h * HD : kvm + (size_t)(b * NMEM) * 1024 + 512 + h * HD;
        const int ld = kind == 0 ? NPROJ : 1024;
        for (int qi = 0; qi < 8; ++qi) {
            const int ql = F.wave * 8 + qi, t = b * SEQ + n * CH + ql;
            const bf16* qp = proj + (size_t)t * NPROJ + (kind == 0 ? C_QC : C_QM) + h * HD;
            { const unsigned w = ((const unsigned*)qp)[F.lane]; sq[2 * F.lane] = bflo(w); sq[2 * F.lane + 1] = bfhi(w); }
            asm volatile("s_waitcnt lgkmcnt(0)" ::: "memory");
            float mx = -3.0e38f;
            for (int kk = F.lane; kk < nk; kk += 64) { const v4u* kr = (const v4u*)(kb + (size_t)kk * ld); float s = 0.f;
#pragma unroll
                for (int c = 0; c < 16; ++c) { float f[8]; unpack8(kr[c], f);
#pragma unroll
                    for (int j = 0; j < 8; ++j) s += f[j] * sq[c * 8 + j]; }
                if (kind == 0) { int rel = (n * CH + ql) - (c0 * CH + kk); rel = rel < -128 ? -128 : (rel > 128 ? 128 : rel); s += relb[h * RELW + rel + 128]; }
                sp[kk] = s; mx = fmaxf(mx, s); }
            mx = wave_max(mx); float sum = 0.f;
            for (int kk = F.lane; kk < nk; kk += 64) { const float p = __expf(sp[kk] - mx); sp[kk] = p; sum += p; }
            sum = wave_sum(sum); const float inv = 1.0f / sum;
            asm volatile("s_waitcnt lgkmcnt(0)" ::: "memory");
            float o0 = 0.f, o1 = 0.f;
            for (int kk = 0; kk < nk; ++kk) { const float p = sp[kk]; const unsigned w = *(const unsigned*)(vb + (size_t)kk * ld + 2 * F.lane); o0 += p * bflo(w); o1 += p * bfhi(w); }
            *(unsigned*)(mix + (size_t)t * D + (kind == 0 ? 1024 : 1536) + h * HD + 2 * F.lane) = pk2(o0 * inv, o1 * inv);
            asm volatile("s_waitcnt lgkmcnt(0)" ::: "memory");
        }
    }
}

__device__ __forceinline__ void phase_recur_naive(Frame& F, int l) {
    if (F.blk >= 2 * NB * NH) return;
    const int kind = F.blk / (NB * NH), b = (F.blk / NH) % NB, h = F.blk % NH;
    const bf16* proj = (const bf16*)(WSP + SC_PROJ); const bf16* conva = (const bf16*)(WSP + SC_CONVA); const float* gates = (const float*)(WSP + MS_GATES);
    float* obuf = (float*)(WSP + SC_OBUF);
    LAS float* sk = (LAS float*)F.lds; LAS float* sqv = sk + 128; LAS float* sv = sk + 256; LAS float* red = sk + 384; LAS float* red2 = sk + 896; LAS float* sab = sk + 1408;
    const int v = F.tid & 127, kg = F.tid >> 7;
    float s[32];
#pragma unroll
    for (int i = 0; i < 32; ++i) s[i] = 0.f;
    const float gam = 1.0f - exp2f(-5.0f - (float)h);
    const bf16* qb = kind == 0 ? conva + C_QA + h * HD : proj + C_QB + h * HD; const bf16* kb = kind == 0 ? conva + 512 + h * HD : proj + C_KB + h * HD; const bf16* vb = kind == 0 ? conva + 1024 + h * HD : proj + C_VB + h * HD;
    const int ld = kind == 0 ? 1536 : NPROJ;
    bf16 pk_ = 0, pq_ = 0, pv_ = 0; float pg_ = 0.f, pb_ = 0.f;
    { const int t = b * SEQ; if (F.tid < 128) { pk_ = kb[(size_t)t * ld + F.tid]; pq_ = qb[(size_t)t * ld + F.tid]; pv_ = vb[(size_t)t * ld + F.tid]; } if (kind == 0) { pg_ = gates[(size_t)t * 8 + h]; pb_ = gates[(size_t)t * 8 + 4 + h]; } }
    for (int tt = 0; tt < SEQ; ++tt) {
        const int t = b * SEQ + tt;
        if (F.tid < 128) { sk[F.tid] = bf2f(pk_); sqv[F.tid] = bf2f(pq_); sv[F.tid] = bf2f(pv_); }
        if (F.tid == 0) { if (kind == 0) { sab[0] = expf(pg_); sab[1] = pb_; } else { sab[0] = gam; sab[1] = 0.f; } }
        if (tt + 1 < SEQ) { const int t1 = t + 1; if (F.tid < 128) { pk_ = kb[(size_t)t1 * ld + F.tid]; pq_ = qb[(size_t)t1 * ld + F.tid]; pv_ = vb[(size_t)t1 * ld + F.tid]; } if (kind == 0) { pg_ = gates[(size_t)t1 * 8 + h]; pb_ = gates[(size_t)t1 * 8 + 4 + h]; } }
        __syncthreads();
        const float a = sab[0], bb = sab[1], bp = kind == 0 ? bb : 1.0f;
        float part = 0.f;
#pragma unroll
        for (int i = 0; i < 32; ++i) part += sk[kg * 32 + i] * s[i];
        red[kg * 128 + v] = part;
        __syncthreads();
        const float ks = (red[v] + red[128 + v]) + (red[256 + v] + red[384 + v]);
        const float dl = bp * sv[v] - a * bb * ks;
        float p2 = 0.f;
#pragma unroll
        for (int i = 0; i < 32; ++i) { s[i] = a * s[i] + sk[kg * 32 + i] * dl; p2 += sqv[kg * 32 + i] * s[i]; }
        red2[kg * 128 + v] = p2;
        __syncthreads();
        if (kg == 0) obuf[(size_t)t * 1024 + kind * 512 + h * HD + v] = (red2[v] + red2[128 + v]) + (red2[256 + v] + red2[384 + v]);
    }
}


template <int MT, int KS, int NTHR>
__device__ __forceinline__ void write_frags(const LAS bf16* X, int ldx, bf16* dst, int t0) {
    v2u lo[MT * KS * 64 / NTHR], hi[MT * KS * 64 / NTHR];
#pragma unroll
    for (int it = 0; it < MT * KS * 64 / NTHR; ++it) { const int idx = t0 + it * NTHR, ln = idx & 63, ks = (idx >> 6) % KS, mt = (idx >> 6) / KS, c16 = ln & 15, q4 = ln >> 4;
        const LAS bf16* p = X + (16 * mt + c16) * ldx + 32 * ks + 4 * q4; lo[it] = *(const LAS v2u*)p; hi[it] = *(const LAS v2u*)(p + 16); }
#pragma unroll
    for (int it = 0; it < MT * KS * 64 / NTHR; ++it) { const int idx = t0 + it * NTHR; *(v4u*)(dst + (size_t)idx * 8) = (v4u){lo[it].x, lo[it].y, hi[it].x, hi[it].y}; }
}
template <int I, int H> __device__ __forceinline__ void c1_load(f32x4 (&dst)[8], const LAS float* Lm) {
#pragma unroll
    for (int jj = 0; jj < 8; ++jj) { constexpr int dummy = 0; const int j4 = 8 * H + jj; if (j4 < (I + 3) / 4) dst[jj] = *(const LAS f32x4*)(Lm + I * 64 + 4 * j4); (void)dummy; }
}
template <int I, int H> __device__ __forceinline__ void c1_comp(const f32x4 (&src)[8], const float (&x)[64], float& a0, float& a1, float& a2, float& a3) {
#pragma unroll
    for (int jj = 0; jj < 8; ++jj) { const int j4 = 8 * H + jj; if (j4 < (I + 3) / 4) { const f32x4 lv = src[jj];
        if (4 * j4 + 0 < I) a0 += lv.x * x[4 * j4 + 0]; if (4 * j4 + 1 < I) a1 += lv.y * x[4 * j4 + 1]; if (4 * j4 + 2 < I) a2 += lv.z * x[4 * j4 + 2]; if (4 * j4 + 3 < I) a3 += lv.w * x[4 * j4 + 3]; } }
}
template <int I> struct C1Rows {
    static __device__ __forceinline__ void run(float (&x)[64], f32x4 (&la)[8], f32x4 (&lb)[8], const LAS float* Lm) {
        float a0 = 0.f, a1 = 0.f, a2 = 0.f, a3 = 0.f;
        c1_load<I, 1>(lb, Lm);
        __builtin_amdgcn_sched_barrier(0);
        c1_comp<I, 0>(la, x, a0, a1, a2, a3);
        __builtin_amdgcn_sched_barrier(0);
        if (I + 1 < 64) c1_load<(I + 1 < 64 ? I + 1 : 63), 0>(la, Lm);
        __builtin_amdgcn_sched_barrier(0);
        c1_comp<I, 1>(lb, x, a0, a1, a2, a3);
        x[I] = x[I] - ((a0 + a1) + (a2 + a3));
        __builtin_amdgcn_sched_barrier(0);
        C1Rows<I + 1>::run(x, la, lb, Lm);
    }
};
template <> struct C1Rows<64> { static __device__ __forceinline__ void run(float (&)[64], f32x4 (&)[8], f32x4 (&)[8], const LAS float*) {} };
constexpr int C1_HSZ = 77824;
__device__ __forceinline__ void phase_c1(Frame& F, int l) {
    const bf16* proj = (const bf16*)(WSP + SC_PROJ); const bf16* conva = (const bf16*)(WSP + SC_CONVA); const float* gates = (const float*)(WSP + MS_GATES);
    const int lane = F.lane, wave = F.wave, c16 = lane & 15, q4 = lane >> 4;
    const int hb = wave >> 2, lw = wave & 3, lt = F.tid & 255;
    LAS unsigned char* hl = F.lds + hb * C1_HSZ;
    LAS float* Lm = (LAS float*)hl; LAS float* Lm_u = Lm;
    LAS bf16* Xa = (LAS bf16*)(hl + 16384);
    LAS bf16* Xk = (LAS bf16*)(hl + 25088);
    LAS float* sgc = (LAS float*)(hl + 42496); LAS float* sbeta = sgc + 64; LAS float* seg = sgc + 128; LAS float* sbeta_u = sbeta; LAS float* seg_u = seg;
    LAS bf16* Xkr = (LAS bf16*)(hl + 43264);
    LAS bf16* Xw = Xkr;
    LAS bf16* Xv = (LAS bf16*)(hl + 60160);
    for (int u0 = F.blk; u0 < 2048; u0 += 2 * F.G) {
        const int uu = u0 + hb * F.G; const bool act = uu < 2048; const int u = act ? uu : 0;
        const int kind = u >> 10, r = u & 1023, b = r >> 7, h = (r >> 5) & 3, n = r & 31, t0 = b * SEQ + n * CH;
        const bf16* qb = kind == 0 ? conva + h * HD : proj + C_QB + h * HD; const bf16* kb = kind == 0 ? conva + 512 + h * HD : proj + C_KB + h * HD; const bf16* vb = kind == 0 ? conva + 1024 + h * HD : proj + C_VB + h * HD;
        const int ld = kind == 0 ? 1536 : NPROJ;
        unsigned char* rec = WSP + SC_PRE + (size_t)(kind * 1024 + (b * NH + h) * 32 + n) * REC_BYTES;
        bf16x8 qa[4];
        { const bf16* xq = qb + (size_t)(t0 + 16 * lw + c16) * ld + 8 * q4;
#pragma unroll
          for (int ks = 0; ks < 4; ++ks) qa[ks] = *(const bf16x8*)(xq + 32 * ks); }
        v4u qv[4], kv[4], vv[4];
        { const int row = lt >> 2, cb = (lt & 3) * 32; const size_t o = (size_t)(t0 + row) * ld + cb;
#pragma unroll
          for (int i = 0; i < 4; ++i) { qv[i] = *(const v4u*)(qb + o + 8 * i); kv[i] = *(const v4u*)(kb + o + 8 * i); vv[i] = *(const v4u*)(vb + o + 8 * i); } }
        if (lw == 0) { float g, be;
            if (kind == 0) { g = gates[(size_t)(t0 + lane) * 8 + h]; be = gates[(size_t)(t0 + lane) * 8 + 4 + h]; } else { g = log1pf(-exp2f(-5.0f - (float)h)); be = 1.0f; }
#pragma unroll
            for (int o = 1; o < 64; o <<= 1) { const float y = __shfl_up(g, o); if (lane >= o) g += y; }
            sgc[lane] = g; sbeta[lane] = be; seg[lane] = __expf(g);
            if (lane == 63 && act) ((float*)(WSP + MS_GTOT))[kind * 1024 + (b * NH + h) * 32 + n] = __expf(g); }
        __syncthreads();
        { const int row = lt >> 2, ksq = lt & 3, cb = ksq * 32; const float eq = seg[row], ek = __expf(sgc[63] - sgc[row]);
          float f[32];
#pragma unroll
          for (int i = 0; i < 4; ++i) { float t8[8]; unpack8(qv[i], t8);
#pragma unroll
              for (int j = 0; j < 8; ++j) f[8 * i + j] = t8[j] * eq; }
          if (act) { bf16* dq = (bf16*)(rec + REC_QF) + (size_t)((((row >> 4) * 4 + ksq) * 64) + (row & 15)) * 8;
#pragma unroll
              for (int qq = 0; qq < 4; ++qq) *(v4u*)(dq + (size_t)qq * 16 * 8) = (v4u){pk2(f[4 * qq], f[4 * qq + 1]), pk2(f[4 * qq + 2], f[4 * qq + 3]), pk2(f[16 + 4 * qq], f[16 + 4 * qq + 1]), pk2(f[16 + 4 * qq + 2], f[16 + 4 * qq + 3])}; }
          { LAS v2u* d = (LAS v2u*)(Xkr + row * 132 + cb);
#pragma unroll
            for (int i = 0; i < 4; ++i) { d[2 * i] = (v2u){kv[i].x, kv[i].y}; d[2 * i + 1] = (v2u){kv[i].z, kv[i].w}; } }
          { LAS v2u* d = (LAS v2u*)(Xv + row * 132 + cb);
#pragma unroll
            for (int i = 0; i < 4; ++i) { d[2 * i] = (v2u){vv[i].x, vv[i].y}; d[2 * i + 1] = (v2u){vv[i].z, vv[i].w}; } }
#pragma unroll
          for (int i = 0; i < 4; ++i) { float t8[8]; unpack8(kv[i], t8);
#pragma unroll
              for (int j = 0; j < 8; ++j) Xk[(cb + 8 * i + j) * 68 + row] = (bf16)f2bf(t8[j] * ek); } }
        __syncthreads();
        { const int mt = lw;
            bf16x8 bfr[16];
#pragma unroll
            for (int nt = 0; nt < 4; ++nt)
#pragma unroll
                for (int ks = 0; ks < 4; ++ks) { const LAS bf16* pb = Xkr + (16 * nt + c16) * 132 + 32 * ks + 8 * q4; const v2u lo = *(const LAS v2u*)pb, hi = *(const LAS v2u*)(pb + 4); bfr[nt * 4 + ks] = __builtin_bit_cast(bf16x8, (v4u){lo.x, lo.y, hi.x, hi.y}); }
#pragma unroll 1
            for (int mat = 0; mat < (kind == 0 ? 2 : 1); ++mat) {
                bf16x8 af[4];
                if (mat == 0) {
#pragma unroll
                    for (int ks = 0; ks < 4; ++ks) af[ks] = qa[ks];
                } else {
#pragma unroll
                    for (int ks = 0; ks < 4; ++ks) { const LAS bf16* pa = Xkr + (16 * mt + c16) * 132 + 32 * ks + 8 * q4; const v2u lo = *(const LAS v2u*)pa, hi = *(const LAS v2u*)(pa + 4); af[ks] = __builtin_bit_cast(bf16x8, (v4u){lo.x, lo.y, hi.x, hi.y}); } }
#pragma unroll
                for (int nt = 0; nt < 4; ++nt) { f32x4 acc = {0.f, 0.f, 0.f, 0.f};
#pragma unroll
                    for (int ks = 0; ks < 4; ++ks) acc = __builtin_amdgcn_mfma_f32_16x16x32_bf16(af[ks], bfr[nt * 4 + ks], acc, 0, 0, 0);
                    const int j = 16 * nt + c16; const float gj = sgc[j];
#pragma unroll
                    for (int rr = 0; rr < 4; ++rr) { const int i = 16 * mt + 4 * q4 + rr; const float dec = j <= i ? __expf(sgc[i] - gj) : 0.f;
                        if (mat == 0) Xa[i * 68 + j] = (bf16)f2bf(acc[rr] * dec); else Lm[i * 64 + j] = j < i ? acc[rr] * dec * sbeta[i] : 0.f; } } } }
        __syncthreads();
        if (act) { write_frags<4, 2, 256>(Xa, 68, (bf16*)(rec + REC_AF), lt); write_frags<8, 2, 256>(Xk, 68, (bf16*)(rec + REC_KF), lt); }
        { const int c = lt;
            int vz = 0; asm volatile("" : "+v"(vz));
            const LAS float* sbeta = sbeta_u + vz; const LAS float* seg = seg_u + vz; const LAS float* Lm = Lm_u + vz;
            if (kind == 0) { float x[64]; const LAS bf16* src = c < 128 ? Xv + c : Xkr + (c - 128);
#pragma unroll
                for (int i = 0; i < 64; ++i) { float rhs = bf2f(src[i * 132]) * sbeta[i]; if (c >= 128) rhs *= seg[i]; x[i] = rhs; }
                { f32x4 la[8], lb[8]; c1_load<1, 0>(la, Lm); C1Rows<1>::run(x, la, lb, Lm); }
                if (c < 128) { const int nt = c >> 4, cc = c & 15;
                    if (act) {
#pragma unroll
                    for (int mt = 0; mt < 4; ++mt)
#pragma unroll
                        for (int qq = 0; qq < 4; ++qq) *(f32x4*)(rec + REC_U + (size_t)(((nt * 4 + mt) * 64) + 16 * qq + cc) * 16) = (f32x4){x[16 * mt + 4 * qq], x[16 * mt + 4 * qq + 1], x[16 * mt + 4 * qq + 2], x[16 * mt + 4 * qq + 3]}; }
                } else {
#pragma unroll
                    for (int i = 0; i < 64; ++i) Xw[i * 132 + (c - 128)] = (bf16)f2bf(x[i]); }
            } else if (c < 128 && act) { const int nt = c >> 4, cc = c & 15;
#pragma unroll 1
                for (int i4 = 0; i4 < 16; ++i4) { const int mt = i4 >> 2, qq = i4 & 3; const LAS bf16* p = Xv + (4 * i4) * 132 + c;
                    *(f32x4*)(rec + REC_U + (size_t)(((nt * 4 + mt) * 64) + 16 * qq + cc) * 16) = (f32x4){bf2f(p[0]), bf2f(p[132]), bf2f(p[264]), bf2f(p[396])}; } }
        }
        __syncthreads();
        if (kind == 0 && act) write_frags<4, 4, 256>(Xw, 132, (bf16*)(rec + REC_WF), lt);
        __syncthreads();
    }
}
__device__ __forceinline__ bf16x8 pack_b(const f32x4 a, const f32x4 b) {
    v4u w; w.x = pg8::cvt_pk_bf16(a[0], a[1]); w.y = pg8::cvt_pk_bf16(a[2], a[3]); w.z = pg8::cvt_pk_bf16(b[0], b[1]); w.w = pg8::cvt_pk_bf16(b[2], b[3]); return __builtin_bit_cast(bf16x8, w); }
__device__ __forceinline__ void scan_dma(const unsigned char* rec, int pair, LAS unsigned char* buf, int wave, int lane) {
#pragma unroll
    for (int k = 0; k < 8; ++k) { const int i = wave * 8 + k;
        const unsigned char* src = i < 56 ? rec + i * 1024 : rec + REC_U + pair * 8192 + (i - 56) * 1024;
        __builtin_amdgcn_global_load_lds((const unsigned*)(src + lane * 16), (LAS unsigned*)(buf + i * 1024), 16, 0, 0); }
}
template <int BUF>
__device__ __forceinline__ void scan_step(LAS unsigned char* lds, f32x4 (&S)[8], const int kind, const float gt, float* op, const int wave, const int lane) {
    const LAS unsigned char* buf = lds + BUF * 65536;
    const LAS bf16x8* Qf = (const LAS bf16x8*)(buf + REC_QF) + lane; const LAS bf16x8* Kf = (const LAS bf16x8*)(buf + REC_KF) + lane;
    const LAS bf16x8* Af = (const LAS bf16x8*)(buf + REC_AF) + lane; const LAS bf16x8* Wf = (const LAS bf16x8*)(buf + REC_WF) + lane;
    const LAS f32x4* Uf = (const LAS f32x4*)(buf + 57344 + wave * 4096) + lane;
    bf16x8 Sb[4];
#pragma unroll
    for (int ks = 0; ks < 4; ++ks) Sb[ks] = pack_b(S[2 * ks], S[2 * ks + 1]);
    f32x4 vn[4]; bf16x8 fa[16], fb[8];
#pragma unroll
    for (int mt = 0; mt < 4; ++mt) vn[mt] = Uf[mt * 64];
    if (kind == 0) {
#pragma unroll
        for (int i = 0; i < 16; ++i) fa[i] = Wf[i * 64];
        __builtin_amdgcn_sched_barrier(0);
#pragma unroll
        for (int mt = 0; mt < 4; ++mt) { f32x4 acc = {0.f, 0.f, 0.f, 0.f};
#pragma unroll
            for (int ks = 0; ks < 4; ++ks) acc = __builtin_amdgcn_mfma_f32_16x16x32_bf16(fa[mt * 4 + ks], Sb[ks], acc, 0, 0, 0);
            vn[mt] = vn[mt] - acc; } }
#pragma unroll
    for (int i = 0; i < 16; ++i) fa[i] = Qf[i * 64];
#pragma unroll
    for (int i = 0; i < 8; ++i) fb[i] = Af[i * 64];
    __builtin_amdgcn_sched_barrier(0);
    bf16x8 Vb[2]; Vb[0] = pack_b(vn[0], vn[1]); Vb[1] = pack_b(vn[2], vn[3]);
    f32x4 o[4];
#pragma unroll
    for (int mt = 0; mt < 4; ++mt) { o[mt] = (f32x4){0.f, 0.f, 0.f, 0.f};
#pragma unroll
        for (int ks = 0; ks < 4; ++ks) o[mt] = __builtin_amdgcn_mfma_f32_16x16x32_bf16(fa[mt * 4 + ks], Sb[ks], o[mt], 0, 0, 0);
#pragma unroll
        for (int kt = 0; kt < 2; ++kt) o[mt] = __builtin_amdgcn_mfma_f32_16x16x32_bf16(fb[mt * 2 + kt], Vb[kt], o[mt], 0, 0, 0); }
    __builtin_amdgcn_sched_barrier(0);
#pragma unroll
    for (int i = 0; i < 16; ++i) fa[i] = Kf[i * 64];
#pragma unroll
    for (int mt = 0; mt < 4; ++mt) { float* p = op + (size_t)mt * 16 * 1024; p[0] = o[mt][0]; p[1024] = o[mt][1]; p[2048] = o[mt][2]; p[3072] = o[mt][3]; }
    __builtin_amdgcn_sched_barrier(0);
#pragma unroll
    for (int m8 = 0; m8 < 8; ++m8) { f32x4 a = S[m8] * gt;
#pragma unroll
        for (int kt = 0; kt < 2; ++kt) a = __builtin_amdgcn_mfma_f32_16x16x32_bf16(fa[m8 * 2 + kt], Vb[kt], a, 0, 0, 0);
        S[m8] = a; }
}
__device__ __forceinline__ void phase_scan(Frame& F, int l) {
    float* obuf = (float*)(WSP + SC_OBUF); const float* gtot = (const float*)(WSP + MS_GTOT);
    const int lane = F.lane, c16 = lane & 15, q4 = lane >> 4, wave = F.wave;
    for (int cb = F.blk; cb < 256; cb += F.G) {
        const int grp = (cb & 7) * 8 + (cb >> 5), pair = (cb >> 3) & 3, kind = grp >> 5, bh = grp & 31, b = bh >> 2, h = bh & 3, s8 = pair * 2 + wave;
        const unsigned char* rec0 = WSP + SC_PRE + (size_t)(kind * 1024 + bh * 32) * REC_BYTES;
        const float gtv = gtot[kind * 1024 + bh * 32 + (lane & 31)];
        float* op0 = obuf + (size_t)(b * SEQ + 4 * q4) * 1024 + kind * 512 + h * HD + 16 * s8 + c16;
        f32x4 S[8];
#pragma unroll
        for (int i = 0; i < 8; ++i) S[i] = (f32x4){0.f, 0.f, 0.f, 0.f};
        scan_dma(rec0, pair, F.lds, wave, lane);
#pragma unroll 1
        for (int n = 0; n < NCHUNK; n += 2) {
            asm volatile("s_waitcnt vmcnt(0)" ::: "memory"); __builtin_amdgcn_s_barrier(); asm volatile("" ::: "memory");
            scan_dma(rec0 + (size_t)(n + 1) * REC_BYTES, pair, F.lds + 65536, wave, lane);
            if (wave < 2) scan_step<0>(F.lds, S, kind, __shfl(gtv, n), op0 + (size_t)n * CH * 1024, wave, lane);
            asm volatile("s_waitcnt vmcnt(0)" ::: "memory"); __builtin_amdgcn_s_barrier(); asm volatile("" ::: "memory");
            if (n + 2 < NCHUNK) scan_dma(rec0 + (size_t)(n + 2) * REC_BYTES, pair, F.lds, wave, lane);
            if (wave < 2) scan_step<1>(F.lds, S, kind, __shfl(gtv, n + 1), op0 + (size_t)(n + 1) * CH * 1024, wave, lane);
        }
        asm volatile("s_waitcnt vmcnt(0) lgkmcnt(0)" ::: "memory"); __builtin_amdgcn_s_barrier(); asm volatile("" ::: "memory");
    }
}

__device__ __forceinline__ void scan_dma8(const unsigned char* rec, LAS unsigned char* buf, int wave, int lane) {
#pragma unroll
    for (int k = 0; k < 7; ++k) { const int i = wave * 7 + k;
        __builtin_amdgcn_global_load_lds((const unsigned*)(rec + i * 1024 + lane * 16), (LAS unsigned*)(buf + i * 1024), 16, 0, 0); }
}
template <int BUF>
__device__ __forceinline__ void scan_step8(LAS unsigned char* lds, f32x4 (&S)[8], f32x4 (&un)[4], const unsigned char* unext, const int kind, const float gt, float* op, const int lane) {
    const LAS unsigned char* buf = lds + BUF * 65536;
    const LAS bf16x8* Qf = (const LAS bf16x8*)(buf + REC_QF) + lane; const LAS bf16x8* Kf = (const LAS bf16x8*)(buf + REC_KF) + lane;
    const LAS bf16x8* Af = (const LAS bf16x8*)(buf + REC_AF) + lane; const LAS bf16x8* Wf = (const LAS bf16x8*)(buf + REC_WF) + lane;
    bf16x8 Sb[4];
#pragma unroll
    for (int ks = 0; ks < 4; ++ks) Sb[ks] = pack_b(S[2 * ks], S[2 * ks + 1]);
    f32x4 vn[4]; bf16x8 fa[16], fb[8];
#pragma unroll
    for (int mt = 0; mt < 4; ++mt) vn[mt] = un[mt];
    if (unext) {
#pragma unroll
        for (int mt = 0; mt < 4; ++mt) un[mt] = *(const f32x4*)(unext + mt * 1024); }
    if (kind == 0) {
#pragma unroll
        for (int i = 0; i < 16; ++i) fa[i] = Wf[i * 64];
        __builtin_amdgcn_sched_barrier(0);
#pragma unroll
        for (int mt = 0; mt < 4; ++mt) { f32x4 acc = {0.f, 0.f, 0.f, 0.f};
#pragma unroll
            for (int ks = 0; ks < 4; ++ks) acc = __builtin_amdgcn_mfma_f32_16x16x32_bf16(fa[mt * 4 + ks], Sb[ks], acc, 0, 0, 0);
            vn[mt] = vn[mt] - acc; } }
#pragma unroll
    for (int i = 0; i < 16; ++i) fa[i] = Qf[i * 64];
#pragma unroll
    for (int i = 0; i < 8; ++i) fb[i] = Af[i * 64];
    __builtin_amdgcn_sched_barrier(0);
    bf16x8 Vb[2]; Vb[0] = pack_b(vn[0], vn[1]); Vb[1] = pack_b(vn[2], vn[3]);
    f32x4 o[4];
#pragma unroll
    for (int mt = 0; mt < 4; ++mt) { o[mt] = (f32x4){0.f, 0.f, 0.f, 0.f};
#pragma unroll
        for (int ks = 0; ks < 4; ++ks) o[mt] = __builtin_amdgcn_mfma_f32_16x16x32_bf16(fa[mt * 4 + ks], Sb[ks], o[mt], 0, 0, 0);
#pragma unroll
        for (int kt = 0; kt < 2; ++kt) o[mt] = __builtin_amdgcn_mfma_f32_16x16x32_bf16(fb[mt * 2 + kt], Vb[kt], o[mt], 0, 0, 0); }
    __builtin_amdgcn_sched_barrier(0);
#pragma unroll
    for (int i = 0; i < 16; ++i) fa[i] = Kf[i * 64];
#pragma unroll
    for (int mt = 0; mt < 4; ++mt) { float* p = op + (size_t)mt * 16 * 1024; p[0] = o[mt][0]; p[1024] = o[mt][1]; p[2048] = o[mt][2]; p[3072] = o[mt][3]; }
    __builtin_amdgcn_sched_barrier(0);
#pragma unroll
    for (int m8 = 0; m8 < 8; ++m8) { f32x4 a = S[m8] * gt;
#pragma unroll
        for (int kt = 0; kt < 2; ++kt) a = __builtin_amdgcn_mfma_f32_16x16x32_bf16(fa[m8 * 2 + kt], Vb[kt], a, 0, 0, 0);
        S[m8] = a; }
}
__device__ __forceinline__ void phase_scan8(Frame& F, int l) {
    float* obuf = (float*)(WSP + SC_OBUF); const float* gtot = (const float*)(WSP + MS_GTOT);
    const int lane = F.lane, c16 = lane & 15, q4 = lane >> 4, wave = F.wave;
    const int grp = (F.blk & 7) * 8 + (F.blk >> 3), kind = grp >> 5, bh = grp & 31, b = bh >> 2, h = bh & 3;
    const unsigned char* rec0 = WSP + SC_PRE + (size_t)(kind * 1024 + bh * 32) * REC_BYTES;
    const float gtv = gtot[kind * 1024 + bh * 32 + (lane & 31)];
    float* op0 = obuf + (size_t)(b * SEQ + 4 * q4) * 1024 + kind * 512 + h * HD + 16 * wave + c16;
    const unsigned char* up = rec0 + REC_U + wave * 4096 + lane * 16;
    f32x4 S[8], ua[4];
#pragma unroll
    for (int i = 0; i < 8; ++i) S[i] = (f32x4){0.f, 0.f, 0.f, 0.f};
#pragma unroll
    for (int mt = 0; mt < 4; ++mt) ua[mt] = *(const f32x4*)(up + mt * 1024);
    scan_dma8(rec0, F.lds, wave, lane);
#pragma unroll 1
    for (int n = 0; n < NCHUNK; n += 2) {
        asm volatile("s_waitcnt vmcnt(0)" ::: "memory"); __builtin_amdgcn_s_barrier(); asm volatile("" ::: "memory");
        scan_dma8(rec0 + (size_t)(n + 1) * REC_BYTES, F.lds + 65536, wave, lane);
        scan_step8<0>(F.lds, S, ua, up + (size_t)(n + 1) * REC_BYTES, kind, __shfl(gtv, n), op0 + (size_t)n * CH * 1024, lane);
        asm volatile("s_waitcnt vmcnt(0)" ::: "memory"); __builtin_amdgcn_s_barrier(); asm volatile("" ::: "memory");
        if (n + 2 < NCHUNK) scan_dma8(rec0 + (size_t)(n + 2) * REC_BYTES, F.lds, wave, lane);
        scan_step8<1>(F.lds, S, ua, n + 2 < NCHUNK ? up + (size_t)(n + 2) * REC_BYTES : nullptr, kind, __shfl(gtv, n + 1), op0 + (size_t)(n + 1) * CH * 1024, lane);
    }
    asm volatile("s_waitcnt vmcnt(0) lgkmcnt(0)" ::: "memory"); __builtin_amdgcn_s_barrier(); asm volatile("" ::: "memory");
}

constexpr int AT_STAGE = 32768, AT_TB = 4 * AT_STAGE;
__device__ __forceinline__ void attn_dma(const bf16* ktile, const bf16* vtile, const unsigned (&koff)[2], const unsigned voff, LAS unsigned char* st, int wave) {
#pragma unroll
    for (int k = 0; k < 2; ++k) __builtin_amdgcn_global_load_lds((const unsigned*)((const char*)ktile + koff[k]), (LAS unsigned*)(st + (2 * wave + k) * 1024), 16, 0, 0);
#pragma unroll
    for (int k = 0; k < 2; ++k) __builtin_amdgcn_global_load_lds((const unsigned*)((const char*)vtile + voff + k * 1024), (LAS unsigned*)(st + 16384 + (2 * wave + k) * 1024), 16, 0, 0);
}
template <int STG>
__device__ __forceinline__ void attn_tile(LAS unsigned char* lds, const int (&kx)[4], const bf16x8 (&Qb)[4], f32x4 (&oacc)[8], float& m, float& lsum, const bool band, const int dn, const int rb0, const LAS float* tb, const int lane) {
    const LAS unsigned char* st = lds + STG * AT_STAGE;
    bf16x8 fr[16];
#pragma unroll
    for (int mt = 0; mt < 4; ++mt)
#pragma unroll
        for (int ks = 0; ks < 4; ++ks) fr[mt * 4 + ks] = *(const LAS bf16x8*)(st + mt * 4096 + kx[ks]);
    __builtin_amdgcn_sched_barrier(0);
    f32x4 sc[4];
#pragma unroll
    for (int mt = 0; mt < 4; ++mt) { sc[mt] = (f32x4){0.f, 0.f, 0.f, 0.f};
#pragma unroll
        for (int ks = 0; ks < 4; ++ks) sc[mt] = __builtin_amdgcn_mfma_f32_16x16x32_bf16(fr[mt * 4 + ks], Qb[ks], sc[mt], 0, 0, 0); }
    __builtin_amdgcn_sched_barrier(0);
#pragma unroll
    for (int i = 0; i < 16; ++i) fr[i] = *(const LAS bf16x8*)(st + 16384 + (i * 64 + lane) * 16);
    __builtin_amdgcn_sched_barrier(0);
    if (band) {
        if (dn >= 3) { const float bc = tb[256];
#pragma unroll
            for (int mt = 0; mt < 4; ++mt) sc[mt] = sc[mt] + bc; }
        else { const int rb = 64 * dn + rb0;
#pragma unroll
            for (int mt = 0; mt < 4; ++mt)
#pragma unroll
                for (int rr = 0; rr < 4; ++rr) { int idx = rb - 16 * mt - rr; idx = idx < 0 ? 0 : (idx > 256 ? 256 : idx); sc[mt][rr] += tb[idx]; } } }
    float mx = fmaxf(fmaxf(fmaxf(sc[0][0], sc[0][1]), fmaxf(sc[0][2], sc[0][3])), fmaxf(fmaxf(sc[1][0], sc[1][1]), fmaxf(sc[1][2], sc[1][3])));
    mx = fmaxf(mx, fmaxf(fmaxf(fmaxf(sc[2][0], sc[2][1]), fmaxf(sc[2][2], sc[2][3])), fmaxf(fmaxf(sc[3][0], sc[3][1]), fmaxf(sc[3][2], sc[3][3]))));
    mx = fmaxf(mx, __shfl_xor(mx, 16)); mx = fmaxf(mx, __shfl_xor(mx, 32));
    const float L2E = 1.4426950408889634f;
    const float mn = fmaxf(m, mx), alpha = __builtin_amdgcn_exp2f((m - mn) * L2E), mnl = mn * L2E; m = mn;
    float ps = 0.f;
#pragma unroll
    for (int mt = 0; mt < 4; ++mt)
#pragma unroll
        for (int rr = 0; rr < 4; ++rr) { const float e = __builtin_amdgcn_exp2f(__builtin_fmaf(sc[mt][rr], L2E, -mnl)); sc[mt][rr] = e; ps += e; }
    lsum = lsum * alpha + ps;
#pragma unroll
    for (int i = 0; i < 8; ++i) oacc[i] = oacc[i] * alpha;
    bf16x8 Pb[2]; Pb[0] = pack_b(sc[0], sc[1]); Pb[1] = pack_b(sc[2], sc[3]);
#pragma unroll
    for (int m8 = 0; m8 < 8; ++m8)
#pragma unroll
        for (int kt = 0; kt < 2; ++kt) oacc[m8] = __builtin_amdgcn_mfma_f32_16x16x32_bf16(fr[m8 * 2 + kt], Pb[kt], oacc[m8], 0, 0, 0);
}
__device__ __forceinline__ void phase_attn(Frame& F, int l, const bool shared_step) {
    KARGS();
    const bf16* proj = (const bf16*)(WSP + SC_PROJ); const bf16* kvm = (const bf16*)(WSP + MS_KVM) + (size_t)l * MROWS * 1024; bf16* mix = (bf16*)(WSP + WS_HB);
    const bf16* vct = (const bf16*)(WSP + SC_VCT); const bf16* vmt = (const bf16*)(WSP + MS_VMT);
    const float* relb = IN(I_RELB) + (size_t)l * NH * RELW;
    const int lane = F.lane, c16 = lane & 15, q4 = lane >> 4, w4 = F.wave & 3, g = F.wave >> 2, wave = F.wave;
    LAS float* tb = (LAS float*)(F.lds + AT_TB);
    int kx[4];
#pragma unroll
    for (int ks = 0; ks < 4; ++ks) kx[ks] = c16 * 256 + (((4 * ks + q4) ^ c16) << 4);
    const int vcu = (F.G & 7) == 0 ? (F.blk & 7) * (F.G >> 3) + (F.blk >> 3) : F.blk;
    const int lb = (F.blk >> 3) - 8;
    for (int it = 0; ; ++it) {
        int p;
        if (shared_step) {
            int j;
            if (it < 5) j = it * 24 + lb; else { if (it > 5 || lb < 8 || lb >= 16) break; j = 112 + lb; }
            int kd, bhl, pn;
            if (j < 48) { kd = 0; bhl = j / 12; pn = 4 + (j - bhl * 12); }
            else if (j < 60) { kd = 0; bhl = (j - 48) & 3; pn = 3 - ((j - 48) >> 2); }
            else if (j < 124) { kd = 1; bhl = (j - 60) >> 4; pn = (j - 60) & 15; }
            else { kd = 0; bhl = j - 124; pn = 0; }
            p = kd * 512 + ((F.blk & 7) * 4 + bhl) * 16 + pn;
        } else { p = vcu + it * F.G; if (p >= 1024) break; }
        const int u0 = 2 * p, kind = u0 >> 10, r = u0 & 1023, b = r >> 7, h = (r >> 5) & 3, n0 = r & 31, n = n0 + g;
        const int cs = kind == 0 ? (n0 - NPREV < 0 ? 0 : n0 - NPREV) : 0, nts = kind == 0 ? n0 + 2 - cs : 4;
        const int c0 = kind == 0 ? (n - NPREV < 0 ? 0 : n - NPREV) : 0, lo = c0 - cs, hi = kind == 0 ? n + 1 - cs : 4;
        const int tq = b * SEQ + n * CH + 16 * w4;
        const bf16* qrow = proj + (size_t)(tq + c16) * NPROJ + (kind == 0 ? C_QC : C_QM) + h * HD + 8 * q4;
        const bf16* kbase = kind == 0 ? proj + (size_t)(b * SEQ + cs * CH) * NPROJ + C_KC + h * HD : kvm + (size_t)(b * NMEM) * 1024 + h * HD;
        const int ldk = kind == 0 ? NPROJ : 1024;
        const bf16* vtb = kind == 0 ? vct + (size_t)((b * NH + h) * NCHUNK + cs) * 8192 : vmt + (size_t)((b * NH + h) * 4) * 8192;
        bf16x8 Qb[4];
#pragma unroll
        for (int ks = 0; ks < 4; ++ks) Qb[ks] = *(const bf16x8*)(qrow + 32 * ks);
        float tbv = 0.f;
        if (kind == 0 && wave < 5) { const int idx = lane + 64 * wave; tbv = relb[h * RELW + (idx < RELW ? idx : RELW - 1)]; }
        asm volatile("s_waitcnt vmcnt(0)" ::: "memory");
        if (kind == 0 && wave < 5) { const int idx = lane + 64 * wave; if (idx < RELW) tb[idx] = tbv; }
        f32x4 oacc[8];
#pragma unroll
        for (int i = 0; i < 8; ++i) oacc[i] = (f32x4){0.f, 0.f, 0.f, 0.f};
        float m = -1.0e30f, lsum = 0.f;
        const int rb0 = 16 * w4 + c16 - 4 * q4 + 128;
        unsigned koff[2];
#pragma unroll
        for (int k = 0; k < 2; ++k) { const int row = 8 * wave + 4 * k + q4; koff[k] = (unsigned)(row * ldk + ((c16 ^ (row & 15)) << 3)) * 2u; }
        const unsigned voff = (unsigned)((2 * wave) * 64 + lane) * 16u;
#define AT_ISSUE(tile, stg) do { const int tc_ = (tile) < nts ? (tile) : nts - 1; attn_dma(kbase + (size_t)tc_ * CH * ldk, vtb + (size_t)tc_ * 8192, koff, voff, F.lds + (stg) * AT_STAGE, wave); } while (0)
#define AT_STEP(k) do { asm volatile("s_waitcnt vmcnt(8) lgkmcnt(0)" ::: "memory"); __builtin_amdgcn_s_barrier(); asm volatile("" ::: "memory"); \
            AT_ISSUE(ti + (k) + 3, ((k) + 3) & 3); \
            if (ti + (k) >= lo && ti + (k) < hi) attn_tile<(k)>(F.lds, kx, Qb, oacc, m, lsum, kind == 0, n - (cs + ti + (k)), rb0, tb, lane); } while (0)
        AT_ISSUE(0, 0); AT_ISSUE(1, 1); AT_ISSUE(2, 2);
#pragma unroll 1
        for (int ti = 0; ti < nts; ti += 4) {
            AT_STEP(0);
            if (ti + 1 < nts) AT_STEP(1);
            if (ti + 2 < nts) AT_STEP(2);
            if (ti + 3 < nts) AT_STEP(3);
        }
#undef AT_STEP
#undef AT_ISSUE
        lsum += __shfl_xor(lsum, 16); lsum += __shfl_xor(lsum, 32);
        const float inv = 1.0f / lsum;
        const int ocol = (kind == 0 ? 1024 : 1536) + h * HD + 4 * q4;
#pragma unroll
        for (int m8 = 0; m8 < 8; ++m8) { const f32x4 o = oacc[m8] * inv; *(v2u*)((unsigned char*)mix + img_off(tq + c16, (ocol + 16 * m8) * 2, D * 2)) = (v2u){pg8::cvt_pk_bf16(o[0], o[1]), pg8::cvt_pk_bf16(o[2], o[3])}; }
        asm volatile("s_waitcnt vmcnt(0) lgkmcnt(0)" ::: "memory"); __builtin_amdgcn_s_barrier(); asm volatile("" ::: "memory");
    }
}

__device__ __forceinline__ void phase_post(Frame& F, int l) {
    KARGS();
    const bf16* proj = (const bf16*)(WSP + SC_PROJ); const float* obuf = (const float*)(WSP + SC_OBUF); bf16* mix = (bf16*)(WSP + WS_HB);
    const int gw = F.blk * NWAVES + F.wave, NGW = F.G * NWAVES, lane = F.lane, li = lane & 15, d0 = li * 8, h = lane >> 4;
    const int kind = gw & 1, tstart = gw >> 1, tstride = NGW >> 1;
    float gv[8]; { const float* gn = kind == 0 ? IN(I_DNG) + l * HD + d0 : IN(I_RNG) + l * GW + h * HD + d0;
#pragma unroll
        for (int j = 0; j < 8; ++j) gv[j] = gn[j]; }
    for (int tb = tstart; tb < T; tb += 4 * tstride) {
        f32x4 a0[4], a1[4]; v4u zz[4];
#pragma unroll
        for (int u = 0; u < 4; ++u) { const int t = tb + u * tstride; a0[u] = *(const f32x4*)(obuf + (size_t)t * 1024 + kind * 512 + lane * 8); a1[u] = *(const f32x4*)(obuf + (size_t)t * 1024 + kind * 512 + lane * 8 + 4);
            zz[u] = *(const v4u*)(proj + (size_t)t * NPROJ + (kind == 0 ? C_ZA : C_GB) + lane * 8); }
#pragma unroll
        for (int u = 0; u < 4; ++u) { const int t = tb + u * tstride;
            float o[8] = {a0[u].x, a0[u].y, a0[u].z, a0[u].w, a1[u].x, a1[u].y, a1[u].z, a1[u].w}; float z[8]; unpack8(zz[u], z);
            if (kind == 0) { float ss = 0.f;
#pragma unroll
                for (int j = 0; j < 8; ++j) ss += o[j] * o[j];
                const float r = rsqrtf(grp16_sum(ss) * (1.0f / HD) + EPS);
#pragma unroll
                for (int j = 0; j < 8; ++j) o[j] = o[j] * r * gv[j] * silu_f(z[j]);
            } else { float sm = 0.f;
#pragma unroll
                for (int j = 0; j < 8; ++j) sm += o[j];
                const float mu = grp16_sum(sm) * (1.0f / HD); float sv = 0.f;
#pragma unroll
                for (int j = 0; j < 8; ++j) { o[j] -= mu; sv += o[j] * o[j]; }
                const float r = rsqrtf(grp16_sum(sv) * (1.0f / HD) + EPS);
#pragma unroll
                for (int j = 0; j < 8; ++j) o[j] = o[j] * r * gv[j] * silu_f(z[j]); }
            *(v4u*)((unsigned char*)mix + img_off(t, (kind * 512 + lane * 8) * 2, D * 2)) = pack8(o); }
    }
}

__device__ __forceinline__ void phase_route(Frame& F) {
    LAS int* lc = (LAS int*)F.lds;
    LAS int* base = lc + 2048;
    LAS int* tot = base + 8; LAS int* tst = tot + 8; LAS int* spos = tst + 16;
    const int* cnt = (const int*)(WSP + MS_CNT); const int* tope = (const int*)(WSP + MS_TOPE); const float* topg = (const float*)(WSP + MS_TOPG);
    int* pos = (int*)(WSP + MS_POS); float* rowg = (float*)(WSP + MS_ROWG); int* tile = (int*)(WSP + MS_TILE);
    const bf16* h2 = (const bf16*)(WSP + WS_HB); bf16* xs = (bf16*)(WSP + SC_XS);
    const int rpb = T / F.G;
    for (int i = F.tid; i < F.G * 8; i += NTHREADS) lc[i] = cnt[i];
    __syncthreads();
    if (F.tid < 8) { int before = 0, total = 0; for (int bI = 0; bI < F.G; ++bI) { const int c = lc[bI * 8 + F.tid]; if (bI < F.blk) before += c; total += c; } base[F.tid] = before; tot[F.tid] = total; }
    __syncthreads();
    if (F.tid == 0) { int ts = 0; for (int e = 0; e < 8; ++e) { tst[e] = ts; ts += (tot[e] + 255) >> 8; } tst[8] = ts;
        if (F.blk == 0) tile[0] = ts; }
    __syncthreads();
    if (F.blk == 0 && F.tid < tst[8]) { int e = 0;
#pragma unroll 1
        for (int q = 1; q < 8; ++q) e += (F.tid >= tst[q]) ? 1 : 0;
        tile[16 + F.tid] = e; }
    if (F.tid < 8) { int cursor = tst[F.tid] * 256 + base[F.tid];
        for (int i = 0; i < 2 * rpb; ++i) { const int tok = F.blk * rpb + (i >> 1); if (tope[tok * 2 + (i & 1)] == F.tid) { spos[i] = cursor; pos[tok * 2 + (i & 1)] = cursor; rowg[cursor] = topg[tok * 2 + (i & 1)]; ++cursor; } } }
    __syncthreads();
    unsigned char* xs8 = (unsigned char*)xs; const float* sa = (const float*)(WSP + MS_SA); float* sxs = (float*)(WSP + MS_SXS);
    for (int i = F.wave; i < 2 * rpb; i += NWAVES) { const int tok = F.blk * rpb + (i >> 1), prow = spos[i];
        v4u w[2];
#pragma unroll
        for (int j = 0; j < 2; ++j) w[j] = *(const v4u*)((const unsigned char*)h2 + img_off(tok, 1024 * j + 16 * F.lane, D));
#pragma unroll
        for (int j = 0; j < 2; ++j) *(v4u*)(xs8 + img_off(prow, 1024 * j + 16 * F.lane, D)) = w[j];
        if (F.lane == 0) sxs[prow] = sa[tok]; }
    const unsigned z0 = (unsigned)F.tid >> 31;
    if (F.blk < 8) { const int e = F.blk, lo = tst[e] * 256 + tot[e], hi = tst[e + 1] * 256;
        for (int r = lo + F.wave; r < hi; r += NWAVES) { rowg[r] = 0.f; if (F.lane == 0) sxs[r] = 0.f;
#pragma unroll
            for (int j = 0; j < 2; ++j) *(v4u*)(xs8 + img_off(r, 1024 * j + 16 * F.lane, D)) = (v4u){z0, z0, z0, z0}; } }
    __syncthreads();
}
__device__ __forceinline__ void phase_combine(Frame& F) {
    const int* pos = (const int*)(WSP + MS_POS); const bf16* Y = (const bf16*)(WSP + SC_Y); const bf16* x3 = (const bf16*)(WSP + WS_XB) + (size_t)T * D;
    const int gw = F.blk * NWAVES + F.wave, NGW = F.G * NWAVES;
    for (int t = gw; t < T; t += NGW) { const int p0 = pos[t * 2], p1 = pos[t * 2 + 1];
        f32x4* o = (f32x4*)(OUTP + (size_t)t * D) + F.lane; const v2u* xr = (const v2u*)(x3 + (size_t)t * D) + F.lane; const v2u* y0 = (const v2u*)(Y + (size_t)p0 * D) + F.lane; const v2u* y1 = (const v2u*)(Y + (size_t)p1 * D) + F.lane;
#pragma unroll
        for (int j = 0; j < 8; ++j) { const v2u xx = xr[64 * j], a = y0[64 * j], c = y1[64 * j]; f32x4 x;
            x.x = bflo(xx.x) + bflo(a.x) + bflo(c.x); x.y = bfhi(xx.x) + bfhi(a.x) + bfhi(c.x); x.z = bflo(xx.y) + bflo(a.y) + bflo(c.y); x.w = bfhi(xx.y) + bfhi(a.y) + bfhi(c.y); o[64 * j] = x; } }
}

constexpr int STEPS_PER_LAYER = 12, N_STEPS = 1 + 2 * STEPS_PER_LAYER;
__global__ void __launch_bounds__(NTHREADS, 2) fwd(Args args) {
    extern __shared__ __attribute__((aligned(16))) unsigned char lds_raw[];
    Frame F; F.lds = (LAS unsigned char*)lds_raw; F.tid = threadIdx.x; F.lane = F.tid & 63; F.wave = __builtin_amdgcn_readfirstlane(F.tid >> 6); F.G = gridDim.x; F.blk = blockIdx.x;
    F.ap = (const __attribute__((address_space(4))) Args*)__builtin_amdgcn_kernarg_segment_ptr();
    F.out = (GAS float*)args.out; F.ws = (GAS unsigned char*)args.ws;
    volatile LAS unsigned* MISC = (volatile LAS unsigned*)(F.lds + LDS_CTL_OFF);
    if (F.tid < 64) MISC[F.tid] = 0u;
    __syncthreads();
    XcdBarrier bar = xcd_barrier_post((unsigned*)(WSP + WS_CTL) + CW_BAR, MISC + 8);
    const int lo = args.step_lo, hi = args.step_hi;
    bool first = true;
#ifndef ONLY
#define ONLY -1
#endif
#define EN(j) (ONLY < 0 || ONLY == (j))
#define FRESH() Frame P = F; asm volatile("" : "+s"(P.ws), "+s"(P.out), "+s"(P.ap), "+s"(P.blk), "+s"(P.G), "+s"(P.wave), "+v"(P.tid), "+v"(P.lane))
#define STEP(k) if (lo <= (k) && (k) < hi && (first ? (first = false, true) : (xcd_barrier(bar), true)))
    STEP(0) { FRESH(); if (EN(0)) phase_p0(P); }
#pragma unroll 1
    for (int l = 0; l < 2; ++l) {
        const int sb = 1 + l * STEPS_PER_LAYER;
        STEP(sb + 0) { FRESH(); { Frame& F = P; KARGS(); const void* xin = l == 0 ? (const void*)IN(I_X) : (const void*)(WSP + WS_XB); if (EN(1)) {
                if (l == 0) {
                    pg8::PlainSched S; S.A = nullptr; S.B = nullptr; S.nM = 0; S.nN = 0; S.G = F.G; S.c = F.blk; S.tstep = (size_t)256 * D * 2;
                    S.A2 = (const char*)(WSP + MS_MEMH); S.B2 = (const char*)(WSP + WS_WMKV); S.a2stride = (size_t)MROWS * D * 2; S.b2stride = (size_t)1024 * D * 2; S.n2 = 2;
                    pg8::EpiProj E{(bf16*)(WSP + SC_PROJ), (bf16*)(WSP + MS_KVM), (size_t)MROWS * 1024, nullptr, 1.0f};
                    pg8::gemm_phase<0>(F.lds, F.tid, D * 2, S, E);
                    if (F.blk >= 64) phase_rmsnorm(F, xin, l, IN(I_NMIXG) + (size_t)l * D, (bf16*)(WSP + WS_HB), 1, l, F.blk - 64, F.G - 64);
                } else phase_rmsnorm(F, xin, l, IN(I_NMIXG) + (size_t)l * D, (bf16*)(WSP + WS_HB), 1, l, F.blk, F.G); } } }
        STEP(sb + 1) { FRESH(); Frame& F = P;
#if W_IN_I8
            pg8::PlainSched S; S.A = (const char*)(WSP + WS_HB); S.B = (const char*)(WSP + WS_WIN) + (size_t)l * NPROJ * D; S.nM = T / 256; S.nN = NPROJ / 256; S.G = F.G; S.c = F.blk; S.tstep = (size_t)256 * D;
            S.A2 = nullptr; S.B2 = nullptr; S.a2stride = 0; S.b2stride = 0; S.n2 = 0;
            pg8::EpiProj E{(bf16*)(WSP + SC_PROJ), (bf16*)(WSP + MS_KVM), (size_t)MROWS * 1024, (const float*)(WSP + MS_SA), INV_SW_D};
            if (EN(2)) pg8::gemm_phase<2>(F.lds, F.tid, D, S, E);
#else
            pg8::PlainSched S; S.A = (const char*)(WSP + WS_HB); S.B = (const char*)(WSP + WS_WIN) + (size_t)l * NPROJ * D * 2; S.nM = T / 256; S.nN = NPROJ / 256; S.G = F.G; S.c = F.blk; S.tstep = (size_t)256 * D * 2;
            S.A2 = nullptr; S.B2 = nullptr; S.a2stride = 0; S.b2stride = 0; S.n2 = 0;
            pg8::EpiProj E{(bf16*)(WSP + SC_PROJ), (bf16*)(WSP + MS_KVM), (size_t)MROWS * 1024, nullptr, 1.0f};
            if (EN(2)) pg8::gemm_phase<0>(F.lds, F.tid, D * 2, S, E);
#endif
        }
        STEP(sb + 2) { FRESH(); if (EN(3)) phase_prep(P, l); }
        STEP(sb + 3) { FRESH(); if (EN(4)) phase_c1(P, l); }
        STEP(sb + 4) { FRESH(); if (EN(5)) {
            const bool sh = P.G == 256, sc = (P.blk >> 3) < 8;
            if (!sh || !sc) phase_attn(P, l, sh);
            if (!sh) phase_scan(P, l); else if (sc) phase_scan8(P, l);
        } }
        STEP(sb + 5) { FRESH(); if (EN(6)) phase_post(P, l); }
        STEP(sb + 6) { FRESH(); Frame& F = P; KARGS(); const void* xin = l == 0 ? (const void*)IN(I_X) : (const void*)(WSP + WS_XB);
            bf16* xmid = l == 0 ? (bf16*)OUTP : (bf16*)(WSP + WS_XB) + (size_t)T * D;
            pg8::PlainSched S; S.A = (const char*)(WSP + WS_HB); S.B = (const char*)(WSP + WS_WOUT) + (size_t)l * D * D * 2; S.nM = T / 256; S.nN = D / 256; S.G = F.G; S.c = F.blk; S.tstep = (size_t)256 * D * 2;
            S.A2 = nullptr; S.B2 = nullptr; S.a2stride = 0; S.b2stride = 0; S.n2 = 0;
            pg8::EpiRes E{xin, l, xmid};
            if (EN(7)) pg8::gemm_phase<0>(F.lds, F.tid, D * 2, S, E);
        }
        STEP(sb + 7) { FRESH(); { Frame& F = P; KARGS(); if (EN(8)) phase_rmsnorm(F, l == 0 ? (const void*)OUTP : (const void*)((bf16*)(WSP + WS_XB) + (size_t)T * D), 1, IN(I_NFFG) + (size_t)l * D, (bf16*)(WSP + WS_HB), l == 0 ? 0 : 2, l, F.blk, F.G); } }
        if (l == 1) { STEP(sb + 8) { FRESH(); if (EN(9)) phase_route(P); } }
        STEP(sb + 9) { FRESH(); Frame& F = P;
            pg8::GroupSched S; S.G = F.G; S.c = F.blk; S.tstep = (size_t)256 * D;
            if (l == 0) { S.A = (const char*)(WSP + WS_HB); S.B = (const char*)(WSP + WS_WGU); S.tile_e = nullptr; S.nrt = T / 256; S.nN = 2 * DFF / 256; S.estride = 0; }
            else { S.A = (const char*)(WSP + SC_XS); S.B = (const char*)(WSP + WS_MGU); S.tile_e = (const int*)(WSP + MS_TILE) + 16; S.nrt = ((const int*)(WSP + MS_TILE))[0]; S.nN = 2 * DFFE / 256; S.estride = (size_t)2 * DFFE * D; }
            pg8::EpiSwiglu E{l == 0 ? (bf16*)(WSP + SC_ACT) : (bf16*)(WSP + SC_MACT), l == 0 ? DFF : DFFE, INV_SW_D, l, l == 0 ? (const float*)(WSP + MS_SA) : (const float*)(WSP + MS_SXS)};
            if (EN(10)) pg8::gemm_phase<2>(F.lds, F.tid, D, S, E);
        }
        STEP(sb + 10) { FRESH(); Frame& F = P;
            pg8::GroupSched S; S.G = F.G; S.c = F.blk; S.nN = D / 256;
            pg8::EpiDown E{(const bf16*)OUTP, (bf16*)(WSP + WS_XB), (bf16*)(WSP + SC_Y), (const float*)(WSP + MS_ROWG), l};
            if (l == 0) { S.A = (const char*)(WSP + SC_ACT); S.B = (const char*)(WSP + WS_WDN); S.tile_e = nullptr; S.nrt = T / 256; S.estride = 0; S.tstep = (size_t)256 * DFF * 2;
                if (EN(11)) pg8::gemm_phase<0>(F.lds, F.tid, DFF * 2, S, E); }
            else { S.A = (const char*)(WSP + SC_MACT); S.B = (const char*)(WSP + WS_MDN); S.tile_e = (const int*)(WSP + MS_TILE) + 16; S.nrt = ((const int*)(WSP + MS_TILE))[0]; S.estride = (size_t)D * DFFE; S.tstep = (size_t)256 * DFFE;
                if (EN(11)) pg8::gemm_phase<1>(F.lds, F.tid, DFFE, S, E); }
        }
        if (l == 1) { STEP(sb + 11) { FRESH(); if (EN(12)) phase_combine(P); } }
    }
#undef STEP
}

extern "C" void kernel_launch(void* const* d_in, const int* in_sizes, int n_in, void* d_out, int out_size, void* d_ws, size_t ws_size, hipStream_t stream) {
    static int grid = 0;
    if (grid == 0) {
        if (n_in != 25 || out_size != T * D || ws_size < WS_END) { fprintf(stderr, "kernel_launch: unexpected shapes (n_in %d, out %d, ws %zu < %zu)\n", n_in, out_size, ws_size, (size_t)WS_END); grid = -1; return; }
        int dev = 0, cus = 0, per_cu = 0;
        if (hipGetDevice(&dev) != hipSuccess || hipDeviceGetAttribute(&cus, hipDeviceAttributeMultiprocessorCount, dev) != hipSuccess) { grid = -1; return; }
        if (hipFuncSetAttribute((const void*)fwd, hipFuncAttributeMaxDynamicSharedMemorySize, LDS_BYTES) != hipSuccess) { fprintf(stderr, "kernel_launch: hipFuncSetAttribute failed\n"); grid = -1; return; }
        if (hipOccupancyMaxActiveBlocksPerMultiprocessor(&per_cu, (const void*)fwd, NTHREADS, LDS_BYTES) != hipSuccess || per_cu < 1) { fprintf(stderr, "kernel_launch: occupancy query says %d\n", per_cu); }
        (void)hipGetLastError();
        grid = cus;
        if (T % grid != 0) { fprintf(stderr, "kernel_launch: grid %d does not divide T\n", grid); grid = -1; return; }
    }
    if (grid < 0) return;
    (void)in_sizes;
    if (hipMemsetAsync((char*)d_ws + WS_CTL, 0, CTL_ZERO_BYTES, stream) != hipSuccess) return;
    Args a{};
    for (int i = 0; i < 25; ++i) a.in[i] = (const float*)d_in[i];
    a.out = (float*)d_out; a.ws = (unsigned char*)d_ws; a.pad0 = 3;
#if ONE_LAUNCH
    a.step_lo = 0; a.step_hi = N_STEPS;
    hipLaunchKernelGGL(fwd, dim3(grid), dim3(NTHREADS), LDS_BYTES, stream, a);
#ifdef PROBE_STEPS
    { const int ps[] = PROBE_STEPS; for (int s : ps) { a.step_lo = s; a.step_hi = s + 1; a.pad0 = PROBE_MASK; hipLaunchKernelGGL(fwd, dim3(grid), dim3(NTHREADS), LDS_BYTES, stream, a); } }
#endif
#else
    for (int s = 0; s < N_STEPS; ++s) {
        if (s >= 1 && s < 1 + STEPS_PER_LAYER && ((s - 1) == 8 || (s - 1) == 11)) continue;
        a.step_lo = s; a.step_hi = s + 1;
        hipLaunchKernelGGL(fwd, dim3(grid), dim3(NTHREADS), LDS_BYTES, stream, a);
    }
#endif
}
```
